# Optimizing an MI355X kernel written in HIP

```python
import math
import jax, jax.numpy as jnp
from jax import lax
import numpy as np

D_MODEL = 4096
BATCH = 2
SEQ = 4096
DEPTH = 4

N_MIXERS = 2
N_SSM_LAYERS = (DEPTH + 1) // 2
N_ATTN_LAYERS = DEPTH // 2
SSM_GROUP = 16
SSM_GROUPS = D_MODEL // SSM_GROUP
SSM_STATE = 64
DT_MIN = 0.001
DT_MAX = 0.1
HEAD_DIM = 64
N_HEADS = D_MODEL // HEAD_DIM
N_KV_HEADS = 8
GQA_GROUP = N_HEADS // N_KV_HEADS
WINDOW = 128
BLOCK = WINDOW
Q_WIDTH = N_HEADS * HEAD_DIM
KV_WIDTH = N_KV_HEADS * HEAD_DIM
QKV_WIDTH = Q_WIDTH + 2 * KV_WIDTH
REL_BUCKETS = 32
REL_MAX_DIST = 128
D_FF = ((8 * D_MODEL + 3 * 256 - 1) // (3 * 256)) * 256
ALPHA = (2 * DEPTH) ** 0.25
BETA = (8 * DEPTH) ** -0.25
N_MODS = 6
ADA_INIT = 0.1
LN_EPS = 1e-5
NEG_INF = -1e30

kernel_name = "hybrid_s5_swa_sink_deepnorm_adaln"


def _layernorm(x, g, b):
    xf = x.astype(jnp.float32)
    mu = jnp.mean(xf, axis=-1, keepdims=True)
    var = jnp.mean(jnp.square(xf - mu), axis=-1, keepdims=True)
    y = (xf - mu) * lax.rsqrt(var + LN_EPS) * g.astype(jnp.float32) + b.astype(jnp.float32)
    return y.astype(x.dtype)


def _rel_bucket(dist):
    max_exact = REL_BUCKETS // 2
    d = jnp.maximum(dist, 0)
    log_ratio = jnp.log(jnp.maximum(d, 1).astype(jnp.float32) / max_exact) / math.log(REL_MAX_DIST / max_exact)
    large = max_exact + (log_ratio * (REL_BUCKETS - max_exact)).astype(jnp.int32)
    large = jnp.minimum(large, REL_BUCKETS - 1)
    return jnp.where(d < max_exact, d, large)


def _s5_mixer(h, a_re, a_im, log_dt, b_re, b_im, c_re, c_im, d_skip, w_val, w_gate):
    bsz, seq, _ = h.shape
    f32 = jnp.float32
    x = h.astype(f32)
    xg = x.reshape(bsz, seq, SSM_GROUPS, SSM_GROUP)
    a_re = a_re.astype(f32)
    a_im = a_im.astype(f32)
    dt = jnp.exp(log_dt.astype(f32))[:, None]
    mag = jnp.exp(a_re * dt)
    ab_re = mag * jnp.cos(a_im * dt)
    ab_im = mag * jnp.sin(a_im * dt)
    den = a_re * a_re + a_im * a_im
    nr = ab_re - 1.0
    k_re = (nr * a_re + ab_im * a_im) / den
    k_im = (ab_im * a_re - nr * a_im) / den
    b_re = b_re.astype(f32)
    b_im = b_im.astype(f32)
    bb_re = k_re[..., None] * b_re - k_im[..., None] * b_im
    bb_im = k_re[..., None] * b_im + k_im[..., None] * b_re
    u_re = jnp.einsum('blgc,gpc->lbgp', xg, bb_re)
    u_im = jnp.einsum('blgc,gpc->lbgp', xg, bb_im)
    shp = (seq, 1, SSM_GROUPS, SSM_STATE)
    at_re = jnp.broadcast_to(ab_re[None, None], shp)
    at_im = jnp.broadcast_to(ab_im[None, None], shp)

    def combine(e1, e2):
        a1r, a1i, b1r, b1i = e1
        a2r, a2i, b2r, b2i = e2
        return (a2r * a1r - a2i * a1i,
                a2r * a1i + a2i * a1r,
                a2r * b1r - a2i * b1i + b2r,
                a2r * b1i + a2i * b1r + b2i)

    _, _, s_re, s_im = lax.associative_scan(combine, (at_re, at_im, u_re, u_im), axis=0)
    y = (jnp.einsum('lbgp,gcp->blgc', s_re, c_re.astype(f32))
         - jnp.einsum('lbgp,gcp->blgc', s_im, c_im.astype(f32)))
    y = y.reshape(bsz, seq, D_MODEL) + d_skip.astype(f32) * x
    u = jax.nn.gelu(y).astype(h.dtype)
    return (u @ w_val) * jax.nn.sigmoid(u @ w_gate)


def _swa_sink_attention(h, w_qkv, b_qkv, w_o, sinks, rel_bias):
    bsz, seq, _ = h.shape
    nb = seq // BLOCK
    qkv = h @ w_qkv + b_qkv
    q, k, v = jnp.split(qkv, [Q_WIDTH, Q_WIDTH + KV_WIDTH], axis=-1)
    q = q.reshape(bsz, nb, BLOCK, N_KV_HEADS, GQA_GROUP, HEAD_DIM)
    k = k.reshape(bsz, nb, BLOCK, N_KV_HEADS, HEAD_DIM)
    v = v.reshape(bsz, nb, BLOCK, N_KV_HEADS, HEAD_DIM)

    def with_prev(t):
        prev = jnp.pad(t[:, :-1], ((0, 0), (1, 0), (0, 0), (0, 0), (0, 0)))
        return jnp.concatenate([prev, t], axis=2)

    kb = with_prev(k)
    vb = with_prev(v)
    logits = jnp.einsum('bnqkgd,bnskd->bnkgqs', q, kb,
                        preferred_element_type=jnp.float32) * (HEAD_DIM ** -0.5)
    qi = jnp.arange(BLOCK)[:, None]
    sj = jnp.arange(2 * BLOCK)[None, :]
    dist = qi + BLOCK - sj
    band = (dist >= 0) & (dist < WINDOW)
    blk = jnp.arange(nb)[:, None, None]
    mask = band[None] & ((blk > 0) | (sj >= BLOCK)[None])
    bias = rel_bias.astype(jnp.float32)[_rel_bucket(dist)]
    bias = jnp.transpose(bias, (2, 0, 1)).reshape(N_KV_HEADS, GQA_GROUP, BLOCK, 2 * BLOCK)
    logits = jnp.where(mask[None, :, None, None], logits + bias, NEG_INF)
    sink = jnp.broadcast_to(sinks.astype(jnp.float32).reshape(N_KV_HEADS, GQA_GROUP)[None, None, :, :, None, None],
                            logits.shape[:-1] + (1,))
    probs = jax.nn.softmax(jnp.concatenate([logits, sink], axis=-1), axis=-1)[..., :-1]
    out = jnp.einsum('bnkgqs,bnskd->bnqkgd', probs.astype(vb.dtype), vb)
    out = out.reshape(bsz, seq, Q_WIDTH)
    return out @ w_o


def _swiglu(h, w_in, w_down):
    gu = h @ w_in
    g, u = jnp.split(gu, 2, axis=-1)
    return (jax.nn.silu(g) * u) @ w_down


def setup_inputs(seed: int = 0) -> dict:
    key = jax.random.key(seed)
    ks = jax.random.split(key, 24)
    f32 = jnp.float32

    def nrm(k, shape, scale):
        return jax.random.normal(k, shape, f32) * scale

    n_idx = jnp.arange(SSM_STATE, dtype=f32)
    return {
        "x": nrm(ks[0], (BATCH, SEQ, D_MODEL), 1.0),
        "c": nrm(ks[1], (BATCH, D_MODEL), 1.0),
        "w_ada": nrm(ks[2], (D_MODEL, N_MODS * D_MODEL), ADA_INIT * D_MODEL ** -0.5),
        "b_ada": nrm(ks[3], (N_MODS * D_MODEL,), 0.01),
        "ada_table": nrm(ks[4], (DEPTH, N_MODS, D_MODEL), ADA_INIT),
        "ln_g": 1.0 + nrm(ks[5], (DEPTH, 2, D_MODEL), 0.02),
        "ln_b": nrm(ks[6], (DEPTH, 2, D_MODEL), 0.02),
        "ffn_w_in": nrm(ks[7], (DEPTH, D_MODEL, 2 * D_FF), D_MODEL ** -0.5),
        "ffn_w_down": nrm(ks[8], (DEPTH, D_FF, D_MODEL), BETA * D_FF ** -0.5),
        "attn_w_qkv": nrm(ks[9], (N_ATTN_LAYERS, D_MODEL, QKV_WIDTH), D_MODEL ** -0.5),
        "attn_b_qkv": nrm(ks[10], (N_ATTN_LAYERS, QKV_WIDTH), 0.01),
        "attn_w_o": nrm(ks[11], (N_ATTN_LAYERS, Q_WIDTH, D_MODEL), BETA * Q_WIDTH ** -0.5),
        "attn_sinks": nrm(ks[12], (N_ATTN_LAYERS, N_HEADS), 0.5),
        "rel_bias": nrm(ks[13], (REL_BUCKETS, N_HEADS), 0.5),
        "ssm_a_re": -0.5 * jnp.exp(nrm(ks[14], (N_SSM_LAYERS, SSM_GROUPS, SSM_STATE), 0.05)),
        "ssm_a_im": math.pi * n_idx + nrm(ks[15], (N_SSM_LAYERS, SSM_GROUPS, SSM_STATE), 0.05),
        "ssm_log_dt": jax.random.uniform(ks[16], (N_SSM_LAYERS, SSM_GROUPS), f32,
                                         math.log(DT_MIN), math.log(DT_MAX)),
        "ssm_b_re": nrm(ks[17], (N_SSM_LAYERS, SSM_GROUPS, SSM_STATE, SSM_GROUP), (2 * SSM_GROUP) ** -0.5),
        "ssm_b_im": nrm(ks[18], (N_SSM_LAYERS, SSM_GROUPS, SSM_STATE, SSM_GROUP), (2 * SSM_GROUP) ** -0.5),
        "ssm_c_re": nrm(ks[19], (N_SSM_LAYERS, SSM_GROUPS, SSM_GROUP, SSM_STATE), SSM_STATE ** -0.5),
        "ssm_c_im": nrm(ks[20], (N_SSM_LAYERS, SSM_GROUPS, SSM_GROUP, SSM_STATE), SSM_STATE ** -0.5),
        "ssm_d": nrm(ks[21], (N_SSM_LAYERS, D_MODEL), 0.5),
        "ssm_w_val": nrm(ks[22], (N_SSM_LAYERS, D_MODEL, D_MODEL), BETA * D_MODEL ** -0.5),
        "ssm_w_gate": nrm(ks[23], (N_SSM_LAYERS, D_MODEL, D_MODEL), D_MODEL ** -0.5),
    }


def reference(x, c, w_ada, b_ada, ada_table, ln_g, ln_b, ffn_w_in, ffn_w_down,
              attn_w_qkv, attn_b_qkv, attn_w_o, attn_sinks, rel_bias,
              ssm_a_re, ssm_a_im, ssm_log_dt, ssm_b_re, ssm_b_im, ssm_c_re, ssm_c_im,
              ssm_d, ssm_w_val, ssm_w_gate):
    bsz = x.shape[0]
    mods_shared = (jax.nn.silu(c) @ w_ada + b_ada).reshape(bsz, N_MODS, D_MODEL)
    for layer in range(DEPTH):
        mods = mods_shared + ada_table[layer]
        shift_m = mods[:, 0, None, :]
        scale_m = mods[:, 1, None, :]
        gate_m = mods[:, 2, None, :]
        shift_f = mods[:, 3, None, :]
        scale_f = mods[:, 4, None, :]
        gate_f = mods[:, 5, None, :]
        j = layer // N_MIXERS
        h = x * (1.0 + scale_m) + shift_m
        if layer % N_MIXERS == 0:
            y = _s5_mixer(h, ssm_a_re[j], ssm_a_im[j], ssm_log_dt[j], ssm_b_re[j], ssm_b_im[j],
                          ssm_c_re[j], ssm_c_im[j], ssm_d[j], ssm_w_val[j], ssm_w_gate[j])
        else:
            y = _swa_sink_attention(h, attn_w_qkv[j], attn_b_qkv[j], attn_w_o[j],
                                    attn_sinks[j], rel_bias)
        x = _layernorm(ALPHA * x + (1.0 + gate_m) * y, ln_g[layer, 0], ln_b[layer, 0])
        h = x * (1.0 + scale_f) + shift_f
        y = _swiglu(h, ffn_w_in[layer], ffn_w_down[layer])
        x = _layernorm(ALPHA * x + (1.0 + gate_f) * y, ln_g[layer, 1], ln_b[layer, 1])
    return x
```

```cpp
#include <hip/hip_runtime.h>
#include <cstdio>
#include <cstdint>
namespace pg8 {
#define PG8_LAS __attribute__((address_space(3)))
typedef unsigned short bf16_t;
typedef short bf16x8 __attribute__((ext_vector_type(8)));
typedef float f32x4 __attribute__((ext_vector_type(4)));
typedef unsigned u32x4 __attribute__((ext_vector_type(4)));
constexpr int BM = 256, BK = 64, HALF = 128, HTB = HALF * BK * 2  , STAGE_BYTES = 8 * HTB, NXCD = 8, WGM = 8;

__host__ __device__ __forceinline__ int lds_byte(int r, int c) { const int st = (r >> 4) * 2 + (c >> 5), rr = r & 15, cc = c & 31, ob = rr * 64 + cc * 2; return st * 1024 + (ob ^ (((ob >> 9) & 1) << 5)); }
__host__ __device__ __forceinline__ void stage_rc(int b, int& R, int& C) { const int st = b / 1024, sb = b % 1024, swz = sb ^ (((sb >> 9) & 1) << 5); R = (st >> 1) * 16 + swz / 64; C = (st & 1) * 32 + (swz % 64) / 2; }
__host__ __device__ __forceinline__ int perm32(int rho) { const int n = rho >> 4, i = rho & 15; return 8 * (i >> 2) + 4 * n + (i & 3); }

struct Unit { int pm, pn; };
struct Gemm { const bf16_t* A; const bf16_t* Bt; int M, N, K; };

struct StaticOrder {
    int nM, nN, nwg, G, c;
    __host__ __device__ void init(int M, int N, int G_, int c_) { nM = M / BM; nN = N / BM; nwg = nM * nN; G = G_; c = c_; }
    __host__ __device__ bool next(int i, Unit& u) const {
        const long L = (long)i * G + c; if (L >= nwg) return false;
        int wgid = (int)L; { const int q = nwg / NXCD, r = nwg % NXCD, xcd = wgid % NXCD, off = wgid / NXCD; wgid = (xcd < r ? xcd * (q + 1) : r * (q + 1) + (xcd - r) * q) + off; }
        const int nig = WGM * nN, gid = wgid / nig, fm = gid * WGM, gsz = (nM - fm) < WGM ? (nM - fm) : WGM;
        u.pm = fm + ((wgid % nig) % gsz); u.pn = (wgid % nig) / gsz; return true;
    }
    __device__ __forceinline__ void a_ready(const Unit&) const {}
    __device__ __forceinline__ void done(const Unit&) const {}
};
__device__ __forceinline__ unsigned cvt_pk_bf16(float lo, float hi) { unsigned r; asm volatile("v_cvt_pk_bf16_f32 %0, %1, %2" : "=v"(r) : "v"(lo), "v"(hi)); return r; }
typedef float f32x2 __attribute__((ext_vector_type(2)));
__device__ __forceinline__ float fast_sigmoid(float v) { return __builtin_amdgcn_rcpf(1.0f + __builtin_amdgcn_exp2f(-1.44269504089f * v)); }
constexpr float ALPHA_RES = 1.681792830507429f;

struct EpiQKV {
    static constexpr bool PERM = true, AFTER_DRAIN = false;
    bf16_t* O; int ldc; const float* bias;
    __device__ __forceinline__ void operator()(const f32x4 (&acc)[2][2][4][2], const Unit& u, int wr, int wc, int fr, int fq) const {
        const int row0 = u.pm * BM + wr * 64 + fr, col0 = u.pn * BM + wc * 32 + 8 * fq;
        f32x4 bv[2][2];
#pragma unroll
        for (int bj = 0; bj < 2; ++bj)
#pragma unroll
            for (int n = 0; n < 2; ++n) bv[bj][n] = *(const f32x4*)(bias + col0 + bj * HALF + 4 * n);
#pragma unroll
        for (int ai = 0; ai < 2; ++ai)
#pragma unroll
            for (int m = 0; m < 4; ++m) { bf16_t* rowp = O + (size_t)(row0 + ai * HALF + m * 16) * ldc + col0;
#pragma unroll
                for (int bj = 0; bj < 2; ++bj) { const f32x4 v0 = acc[ai][bj][m][0] + bv[bj][0], v1 = acc[ai][bj][m][1] + bv[bj][1];
                    u32x4 w; w.x = cvt_pk_bf16(v0[0], v0[1]); w.y = cvt_pk_bf16(v0[2], v0[3]); w.z = cvt_pk_bf16(v1[0], v1[1]); w.w = cvt_pk_bf16(v1[2], v1[3]);
                    *(u32x4*)(rowp + bj * HALF) = w; } }
    }
};
struct EpiSwiGLU {
    static constexpr bool PERM = true, AFTER_DRAIN = false;
    bf16_t* O; int ldc;
    __device__ __forceinline__ void operator()(const f32x4 (&acc)[2][2][4][2], const Unit& u, int wr, int wc, int fr, int fq) const {
        const int row0 = u.pm * BM + wr * 64 + fr, col0 = u.pn * HALF + wc * 32 + 8 * fq;
#pragma unroll
        for (int ai = 0; ai < 2; ++ai)
#pragma unroll
            for (int m = 0; m < 4; ++m) { bf16_t* rowp = O + (size_t)(row0 + ai * HALF + m * 16) * ldc + col0;
                float t[8], gu[8];
#pragma unroll
                for (int i = 0; i < 8; ++i) { const float g = acc[ai][0][m][i >> 2][i & 3]; t[i] = -1.44269504089f * g; gu[i] = g * acc[ai][1][m][i >> 2][i & 3]; }
#pragma unroll
                for (int i = 0; i < 8; ++i) t[i] = __builtin_amdgcn_exp2f(t[i]);
#pragma unroll
                for (int i = 0; i < 8; ++i) t[i] = t[i] + 1.0f;
#pragma unroll
                for (int i = 0; i < 8; ++i) t[i] = __builtin_amdgcn_rcpf(t[i]);
#pragma unroll
                for (int i = 0; i < 8; ++i) t[i] = t[i] * gu[i];
                asm volatile("" : "+v"(t[0]), "+v"(t[1]), "+v"(t[2]), "+v"(t[3]), "+v"(t[4]), "+v"(t[5]), "+v"(t[6]), "+v"(t[7]));
                u32x4 w; w.x = cvt_pk_bf16(t[0], t[1]); w.y = cvt_pk_bf16(t[2], t[3]); w.z = cvt_pk_bf16(t[4], t[5]); w.w = cvt_pk_bf16(t[6], t[7]);
                *(u32x4*)rowp = w; }
    }
};
struct EpiGLUY {
    static constexpr bool PERM = true, AFTER_DRAIN = false;
    bf16_t* Y; const float* gmod;
    __device__ __forceinline__ void operator()(const f32x4 (&acc)[2][2][4][2], const Unit& u, int wr, int wc, int fr, int fq) const {
        const int row0 = u.pm * BM + wr * 64 + fr, col0 = u.pn * HALF + wc * 32 + 8 * fq, b = u.pm >> 4;
        f32x4 gm[2];
#pragma unroll
        for (int n = 0; n < 2; ++n) gm[n] = *(const f32x4*)(gmod + (size_t)b * 6 * 4096 + col0 + 4 * n) + 1.0f;
#pragma unroll
        for (int ai = 0; ai < 2; ++ai)
#pragma unroll
            for (int m = 0; m < 4; ++m) { float r[8], t[8];
#pragma unroll
                for (int i = 0; i < 8; ++i) { t[i] = -1.44269504089f * acc[ai][1][m][i >> 2][i & 3]; r[i] = gm[i >> 2][i & 3] * acc[ai][0][m][i >> 2][i & 3]; }
#pragma unroll
                for (int i = 0; i < 8; ++i) t[i] = __builtin_amdgcn_exp2f(t[i]);
#pragma unroll
                for (int i = 0; i < 8; ++i) t[i] = t[i] + 1.0f;
#pragma unroll
                for (int i = 0; i < 8; ++i) t[i] = __builtin_amdgcn_rcpf(t[i]);
#pragma unroll
                for (int i = 0; i < 8; ++i) r[i] = r[i] * t[i];
                asm volatile("" : "+v"(r[0]), "+v"(r[1]), "+v"(r[2]), "+v"(r[3]), "+v"(r[4]), "+v"(r[5]), "+v"(r[6]), "+v"(r[7]));
                u32x4 w; w.x = cvt_pk_bf16(r[0], r[1]); w.y = cvt_pk_bf16(r[2], r[3]); w.z = cvt_pk_bf16(r[4], r[5]); w.w = cvt_pk_bf16(r[6], r[7]);
                *(u32x4*)(Y + (size_t)(row0 + ai * HALF + m * 16) * 4096 + col0) = w; }
    }
};
struct EpiY {
    static constexpr bool PERM = true, AFTER_DRAIN = false;
    bf16_t* Y; const float* gmod;
    __device__ __forceinline__ void operator()(const f32x4 (&acc)[2][2][4][2], const Unit& u, int wr, int wc, int fr, int fq) const {
        const int row0 = u.pm * BM + wr * 64 + fr, col0 = u.pn * BM + wc * 32 + 8 * fq, b = u.pm >> 4;
        f32x4 gm[2][2];
#pragma unroll
        for (int bj = 0; bj < 2; ++bj)
#pragma unroll
            for (int n = 0; n < 2; ++n) gm[bj][n] = *(const f32x4*)(gmod + (size_t)b * 6 * 4096 + col0 + bj * HALF + 4 * n) + 1.0f;
#pragma unroll
        for (int ai = 0; ai < 2; ++ai)
#pragma unroll
            for (int m = 0; m < 4; ++m) { bf16_t* rowp = Y + (size_t)(row0 + ai * HALF + m * 16) * 4096 + col0;
#pragma unroll
                for (int bj = 0; bj < 2; ++bj) { const f32x4 v0 = acc[ai][bj][m][0] * gm[bj][0], v1 = acc[ai][bj][m][1] * gm[bj][1];
                    u32x4 w; w.x = cvt_pk_bf16(v0[0], v0[1]); w.y = cvt_pk_bf16(v0[2], v0[3]); w.z = cvt_pk_bf16(v1[0], v1[1]); w.w = cvt_pk_bf16(v1[2], v1[3]);
                    *(u32x4*)(rowp + bj * HALF) = w; } }
    }
};
template <class Epi, class Sched, bool ALIGN_EPI, bool SP2, int KD>
__device__ __forceinline__ void gemm_phase(PG8_LAS unsigned char* lds, const Gemm g, const Sched& S, const Epi& E) {
    int tid_ = threadIdx.x; asm volatile("" : "+v"(tid_));
    const int tid = tid_, wid = __builtin_amdgcn_readfirstlane(tid >> 6), lane = tid & 63, wr = wid >> 2, wc = wid & 3, fr = lane & 15, fq = lane >> 4;
    constexpr int K = KD, nt = K / BK; static_assert(KD % 128 == 0 && KD >= 256, "K");
    unsigned voffA[2], voffB[2];
#pragma unroll
    for (int i = 0; i < 2; ++i) { int R, C; stage_rc(tid * 16 + i * 8192, R, C); const int Rb = Epi::PERM ? ((R & ~31) + perm32(R & 31)) : R;
        voffA[i] = (unsigned)(R * K + C) * 2u; voffB[i] = (unsigned)(Rb * K + C) * 2u; }
    const size_t kstep = (size_t)(BK * 2);
    const size_t hstep = (size_t)HALF * K * 2;
    const size_t tstep = 2 * hstep;
    const unsigned ldsw = (unsigned)wid * 1024u;
    const int aoff = lds_byte(wr * 64 + fr, fq * 8), boff = lds_byte(wc * 32 + fr, fq * 8);
#define PG8_SA(b, h) (((b) * 2 + (h)) * HTB)
#define PG8_SB(b, h) ((4 + (b) * 2 + (h)) * HTB)
#define PG8_STAGE(bufoff, gbase, voff) do { _Pragma("unroll") for (int _i = 0; _i < 2; ++_i) \
        __builtin_amdgcn_global_load_lds((const unsigned*)((const char*)(gbase) + (voff)[_i]), (PG8_LAS unsigned*)(lds + (bufoff) + ldsw + _i * 8192), 16, 0, 0); } while (0)
#define PG8_LDA(dst, b, h) do { _Pragma("unroll") for (int m = 0; m < 4; ++m) _Pragma("unroll") for (int k = 0; k < 2; ++k) dst[m][k] = *(const PG8_LAS bf16x8*)(lds + PG8_SA(b, h) + aoff + m * 2048 + k * 1024); } while (0)
#define PG8_LDB(dst, b, h) do { _Pragma("unroll") for (int n = 0; n < 2; ++n) _Pragma("unroll") for (int k = 0; k < 2; ++k) dst[n][k] = *(const PG8_LAS bf16x8*)(lds + PG8_SB(b, h) + boff + n * 2048 + k * 1024); } while (0)
#define PG8_MMA(ai, bj, At, Bt) do { __builtin_amdgcn_s_setprio(1); _Pragma("unroll") for (int m = 0; m < 4; ++m) _Pragma("unroll") for (int n = 0; n < 2; ++n) _Pragma("unroll") for (int k = 0; k < 2; ++k) \
        acc[ai][bj][m][n] = __builtin_amdgcn_mfma_f32_16x16x32_bf16(Bt[n][k], At[m][k], acc[ai][bj][m][n], 0, 0, 0); __builtin_amdgcn_s_setprio(0); } while (0)
#define PG8_WAIT_V(n) asm volatile("s_waitcnt vmcnt(" #n ")" ::: "memory")
#define PG8_WAIT_L(n) asm volatile("s_waitcnt lgkmcnt(" #n ")" ::: "memory")
#define PG8_BAR __builtin_amdgcn_s_barrier()
#define PG8_SCHED __builtin_amdgcn_sched_barrier(0)
    Unit cur, nxt; int ui = 0;
    if (!S.next(0, cur)) return;
    f32x4 acc[2][2][4][2];
#pragma unroll
    for (int a = 0; a < 2; ++a)
#pragma unroll
        for (int b = 0; b < 2; ++b)
#pragma unroll
            for (int m = 0; m < 4; ++m)
#pragma unroll
                for (int n = 0; n < 2; ++n) acc[a][b][m][n] = (f32x4){0.f, 0.f, 0.f, 0.f};
    bf16x8 At[4][2], B0[2][2], B1[2][2];
    const char* cA = (const char*)g.A + (size_t)cur.pm * tstep; const char* cB = (const char*)g.Bt + (size_t)cur.pn * tstep;
    S.a_ready(cur);
    if constexpr (SP2) {
        PG8_STAGE(PG8_SB(0, 0), cB, voffB); PG8_STAGE(PG8_SB(0, 1), cB + hstep, voffB); PG8_STAGE(PG8_SA(0, 0), cA, voffA); PG8_STAGE(PG8_SA(0, 1), cA + hstep, voffA);
        if (wr == 1) PG8_BAR;
        PG8_WAIT_V(2); PG8_BAR;
        PG8_STAGE(PG8_SB(1, 0), cB + kstep, voffB); PG8_STAGE(PG8_SA(1, 0), cA + kstep, voffA); PG8_STAGE(PG8_SB(1, 1), cB + hstep + kstep, voffB);
        PG8_WAIT_V(6); PG8_BAR;
    } else {
        PG8_STAGE(PG8_SB(0, 0), cB, voffB); PG8_STAGE(PG8_SA(0, 0), cA, voffA); PG8_STAGE(PG8_SB(0, 1), cB + hstep, voffB); PG8_STAGE(PG8_SA(0, 1), cA + hstep, voffA);
        if (wr == 1) PG8_BAR;
        PG8_WAIT_V(4); PG8_BAR;
        PG8_STAGE(PG8_SB(1, 0), cB + kstep, voffB); PG8_STAGE(PG8_SA(1, 0), cA + kstep, voffA); PG8_STAGE(PG8_SB(1, 1), cB + hstep + kstep, voffB);
        PG8_WAIT_V(6); PG8_BAR;
    }
    for (;;) {
        const bool has_next = S.next(ui + 1, nxt);
        const char* nA = has_next ? (const char*)g.A + (size_t)nxt.pm * tstep : cA; const char* nB = has_next ? (const char*)g.Bt + (size_t)nxt.pn * tstep : cB;
        for (int t = 0; t < nt; t += 2) {
            const bool last = (t == nt - 2);
            const char* a1 = cA + (size_t)(t + 1) * kstep;
            const char* a2 = last ? nA : cA + (size_t)(t + 2) * kstep; const char* b2 = last ? nB : cB + (size_t)(t + 2) * kstep;
            const char* a3 = a2 + kstep; const char* b3 = b2 + kstep;
            if (last && has_next) S.a_ready(nxt);
            if constexpr (SP2) {
            PG8_LDB(B0, 0, 0); PG8_LDB(B1, 0, 1); PG8_SCHED; PG8_LDA(At, 0, 0); PG8_STAGE(PG8_SA(1, 1), a1 + hstep, voffA);
            PG8_WAIT_V(8); PG8_WAIT_L(0); PG8_BAR; PG8_MMA(0, 0, At, B0); PG8_MMA(0, 1, At, B1); PG8_BAR; PG8_SCHED;
            PG8_LDA(At, 0, 1); PG8_STAGE(PG8_SB(0, 0), b2, voffB); PG8_STAGE(PG8_SB(0, 1), b2 + hstep, voffB); PG8_STAGE(PG8_SA(0, 0), a2, voffA);
            PG8_WAIT_V(8); PG8_WAIT_L(0); PG8_BAR; PG8_MMA(1, 0, At, B0); PG8_MMA(1, 1, At, B1); PG8_BAR; PG8_SCHED;
            PG8_LDB(B0, 1, 0); PG8_LDB(B1, 1, 1); PG8_SCHED; PG8_LDA(At, 1, 0); PG8_STAGE(PG8_SA(0, 1), a2 + hstep, voffA);
            PG8_WAIT_V(8); PG8_WAIT_L(0); PG8_BAR; PG8_MMA(0, 0, At, B0); PG8_MMA(0, 1, At, B1); PG8_BAR; PG8_SCHED;
            PG8_LDA(At, 1, 1); PG8_STAGE(PG8_SB(1, 0), b3, voffB); PG8_STAGE(PG8_SB(1, 1), b3 + hstep, voffB); PG8_STAGE(PG8_SA(1, 0), a3, voffA);
            PG8_WAIT_V(8); PG8_WAIT_L(0); PG8_BAR; PG8_MMA(1, 0, At, B0); PG8_MMA(1, 1, At, B1); PG8_BAR; PG8_SCHED;
            } else {
            PG8_LDB(B0, 0, 0); PG8_SCHED; PG8_LDA(At, 0, 0); PG8_STAGE(PG8_SA(1, 1), a1 + hstep, voffA);
            PG8_WAIT_L(8); PG8_BAR; PG8_WAIT_L(0); PG8_MMA(0, 0, At, B0); PG8_BAR; PG8_SCHED;
            PG8_LDB(B1, 0, 1); PG8_STAGE(PG8_SB(0, 0), b2, voffB);
            PG8_BAR; PG8_WAIT_L(0); PG8_MMA(0, 1, At, B1); PG8_BAR;
            PG8_LDA(At, 0, 1); PG8_STAGE(PG8_SA(0, 0), a2, voffA);
            PG8_BAR; PG8_WAIT_L(0); PG8_MMA(1, 0, At, B0); PG8_BAR; PG8_SCHED;
            PG8_STAGE(PG8_SB(0, 1), b2 + hstep, voffB);
            PG8_WAIT_V(6); PG8_BAR; PG8_MMA(1, 1, At, B1); PG8_BAR;
            PG8_LDB(B0, 1, 0); PG8_SCHED; PG8_LDA(At, 1, 0); PG8_STAGE(PG8_SA(0, 1), a2 + hstep, voffA);
            PG8_WAIT_L(8); PG8_BAR; PG8_WAIT_L(0); PG8_MMA(0, 0, At, B0); PG8_BAR; PG8_SCHED;
            PG8_LDB(B1, 1, 1); PG8_STAGE(PG8_SB(1, 0), b3, voffB);
            PG8_BAR; PG8_WAIT_L(0); PG8_MMA(0, 1, At, B1); PG8_BAR;
            PG8_LDA(At, 1, 1); PG8_STAGE(PG8_SA(1, 0), a3, voffA);
            PG8_BAR; PG8_WAIT_L(0); PG8_MMA(1, 0, At, B0); PG8_BAR; PG8_SCHED;
            PG8_STAGE(PG8_SB(1, 1), b3 + hstep, voffB);
            PG8_WAIT_V(6); PG8_BAR; PG8_MMA(1, 1, At, B1); PG8_BAR;
            }
        }
        if constexpr (ALIGN_EPI) { if (wr == 0) PG8_BAR; }
        if constexpr (!Epi::AFTER_DRAIN) { E(acc, cur, wr, wc, fr, fq); S.done(cur); }
        if (!has_next) break;
#pragma unroll
        for (int a = 0; a < 2; ++a)
#pragma unroll
            for (int b = 0; b < 2; ++b)
#pragma unroll
                for (int m = 0; m < 4; ++m)
#pragma unroll
                    for (int n = 0; n < 2; ++n) acc[a][b][m][n] = (f32x4){0.f, 0.f, 0.f, 0.f};
        cur = nxt; cA = nA; cB = nB; ++ui;
        if constexpr (ALIGN_EPI) { if (wr == 1) PG8_BAR; }
    }
    PG8_WAIT_V(0);
    if constexpr (!ALIGN_EPI) { if (wr == 0) PG8_BAR; }
    PG8_BAR;
    if constexpr (Epi::AFTER_DRAIN) { E.fused(acc, cur, wr, wc, fr, fq, lds, wid, lane); S.done(cur); }
#undef PG8_SA
#undef PG8_SB
#undef PG8_STAGE
#undef PG8_LDA
#undef PG8_LDB
#undef PG8_MMA
#undef PG8_WAIT_V
#undef PG8_WAIT_L
#undef PG8_BAR
#undef PG8_SCHED
}
}

#ifndef MK_ONE_LAUNCH
#define MK_ONE_LAUNCH 1
#endif
constexpr int NWAVES = 8, NTHR = 512;
constexpr int DM = 4096, SEQ = 4096, MROWS = 8192, DFF = 11008, NQKV = 5120;
constexpr int TC = 64, NCHUNK = 64;
constexpr float LN_EPS = 1e-5f;
constexpr int N_PHASES = 3 + 8 * 4;

#define GAS __attribute__((address_space(1)))
#define LAS __attribute__((address_space(3)))
typedef unsigned short bf16;
typedef float f32x4 __attribute__((ext_vector_type(4)));
typedef unsigned u32x4 __attribute__((ext_vector_type(4)));
typedef unsigned u32x2 __attribute__((ext_vector_type(2)));
typedef short bf16x8 __attribute__((ext_vector_type(8)));

constexpr size_t MiB = 1u << 20;
constexpr size_t alignup(size_t x) { return (x + MiB - 1) & ~(MiB - 1); }
constexpr size_t WS_CTL = 0, CTL_BYTES = 1 * MiB;
constexpr size_t WS_MODP = 1 * MiB,                    SZ_MODP = 64ull * 2 * 24576 * 4;
constexpr size_t WS_MODSL = alignup(WS_MODP + SZ_MODP), SZ_MODSL = 4ull * 2 * 6 * 4096 * 4;
constexpr size_t WS_ABAR = alignup(WS_MODSL + SZ_MODSL), SZ_ABAR = 2ull * 256 * 2 * 64 * 4;
constexpr size_t WS_ABART = alignup(WS_ABAR + SZ_ABAR);
constexpr size_t WS_BBAR = alignup(WS_ABART + SZ_ABAR), SZ_BBAR = 2ull * 256 * 8 * 64 * 16;
constexpr size_t WS_E = alignup(WS_BBAR + SZ_BBAR),     SZ_E = 2ull * 64 * 256 * 2 * 64 * 4;
constexpr size_t SZ_WIN = 22016ull * 4096 * 2, SZ_WDN = 4096ull * 11008 * 2, SZ_WGLU = 8192ull * 4096 * 2, SZ_WQKV = 5120ull * 4096 * 2, SZ_WO = 4096ull * 4096 * 2;
constexpr size_t WS_SP = alignup(WS_E + SZ_E);
constexpr size_t WS_WIN = alignup(WS_SP + SZ_E);
constexpr size_t WS_WDN = alignup(WS_WIN + 4 * SZ_WIN);
constexpr size_t WS_WGLU = alignup(WS_WDN + 4 * SZ_WDN);
constexpr size_t WS_WQKV = alignup(WS_WGLU + 2 * SZ_WGLU);
constexpr size_t WS_WO = alignup(WS_WQKV + 2 * SZ_WQKV);
constexpr size_t WS_H = alignup(WS_WO + 2 * SZ_WO),    SZ_H = 8192ull * 4096 * 2;
constexpr size_t WS_ACT = alignup(WS_H + SZ_H),        SZ_ACT = 8192ull * 11008 * 2;
constexpr size_t WS_Z = alignup(WS_ACT + SZ_ACT),      SZ_Z = 8192ull * 4096 * 4;
constexpr size_t WS_X = alignup(WS_Z + SZ_Z);
constexpr size_t WS_X2 = alignup(WS_X + SZ_Z);
constexpr size_t WS_QKV = alignup(WS_X2 + SZ_Z),        SZ_QKV = 8192ull * 5120 * 2;
constexpr size_t WS_O = alignup(WS_QKV + SZ_QKV);
constexpr size_t WS_U = alignup(WS_O + SZ_H);
constexpr size_t WS_END = alignup(WS_U + SZ_H);
constexpr int CW_BAR = 4096;

constexpr int RING_BYTES = 131072, LDSCTL_OFF = RING_BYTES, MISC_OFF = LDSCTL_OFF + 320, LDS_BYTES = 147456;

__device__ __forceinline__ unsigned pk2(float lo, float hi) { return pg8::cvt_pk_bf16(lo, hi); }
__device__ __forceinline__ float bf_lo(unsigned w) { return __uint_as_float(w << 16); }
__device__ __forceinline__ float bf_hi(unsigned w) { return __uint_as_float(w & 0xffff0000u); }
__device__ __forceinline__ float wave_sum(float v) {
#pragma unroll
    for (int o = 1; o < 64; o <<= 1) v += __shfl_xor(v, o);
    return v;
}

#define XB_TMO      128
#define XB_XCNT(j)  (256  + 64 * (j))
#define XB_XSUB(j)  (1280 + 64 * (j))
#define XB_XGEN(j)  (2304 + 64 * (j))
#define XB_TOP      3328
#define XB_TOPGEN   3392
#define XCD_BAR_WORDS 3456
#define XB_SPIN_CAP (1u << 20)

__device__ __forceinline__ unsigned xb_ld(unsigned* p)              { return __hip_atomic_load(p, __ATOMIC_RELAXED, __HIP_MEMORY_SCOPE_AGENT); }
__device__ __forceinline__ unsigned xb_add(unsigned* p, unsigned v) { return __hip_atomic_fetch_add(p, v, __ATOMIC_RELAXED, __HIP_MEMORY_SCOPE_AGENT); }
__device__ __forceinline__ unsigned xb_xcc_id() { return (unsigned)__builtin_amdgcn_s_getreg((3 << 11) | 20) & 0xFu; }
#define XB_SPIN(cond, bar) do { unsigned _sp = 0; while (cond) { __builtin_amdgcn_s_sleep(1); \
    if ((++_sp & 255u) == 0u) { if (xb_ld(&(bar)[XB_TMO])) break; if (_sp > XB_SPIN_CAP) { atomicAdd(&(bar)[XB_TMO], 1u); break; } } } } while (0)

struct XcdBarrier { unsigned* bar; unsigned x; volatile LAS unsigned* st; };
__device__ __forceinline__ XcdBarrier xcd_barrier_post(unsigned* bar, volatile LAS unsigned* st) {
    XcdBarrier b; b.bar = bar; b.x = xb_xcc_id(); b.st = st;
    if (threadIdx.x == 0) (void)xb_add(&bar[XB_XCNT(b.x)], 1u);
    return b;
}
__device__ __forceinline__ void xcd_barrier_complete(unsigned* bar, unsigned x, unsigned& nloc, unsigned& nx) {
    const unsigned G = gridDim.x * gridDim.y * gridDim.z;
    unsigned sum, cnt, mine, sp = 0u;
    for (;;) {
        sum = 0u; cnt = 0u; mine = 0u;
#pragma unroll
        for (unsigned j = 0; j < 16; ++j) { const unsigned c = xb_ld(&bar[XB_XCNT(j)]); sum += c; cnt += (c > 0u) ? 1u : 0u; mine = (j == x) ? c : mine; }
        if (sum == G) break;
        __builtin_amdgcn_s_sleep(1);
        if ((++sp & 255u) == 0u) { if (xb_ld(&bar[XB_TMO])) break; if (sp > XB_SPIN_CAP) { atomicAdd(&bar[XB_TMO], 1u); break; } }
    }
    nloc = mine > 0u ? mine : 1u; nx = cnt > 0u ? cnt : 1u;
}
__device__ __forceinline__ void xcd_barrier(const XcdBarrier& b) {
    asm volatile("s_waitcnt vmcnt(0)" ::: "memory");
    __syncthreads();
    if (threadIdx.x == 0) {
        unsigned* bar = b.bar;
        __builtin_amdgcn_s_waitcnt(0);
        unsigned nloc = b.st[0], nx = b.st[1];
        if (nloc == 0u) { xcd_barrier_complete(bar, b.x, nloc, nx); b.st[0] = nloc; b.st[1] = nx; }
        const unsigned old = xb_add(&bar[XB_XSUB(b.x)], 1u);
        const unsigned gen = old / nloc;
        if (old + 1u == (gen + 1u) * nloc) {
            __builtin_amdgcn_fence(__ATOMIC_RELEASE, "agent");
            asm volatile("s_waitcnt vmcnt(0)" ::: "memory");
            const unsigned og = xb_add(&bar[XB_TOP], 1u);
            const unsigned tg = og / nx;
            if (og + 1u == (tg + 1u) * nx) xb_add(&bar[XB_TOPGEN], 1u);
            else XB_SPIN(xb_ld(&bar[XB_TOPGEN]) == tg, bar);
            __builtin_amdgcn_fence(__ATOMIC_ACQUIRE, "agent");
            xb_add(&bar[XB_XGEN(b.x)], 1u);
            asm volatile("s_waitcnt vmcnt(0)" ::: "memory");
        } else {
            XB_SPIN(xb_ld(&bar[XB_XGEN(b.x)]) == gen, bar);
            __builtin_amdgcn_fence(__ATOMIC_ACQUIRE, "agent");
            asm volatile("s_waitcnt vmcnt(0)" ::: "memory");
        }
    }
    __syncthreads();
}

__device__ const unsigned char kBucket[128] = {0, 1, 2, 3, 4, 5, 6, 7, 8, 9, 10, 11, 12, 13, 14, 15, 16, 16, 16, 17, 17, 18, 18, 18, 19, 19, 19, 20, 20, 20, 20, 21, 21, 21, 21, 22, 22, 22, 22, 22, 23, 23, 23, 23, 23, 23,
    24, 24, 24, 24, 24, 24, 25, 25, 25, 25, 25, 25, 25, 26, 26, 26, 26, 26, 26, 26, 26, 27, 27, 27, 27, 27, 27, 27, 27, 27, 27, 28, 28, 28, 28, 28, 28, 28, 28, 28, 28, 29, 29, 29, 29, 29, 29, 29, 29, 29, 29, 29, 29,
    30, 30, 30, 30, 30, 30, 30, 30, 30, 30, 30, 30, 30, 30, 31, 31, 31, 31, 31, 31, 31, 31, 31, 31, 31, 31, 31, 31, 31};

__device__ __forceinline__ void p0_transpose_item(const float* W, int K, int N, int ldw, bf16* WT, int mode, LAS float* scr, int item, int lane) {
    const int nblk = N / 32, kb = item / nblk, nb = item % nblk, k0 = 64 * kb, n0 = 32 * nb;
    const int r0 = mode == 0 ? n0 : (256 * (n0 >> 7) + 128 * (mode - 1) + (n0 & 127));
    f32x4 v[8];
#pragma unroll
    for (int i = 0; i < 8; ++i) v[i] = __builtin_nontemporal_load((const f32x4*)(W + (size_t)(k0 + 8 * i + (lane >> 3)) * ldw + n0 + 4 * (lane & 7)));
#pragma unroll
    for (int i = 0; i < 8; ++i) { LAS float* d = scr + (8 * i + (lane >> 3)) * 33 + 4 * (lane & 7); d[0] = v[i][0]; d[1] = v[i][1]; d[2] = v[i][2]; d[3] = v[i][3]; }
    asm volatile("s_waitcnt lgkmcnt(0)" ::: "memory");
    const int c = lane & 7;
#pragma unroll
    for (int j = 0; j < 4; ++j) { const int n = (lane >> 3) + 8 * j; const LAS float* s = scr + (8 * c) * 33 + n;
        u32x4 o; o.x = pk2(s[0 * 33], s[1 * 33]); o.y = pk2(s[2 * 33], s[3 * 33]); o.z = pk2(s[4 * 33], s[5 * 33]); o.w = pk2(s[6 * 33], s[7 * 33]);
        __builtin_nontemporal_store(o, (u32x4*)(WT + (size_t)(r0 + n) * K + k0 + 8 * c)); }
    asm volatile("s_waitcnt lgkmcnt(0)" ::: "memory");
}

template <int I> __device__ __forceinline__ const float* in_ptr() {
    unsigned long long v; const unsigned long long kav = (unsigned long long)__builtin_amdgcn_kernarg_segment_ptr();
    const unsigned ka_lo = __builtin_amdgcn_readfirstlane((unsigned)kav), ka_hi = __builtin_amdgcn_readfirstlane((unsigned)(kav >> 32));
    const unsigned long long ka = ((unsigned long long)ka_hi << 32) | ka_lo;
    asm volatile("s_load_dwordx2 %0, %1, %2\n\ts_waitcnt lgkmcnt(0)" : "=s"(v) : "s"(ka), "n"(I * 8));
    return (const float*)(const GAS float*)v;
}
__device__ __forceinline__ unsigned char* ws_ptr() { return (unsigned char*)in_ptr<25>(); }
__device__ __forceinline__ float* out_ptr() { return (float*)in_ptr<24>(); }
#define PHASE_IDS() int tid_ = threadIdx.x; asm volatile("" : "+v"(tid_)); const int tid = tid_, lane = tid & 63, wave = __builtin_amdgcn_readfirstlane(tid >> 6); (void)lane; (void)wave; unsigned char* const ws = ws_ptr(); (void)ws
constexpr int XP_IT_A = 64 * 344, XP_IT_SQ = 64 * 128, XP_IT_QKV = 64 * 160, XP_PER_L = 3 * XP_IT_A, XP_PER_J = 3 * XP_IT_SQ + XP_IT_QKV;
static_assert((11008 / 64) * (4096 / 32) == XP_IT_A, "w_down items");
constexpr int XG_MIX0 = 0, XG_FFN0 = XG_MIX0 + XP_PER_J, XG_FFN1 = XG_FFN0 + XP_PER_L, XG_GLU1 = XG_FFN1 + XP_PER_L, XG_FFN2 = XG_GLU1 + 2 * XP_IT_SQ, XG_QKVO1 = XG_FFN2 + XP_PER_L,
              XG_FFN3 = XG_QKVO1 + XP_IT_QKV + XP_IT_SQ, XG_END = XG_FFN3 + XP_PER_L;
static_assert(XG_FFN0 == 34816 && XG_FFN1 == 100864 && XG_GLU1 == 166912 && XG_FFN2 == 183296 && XG_QKVO1 == 249344 && XG_FFN3 == 267776 && XG_END == 333824, "conversion list");
constexpr int XS_P0A_LO = 0, XS_P0A_HI = XG_FFN0;
constexpr int XS_L0S1_LO = XG_FFN0, XS_L0S1_HI = XG_FFN0 + XP_PER_L / 2, XS_L0S3_LO = XS_L0S1_HI, XS_L0S3_HI = XG_FFN1;
constexpr int XS_T0_LO = XG_FFN1, XS_T0_HI = XG_FFN1 + 16384;
constexpr int XS_T1Q_LO = XS_T0_HI, XS_T1Q_HI = XS_T0_HI + 32768;
constexpr int XS_X = 8448;
constexpr int XS_L0S1X_LO = XS_T1Q_HI, XS_L0S3X_LO = XS_T1Q_HI + XS_X;
constexpr int XS_P0B_LO = XS_T1Q_HI + 2 * XS_X, XS_P0B_HI = XG_GLU1;
constexpr int XS_T1_LO = XG_GLU1, XS_T1_HI = XG_FFN2;
constexpr int XS_L2S1_LO = XG_FFN2, XS_L2S1_HI = XG_FFN2 + XP_PER_L / 2, XS_L2S3_LO = XS_L2S1_HI, XS_L2S3_HI = XG_QKVO1;
constexpr int XS_T2_LO = XG_QKVO1, XS_T2_HI = XG_QKVO1 + 16384;
constexpr int XS_T3Q_LO = XS_T2_HI, XS_T3Q_HI = XS_T2_HI + 32768;
constexpr int XS_L2S1X_LO = XS_T3Q_HI, XS_L2S3X_LO = XS_T3Q_HI + XS_X;
constexpr int XS_P0C_LO = XS_T3Q_HI + 2 * XS_X, XS_P0C_HI = XG_END;
static_assert(XS_P0B_LO <= XS_P0B_HI && XS_P0C_LO <= XS_P0C_HI && XS_T1Q_HI < XG_GLU1 && XS_T2_HI > XG_QKVO1 + XP_IT_QKV && XS_T2_HI < XG_FFN3 && XS_T3Q_HI < XG_END, "conversion deal");
__device__ __forceinline__ void xpose_global_item(int idx, LAS float* scr, int lane) {
    unsigned char* const ws = ws_ptr();
    const float* W; bf16* WT; int K = 4096, N = 4096, ldw = 4096, mode = 0, r;
    const bool mix = idx < XG_FFN0 || (idx >= XG_GLU1 && idx < XG_FFN2) || (idx >= XG_QKVO1 && idx < XG_FFN3);
    if (!mix) {
        int l, base;
        if (idx < XG_FFN1) { l = 0; base = XG_FFN0; } else if (idx < XG_GLU1) { l = 1; base = XG_FFN1; } else if (idx < XG_QKVO1) { l = 2; base = XG_FFN2; } else { l = 3; base = XG_FFN3; }
        r = idx - base; const int which = r / XP_IT_A; r -= which * XP_IT_A;
        if (which < 2) { W = in_ptr<7>() + (size_t)l * 4096 * 22016 + which * 11008; N = 11008; ldw = 22016; WT = (bf16*)(ws + WS_WIN + l * SZ_WIN); mode = 1 + which; }
        else { W = in_ptr<8>() + (size_t)l * 11008 * 4096; K = 11008; WT = (bf16*)(ws + WS_WDN + l * SZ_WDN); }
    } else {
        int j;
        if (idx < XG_FFN0) { j = 0; r = idx; } else if (idx < XG_FFN2) { j = 1; r = idx - XG_GLU1; } else { j = 1; r = idx - XG_QKVO1 + 2 * XP_IT_SQ; }
        if (r < XP_IT_SQ) { W = in_ptr<22>() + (size_t)j * 4096 * 4096; WT = (bf16*)(ws + WS_WGLU + j * SZ_WGLU); mode = 1; }
        else if (r < 2 * XP_IT_SQ) { W = in_ptr<23>() + (size_t)j * 4096 * 4096; WT = (bf16*)(ws + WS_WGLU + j * SZ_WGLU); mode = 2; r -= XP_IT_SQ; }
        else if (r < 2 * XP_IT_SQ + XP_IT_QKV) { W = in_ptr<9>() + (size_t)j * 4096 * 5120; N = 5120; ldw = 5120; WT = (bf16*)(ws + WS_WQKV + j * SZ_WQKV); r -= 2 * XP_IT_SQ; }
        else { W = in_ptr<11>() + (size_t)j * 4096 * 4096; WT = (bf16*)(ws + WS_WO + j * SZ_WO); r -= 2 * XP_IT_SQ + XP_IT_QKV; }
    }
    p0_transpose_item(W, K, N, ldw, WT, mode, scr, r, lane);
}
__device__ __forceinline__ void host_tail(LAS unsigned char* lds, int nunits, int lo, int hi) {
    PHASE_IDS();
    const int first = nunits % (int)gridDim.x;
    if ((int)blockIdx.x < first) return;
    const int nw = ((int)gridDim.x - first) * NWAVES, w = ((int)blockIdx.x - first) * NWAVES + wave;
    LAS float* scr = (LAS float*)(lds + wave * 16384);
    for (int it = lo + w; it < hi; it += nw) xpose_global_item(it, scr, lane);
}

__device__ __forceinline__ void phase0(LAS unsigned char* lds) {
    PHASE_IDS();
    const int gw = blockIdx.x * NWAVES + wave, ngw = gridDim.x * NWAVES, gtid = blockIdx.x * NTHR + tid, gthr = gridDim.x * NTHR;
    {
        LAS float* sc = (LAS float*)lds;
        const float* c = in_ptr<1>();
        for (int i = tid; i < 2 * 4096; i += NTHR) { const float v = c[i]; sc[i] = v / (1.0f + expf(-v)); }
        __syncthreads();
        const float* w_ada = in_ptr<2>(); float* modp = (float*)(ws + WS_MODP);
        for (int it = gw; it < 96 * 64; it += ngw) {
            const int cb = it % 96, ks = it / 96;
            const float* wp = w_ada + (size_t)(ks * 64) * 24576 + cb * 256 + lane * 4;
            f32x4 a0 = {0.f, 0.f, 0.f, 0.f}, a1 = {0.f, 0.f, 0.f, 0.f};
#pragma unroll 8
            for (int k = 0; k < 64; ++k) { const f32x4 w = __builtin_nontemporal_load((const f32x4*)(wp + (size_t)k * 24576)); const float s0 = sc[ks * 64 + k], s1 = sc[4096 + ks * 64 + k]; a0 += s0 * w; a1 += s1 * w; }
            *(f32x4*)(modp + ((size_t)ks * 2 + 0) * 24576 + cb * 256 + lane * 4) = a0;
            *(f32x4*)(modp + ((size_t)ks * 2 + 1) * 24576 + cb * 256 + lane * 4) = a1;
        }
        __syncthreads();
    }
    {
        const float* a_re = in_ptr<14>(); const float* a_im = in_ptr<15>(); const float* log_dt = in_ptr<16>(); const float* b_re = in_ptr<17>(); const float* b_im = in_ptr<18>();
        float* ABAR = (float*)(ws + WS_ABAR); float* ABART = (float*)(ws + WS_ABART); u32x4* BFRAG = (u32x4*)(ws + WS_BBAR);
        for (int i = gtid; i < 2 * 256 * 64; i += gthr) {
            const int p = i & 63, jg = i >> 6;
            const float are = a_re[i], aim = a_im[i], dt = expf(log_dt[jg]);
            const float mag = expf(are * dt), ang = aim * dt;
            const float abr = mag * cosf(ang), abi = mag * sinf(ang);
            const float den = are * are + aim * aim, nr = abr - 1.0f;
            const float kre = (nr * are + abi * aim) / den, kim = (abi * are - nr * aim) / den;
            ABAR[(jg * 2 + 0) * 64 + p] = abr; ABAR[(jg * 2 + 1) * 64 + p] = abi;
            float tr = abr, ti = abi;
#pragma unroll
            for (int q = 0; q < 6; ++q) { const float n2 = tr * tr - ti * ti, i2 = 2.0f * tr * ti; tr = n2; ti = i2; }
            ABART[(jg * 2 + 0) * 64 + p] = tr; ABART[(jg * 2 + 1) * 64 + p] = ti;
            const f32x4* br = (const f32x4*)(b_re + (size_t)i * 16); const f32x4* bi = (const f32x4*)(b_im + (size_t)i * 16);
            float vr[16], vi[16];
#pragma unroll
            for (int q = 0; q < 4; ++q) { const f32x4 r = br[q], m = bi[q];
#pragma unroll
                for (int e = 0; e < 4; ++e) { vr[q * 4 + e] = kre * r[e] - kim * m[e]; vi[q * 4 + e] = kre * m[e] + kim * r[e]; } }
            u32x4* fr_re = BFRAG + ((size_t)jg * 8 + (p >> 4)) * 64 + (p & 15); u32x4* fr_im = fr_re + 4 * 64;
#pragma unroll
            for (int q = 0; q < 2; ++q) { u32x4 w; w.x = pk2(vr[8 * q + 0], vr[8 * q + 1]); w.y = pk2(vr[8 * q + 2], vr[8 * q + 3]); w.z = pk2(vr[8 * q + 4], vr[8 * q + 5]); w.w = pk2(vr[8 * q + 6], vr[8 * q + 7]); fr_re[16 * q] = w;
                w.x = pk2(vi[8 * q + 0], vi[8 * q + 1]); w.y = pk2(vi[8 * q + 2], vi[8 * q + 3]); w.z = pk2(vi[8 * q + 4], vi[8 * q + 5]); w.w = pk2(vi[8 * q + 6], vi[8 * q + 7]); fr_im[16 * q] = w; }
            const u32x4 z4 = {0u, 0u, 0u, 0u}; fr_re[32] = z4; fr_re[48] = z4; fr_im[32] = z4; fr_im[48] = z4;
        }
    }
    {
        LAS float* scr = (LAS float*)(lds + wave * 16384);
        constexpr int NA = XS_P0A_HI - XS_P0A_LO, NB = XS_P0B_HI - XS_P0B_LO, NC = XS_P0C_HI - XS_P0C_LO;
        for (int it = gw; it < NA + NB + NC; it += ngw) {
            const int idx = it < NA ? XS_P0A_LO + it : (it < NA + NB ? XS_P0B_LO + (it - NA) : XS_P0C_LO + (it - NA - NB));
            xpose_global_item(idx, scr, lane);
        }
    }
}

__device__ __forceinline__ void phase1() {
    PHASE_IDS();
    const int gtid = blockIdx.x * NTHR + tid, gthr = gridDim.x * NTHR;
    const float* modp = (const float*)(ws + WS_MODP); const float* b_ada = in_ptr<3>(); const float* tab = in_ptr<4>(); float* modsl = (float*)(ws + WS_MODSL);
    for (int i = gtid; i < 2 * 24576; i += gthr) {
        const int b = i / 24576, n = i % 24576; float s = b_ada[n];
        for (int ks = 0; ks < 64; ++ks) s += modp[((size_t)ks * 2 + b) * 24576 + n];
#pragma unroll
        for (int l = 0; l < 4; ++l) modsl[((size_t)(l * 2 + b) * 6) * 4096 + n] = s + tab[(size_t)l * 24576 + n];
    }
}
__device__ __forceinline__ void phase_modulate(const float* x, const float* mods, int jh, int js, bf16* H) {
    PHASE_IDS();
    const int gtid = blockIdx.x * NTHR + tid, gthr = gridDim.x * NTHR;
    for (int i = gtid; i < MROWS * 1024; i += gthr) {
        const int row = i >> 10, c4 = (i & 1023) * 4, b = row >> 12;
        const f32x4 xv = __builtin_nontemporal_load((const f32x4*)(x + (size_t)row * 4096 + c4));
        const f32x4 sc = *(const f32x4*)(mods + (size_t)(b * 6 + js) * 4096 + c4), sh = *(const f32x4*)(mods + (size_t)(b * 6 + jh) * 4096 + c4);
        const f32x4 h = xv * (1.0f + sc) + sh;
        u32x2 w; w.x = pk2(h[0], h[1]); w.y = pk2(h[2], h[3]);
        *(u32x2*)(H + (size_t)row * 4096 + c4) = w;
    }
}
#define LN_ROW_STATS(va, vb, mean, rstd) do { float s_ = 0.f; \
    _Pragma("unroll") for (int i = 0; i < 8; ++i) s_ += ((va[i][0] + va[i][1]) + (va[i][2] + va[i][3])) + ((vb[i][0] + vb[i][1]) + (vb[i][2] + vb[i][3])); \
    mean = wave_sum(s_) * (1.0f / 4096.0f); float s2_ = 0.f; \
    _Pragma("unroll") for (int i = 0; i < 8; ++i) { va[i] = va[i] - mean; vb[i] = vb[i] - mean; \
        s2_ += ((va[i][0] * va[i][0] + va[i][1] * va[i][1]) + (va[i][2] * va[i][2] + va[i][3] * va[i][3])) + ((vb[i][0] * vb[i][0] + vb[i][1] * vb[i][1]) + (vb[i][2] * vb[i][2] + vb[i][3] * vb[i][3])); } \
    rstd = 1.0f / sqrtf(wave_sum(s2_) * (1.0f / 4096.0f) + LN_EPS); } while (0)
#define LN_LOAD_Z(va, vb, xr, xhs, yr) do { _Pragma("unroll") for (int i = 0; i < 8; ++i) { \
    const f32x4 xa = __builtin_nontemporal_load((const f32x4*)(xr + 512 * i)), xb = __builtin_nontemporal_load((const f32x4*)(xr + 512 * i + xhs)); const u32x4 yw = __builtin_nontemporal_load((const u32x4*)(yr + 512 * i)); \
    va[i][0] = pg8::ALPHA_RES * xa[0] + bf_lo(yw.x); va[i][1] = pg8::ALPHA_RES * xa[1] + bf_hi(yw.x); va[i][2] = pg8::ALPHA_RES * xa[2] + bf_lo(yw.y); va[i][3] = pg8::ALPHA_RES * xa[3] + bf_hi(yw.y); \
    vb[i][0] = pg8::ALPHA_RES * xb[0] + bf_lo(yw.z); vb[i][1] = pg8::ALPHA_RES * xb[1] + bf_hi(yw.z); vb[i][2] = pg8::ALPHA_RES * xb[2] + bf_lo(yw.w); vb[i][3] = pg8::ALPHA_RES * xb[3] + bf_hi(yw.w); } } while (0)
__device__ __forceinline__ void phase_ln1(const float* Xin, bool xin_perm, const bf16* Y1, const float* g, const float* beta, const float* mods, bf16* H) {
    PHASE_IDS();
    const int gw = blockIdx.x * NWAVES + wave, ngw = gridDim.x * NWAVES;
    for (int row = gw; row < MROWS; row += ngw) {
        const int b = row >> 12;
        const int xhs = xin_perm ? 256 : 4; const float* xr = Xin + (size_t)row * 4096 + lane * (xin_perm ? 4 : 8); const bf16* yr = Y1 + (size_t)row * 4096 + lane * 8;
        f32x4 va[8], vb[8]; float mean, rstd;
        LN_LOAD_Z(va, vb, xr, xhs, yr);
        LN_ROW_STATS(va, vb, mean, rstd);
        const float* gp = g + lane * 8; const float* bp = beta + lane * 8;
        const float* scp = mods + (size_t)(b * 6 + 4) * 4096 + lane * 8; const float* shp = mods + (size_t)(b * 6 + 3) * 4096 + lane * 8;
#pragma unroll
        for (int i = 0; i < 8; ++i) {
            const f32x4 xna = va[i] * rstd * *(const f32x4*)(gp + 512 * i) + *(const f32x4*)(bp + 512 * i), xnb = vb[i] * rstd * *(const f32x4*)(gp + 512 * i + 4) + *(const f32x4*)(bp + 512 * i + 4);
            const f32x4 ha = xna * (1.0f + *(const f32x4*)(scp + 512 * i)) + *(const f32x4*)(shp + 512 * i), hb = xnb * (1.0f + *(const f32x4*)(scp + 512 * i + 4)) + *(const f32x4*)(shp + 512 * i + 4);
            u32x4 w; w.x = pk2(ha[0], ha[1]); w.y = pk2(ha[2], ha[3]); w.z = pk2(hb[0], hb[1]); w.w = pk2(hb[2], hb[3]);
            *(u32x4*)(H + (size_t)row * 4096 + lane * 8 + 512 * i) = w;
        }
    }
}
__device__ __forceinline__ void phase_ln2(const float* Xin, bool xin_perm, bool xout_perm, const bf16* Y1, const bf16* Y2, const float* g1, const float* beta1, const float* g2, const float* beta2, float* Xout, const float* mods, bf16* H) {
    PHASE_IDS();
    const int gw = blockIdx.x * NWAVES + wave, ngw = gridDim.x * NWAVES;
    for (int row = gw; row < MROWS; row += ngw) {
        const int b = row >> 12;
        const int xhs = xin_perm ? 256 : 4; const float* xr = Xin + (size_t)row * 4096 + lane * (xin_perm ? 4 : 8); const bf16* yr = Y1 + (size_t)row * 4096 + lane * 8; const bf16* y2r = Y2 + (size_t)row * 4096 + lane * 8;
        f32x4 va[8], vb[8]; float mean, rstd;
        LN_LOAD_Z(va, vb, xr, xhs, yr);
        u32x4 y2w[8];
#pragma unroll
        for (int i = 0; i < 8; ++i) y2w[i] = __builtin_nontemporal_load((const u32x4*)(y2r + 512 * i));
        LN_ROW_STATS(va, vb, mean, rstd);
        { const float* gp = g1 + lane * 8; const float* bp = beta1 + lane * 8;
#pragma unroll
          for (int i = 0; i < 8; ++i) {
              const f32x4 xna = va[i] * rstd * *(const f32x4*)(gp + 512 * i) + *(const f32x4*)(bp + 512 * i), xnb = vb[i] * rstd * *(const f32x4*)(gp + 512 * i + 4) + *(const f32x4*)(bp + 512 * i + 4);
              const u32x4 yw = y2w[i];
              va[i][0] = pg8::ALPHA_RES * xna[0] + bf_lo(yw.x); va[i][1] = pg8::ALPHA_RES * xna[1] + bf_hi(yw.x); va[i][2] = pg8::ALPHA_RES * xna[2] + bf_lo(yw.y); va[i][3] = pg8::ALPHA_RES * xna[3] + bf_hi(yw.y);
              vb[i][0] = pg8::ALPHA_RES * xnb[0] + bf_lo(yw.z); vb[i][1] = pg8::ALPHA_RES * xnb[1] + bf_hi(yw.z); vb[i][2] = pg8::ALPHA_RES * xnb[2] + bf_lo(yw.w); vb[i][3] = pg8::ALPHA_RES * xnb[3] + bf_hi(yw.w); } }
        LN_ROW_STATS(va, vb, mean, rstd);
        const float* gp = g2 + lane * 8; const float* bp = beta2 + lane * 8;
        const float* scp = mods + (size_t)(b * 6 + 1) * 4096 + lane * 8; const float* shp = mods + (size_t)(b * 6 + 0) * 4096 + lane * 8;
        const int ohs = xout_perm ? 256 : 4; float* xo = Xout + (size_t)row * 4096 + lane * (xout_perm ? 4 : 8);
#pragma unroll
        for (int i = 0; i < 8; ++i) {
            const f32x4 xna = va[i] * rstd * *(const f32x4*)(gp + 512 * i) + *(const f32x4*)(bp + 512 * i), xnb = vb[i] * rstd * *(const f32x4*)(gp + 512 * i + 4) + *(const f32x4*)(bp + 512 * i + 4);
            __builtin_nontemporal_store(xna, (f32x4*)(xo + 512 * i)); __builtin_nontemporal_store(xnb, (f32x4*)(xo + 512 * i + ohs));
            if (H) {
                const f32x4 ha = xna * (1.0f + *(const f32x4*)(scp + 512 * i)) + *(const f32x4*)(shp + 512 * i), hb = xnb * (1.0f + *(const f32x4*)(scp + 512 * i + 4)) + *(const f32x4*)(shp + 512 * i + 4);
                u32x4 w; w.x = pk2(ha[0], ha[1]); w.y = pk2(ha[2], ha[3]); w.z = pk2(hb[0], hb[1]); w.w = pk2(hb[2], hb[3]);
                *(u32x4*)(H + (size_t)row * 4096 + lane * 8 + 512 * i) = w;
            }
        }
    }
}

constexpr int SSM_WLDS = 16384, SSM_ST = 2048, SSM_U = 6400, SSM_USTR = 528;
__device__ __forceinline__ void ssm_load_h(const bf16* H, int b, int k, int g, int lane, u32x4& v0, u32x4& v1) {
    const u32x4* src = (const u32x4*)(H + ((size_t)(b * SEQ + k * TC + lane)) * 4096 + g * 16);
    v0 = src[0]; v1 = src[1];
}
__device__ __forceinline__ void ssm_store_h(LAS unsigned char* hs, int lane, const u32x4& v0, const u32x4& v1) { *(LAS u32x4*)(hs + lane * 32) = v0; *(LAS u32x4*)(hs + lane * 32 + 16) = v1; }
__device__ __forceinline__ void ssm_bproj16(const LAS unsigned char* hs, LAS unsigned char* ut, int tg, const bf16x8 (&bf)[8], int fr, int fq) {
    u32x4 aw = {0u, 0u, 0u, 0u};
    if (fq < 2) aw = *(const LAS u32x4*)(hs + (tg * 16 + fr) * 32 + fq * 16);
    const bf16x8 a = __builtin_bit_cast(bf16x8, aw);
#pragma unroll
    for (int tau = 0; tau < 8; ++tau) { f32x4 acc = {0.f, 0.f, 0.f, 0.f};
        acc = __builtin_amdgcn_mfma_f32_16x16x32_bf16(a, bf[tau], acc, 0, 0, 0);
#pragma unroll
        for (int r = 0; r < 4; ++r) *(LAS float*)(ut + (4 * fq + r) * SSM_USTR + (tau * 16 + fr) * 4) = acc[r]; }
}
__device__ __forceinline__ void ssm_update(const LAS unsigned char* ut, int tt, int lane, float are, float aim, float& sre, float& sim) {
    const float ure = *(const LAS float*)(ut + tt * SSM_USTR + lane * 4), uim = *(const LAS float*)(ut + tt * SSM_USTR + 256 + lane * 4);
    const float nre = are * sre - aim * sim + ure, nim = are * sim + aim * sre + uim;
    sre = nre; sim = nim;
}
__device__ __forceinline__ void phase_ssm_local(int j, LAS unsigned char* lds, int xlo, int xhi, int xlo2, int xn2) {
    PHASE_IDS();
    const bf16* H = (const bf16*)(ws + WS_H); float* E = (float*)(ws + WS_E);
    const float* ABAR = (const float*)(ws + WS_ABAR); const u32x4* BFRAG = (const u32x4*)(ws + WS_BBAR);
    LAS unsigned char* hs = lds + wave * SSM_WLDS; LAS unsigned char* ut = hs + SSM_U;
    const int gw = blockIdx.x * NWAVES + wave, ngw = gridDim.x * NWAVES, fr = lane & 15, fq = lane >> 4;
    const int g = gw & 255, jg = j * 256 + g, bstep = ngw >> 8; constexpr int NBK = 2 * (NCHUNK - 1);
    bf16x8 bf[8];
#pragma unroll
    for (int tau = 0; tau < 8; ++tau) bf[tau] = __builtin_bit_cast(bf16x8, BFRAG[((size_t)jg * 8 + tau) * 64 + lane]);
    const float are = ABAR[(jg * 2 + 0) * 64 + lane], aim = ABAR[(jg * 2 + 1) * 64 + lane];
    u32x4 n0 = {0u, 0u, 0u, 0u}, n1 = {0u, 0u, 0u, 0u};
    int xi = gw, itn = 0; const int xtot = xn2 + (xhi - xlo);
    int bk = (gw < (ngw & ~255)) ? (gw >> 8) : NBK;
    if (bk < NBK) ssm_load_h(H, bk / (NCHUNK - 1), bk % (NCHUNK - 1), g, lane, n0, n1);
    for (; bk < NBK; bk += bstep) {
        const int k = bk % (NCHUNK - 1), b = bk / (NCHUNK - 1);
        ssm_store_h(hs, lane, n0, n1);
        { const int nx = bk + bstep; if (nx < NBK) ssm_load_h(H, nx / (NCHUNK - 1), nx % (NCHUNK - 1), g, lane, n0, n1); }
        float sre = 0.f, sim = 0.f;
        for (int tg = 0; tg < TC / 16; ++tg) {
            ssm_bproj16(hs, ut, tg, bf, fr, fq);
#pragma unroll
            for (int tt = 0; tt < 16; ++tt) ssm_update(ut, tt, lane, are, aim, sre, sim);
        }
        float* e = E + (((size_t)(b * NCHUNK + k) * 256 + g) * 2) * 64 + lane;
        e[0] = sre; e[64] = sim;
        if (xi < xtot) { xpose_global_item(xi < xn2 ? xlo2 + xi : xlo + (xi - xn2), (LAS float*)ut, lane); xi += ngw; }
        if ((itn++ & 3) == 3 && xi < xtot) { xpose_global_item(xi < xn2 ? xlo2 + xi : xlo + (xi - xn2), (LAS float*)ut, lane); xi += ngw; }
    }
    for (; xi < xtot; xi += ngw) xpose_global_item(xi < xn2 ? xlo2 + xi : xlo + (xi - xn2), (LAS float*)ut, lane);
}
__device__ __forceinline__ void phase_ssm_carry(int j) {
    PHASE_IDS();
    const float* E = (const float*)(ws + WS_E); float* SP = (float*)(ws + WS_SP); const float* ABART = (const float*)(ws + WS_ABART);
    const int gtid = blockIdx.x * NTHR + tid, gthr = gridDim.x * NTHR;
    for (int i = gtid; i < 2 * 256 * 64; i += gthr) {
        const int p = i & 63, g = (i >> 6) & 255, b = i >> 14, jg = j * 256 + g;
        const float tr = ABART[(jg * 2 + 0) * 64 + p], ti = ABART[(jg * 2 + 1) * 64 + p];
        const size_t base = (((size_t)(b * NCHUNK) * 256 + g) * 2) * 64 + p, kstr = (size_t)256 * 2 * 64;
        float sre = 0.f, sim = 0.f;
        for (int k0 = 0; k0 < NCHUNK; k0 += 8) {
            float er[8], ei[8];
#pragma unroll
            for (int u = 0; u < 8; ++u) { const bool ok = (k0 + u) < NCHUNK - 1; er[u] = ok ? E[base + (size_t)(k0 + u) * kstr] : 0.f; ei[u] = ok ? E[base + (size_t)(k0 + u) * kstr + 64] : 0.f; }
#pragma unroll
            for (int u = 0; u < 8; ++u) { SP[base + (size_t)(k0 + u) * kstr] = sre; SP[base + (size_t)(k0 + u) * kstr + 64] = sim;
                const float nre = tr * sre - ti * sim + er[u], nim = tr * sim + ti * sre + ei[u]; sre = nre; sim = nim; }
        }
    }
}
__device__ __forceinline__ float gelu_tanh(float y) {
    const float a = 0.7978845608028654f * (y + 0.044715f * y * y * y);
    return y * __builtin_amdgcn_rcpf(1.0f + __builtin_amdgcn_exp2f(-2.0f * 1.44269504089f * a));
}
__device__ __forceinline__ void phase_ssm_scan(int j, LAS unsigned char* lds, int xlo, int xhi, int xlo2, int xn2) {
    PHASE_IDS();
    const bf16* H = (const bf16*)(ws + WS_H); const float* SP = (const float*)(ws + WS_SP); bf16* U = (bf16*)(ws + WS_U);
    const float* ABAR = (const float*)(ws + WS_ABAR); const u32x4* BFRAG = (const u32x4*)(ws + WS_BBAR);
    const float* c_re = in_ptr<19>(); const float* c_im = in_ptr<20>(); const float* dsk = in_ptr<21>();
    LAS unsigned char* hs = lds + wave * SSM_WLDS; LAS unsigned char* st = hs + SSM_ST; LAS unsigned char* ut = hs + SSM_U;
    const int gw = blockIdx.x * NWAVES + wave, ngw = gridDim.x * NWAVES, fr = lane & 15, fq = lane >> 4;
    const int g = gw & 255, jg = j * 256 + g, bstep = ngw >> 8; constexpr int NBK = 2 * NCHUNK;
    bf16x8 bf[8];
#pragma unroll
    for (int tau = 0; tau < 8; ++tau) bf[tau] = __builtin_bit_cast(bf16x8, BFRAG[((size_t)jg * 8 + tau) * 64 + lane]);
    const float are = ABAR[(jg * 2 + 0) * 64 + lane], aim = ABAR[(jg * 2 + 1) * 64 + lane];
    bf16x8 cf[4];
#pragma unroll
    for (int s4 = 0; s4 < 4; ++s4) { const float* src = ((s4 >> 1) ? c_im : c_re) + ((size_t)jg * 16 + fr) * 64 + 32 * (s4 & 1) + 8 * fq; const float sg = (s4 >> 1) ? -1.0f : 1.0f;
        const f32x4 a = *(const f32x4*)src * sg, c4 = *(const f32x4*)(src + 4) * sg;
        u32x4 w; w.x = pk2(a[0], a[1]); w.y = pk2(a[2], a[3]); w.z = pk2(c4[0], c4[1]); w.w = pk2(c4[2], c4[3]);
        cf[s4] = __builtin_bit_cast(bf16x8, w); }
    const f32x4 dv4 = *(const f32x4*)(dsk + j * 4096 + g * 16 + 4 * fq);
    u32x4 n0 = {0u, 0u, 0u, 0u}, n1 = {0u, 0u, 0u, 0u}; float nsre = 0.f, nsim = 0.f;
    int xi = gw, itn = 0; const int xtot = xn2 + (xhi - xlo);
    int bk = (gw < (ngw & ~255)) ? (gw >> 8) : NBK;
    if (bk < NBK) { ssm_load_h(H, bk >> 6, bk & (NCHUNK - 1), g, lane, n0, n1); const float* sp = SP + (((size_t)bk * 256 + g) * 2) * 64 + lane; nsre = sp[0]; nsim = sp[64]; }
    for (; bk < NBK; bk += bstep) {
        const int k = bk & (NCHUNK - 1), b = bk >> 6;
        ssm_store_h(hs, lane, n0, n1);
        float sre = nsre, sim = nsim;
        { const int nx = bk + bstep; if (nx < NBK) { ssm_load_h(H, nx >> 6, nx & (NCHUNK - 1), g, lane, n0, n1); const float* sp = SP + (((size_t)nx * 256 + g) * 2) * 64 + lane; nsre = sp[0]; nsim = sp[64]; } }
        for (int tg = 0; tg < TC / 16; ++tg) {
            ssm_bproj16(hs, ut, tg, bf, fr, fq);
            float ur[16], ui[16];
#pragma unroll
            for (int tt = 0; tt < 16; ++tt) { ur[tt] = *(const LAS float*)(ut + tt * SSM_USTR + lane * 4); ui[tt] = *(const LAS float*)(ut + tt * SSM_USTR + 256 + lane * 4); }
#pragma unroll
            for (int tt = 0; tt < 16; ++tt) {
                { const float nre = are * sre - aim * sim + ur[tt], nim = are * sim + aim * sre + ui[tt]; sre = nre; sim = nim; }
                const unsigned w = pk2(sre, sim);
                *(LAS unsigned short*)(st + tt * 272 + lane * 2) = (unsigned short)(w & 0xffffu);
                *(LAS unsigned short*)(st + tt * 272 + 128 + lane * 2) = (unsigned short)(w >> 16);
            }
            f32x4 acc = {0.f, 0.f, 0.f, 0.f};
#pragma unroll
            for (int s4 = 0; s4 < 4; ++s4) { const bf16x8 a = *(const LAS bf16x8*)(st + fr * 272 + 64 * s4 + 16 * fq);
                acc = __builtin_amdgcn_mfma_f32_16x16x32_bf16(cf[s4], a, acc, 0, 0, 0); }
            const int tok = tg * 16 + fr;
            const u32x2 hw = *(const LAS u32x2*)(hs + tok * 32 + fq * 8);
            const float y0 = acc[0] + dv4[0] * bf_lo(hw.x), y1 = acc[1] + dv4[1] * bf_hi(hw.x), y2 = acc[2] + dv4[2] * bf_lo(hw.y), y3 = acc[3] + dv4[3] * bf_hi(hw.y);
            u32x2 w; w.x = pk2(gelu_tanh(y0), gelu_tanh(y1)); w.y = pk2(gelu_tanh(y2), gelu_tanh(y3));
            *(u32x2*)(U + ((size_t)(b * SEQ + k * TC + tok)) * 4096 + g * 16 + 4 * fq) = w;
        }
        if (xi < xtot) { xpose_global_item(xi < xn2 ? xlo2 + xi : xlo + (xi - xn2), (LAS float*)ut, lane); xi += ngw; }
        if ((itn++ & 3) == 3 && xi < xtot) { xpose_global_item(xi < xn2 ? xlo2 + xi : xlo + (xi - xn2), (LAS float*)ut, lane); xi += ngw; }
    }
    for (; xi < xtot; xi += ngw) xpose_global_item(xi < xn2 ? xlo2 + xi : xlo + (xi - xn2), (LAS float*)ut, lane);
}

typedef float f32x16 __attribute__((ext_vector_type(16)));
constexpr int AT_KSTR = 144, AT_VSTR = 520, AT_K_OFF = 0, AT_V_OFF = 256 * AT_KSTR, AT_TBL_OFF = AT_V_OFF + 64 * AT_VSTR;
static_assert(AT_TBL_OFF + 8 * 512 <= RING_BYTES, "attention LDS");
__device__ __forceinline__ void phase_attn(int j, LAS unsigned char* lds) {
    PHASE_IDS();
    const bf16* QKV = (const bf16*)(ws + WS_QKV); bf16* O = (bf16*)(ws + WS_O);
    const float* sinks = in_ptr<12>() + j * 64; const float* relb = in_ptr<13>();
    const int qc = lane & 31, hh = lane >> 5;
    constexpr float LOG2E = 1.44269504089f;
    LAS float* tbl = (LAS float*)(lds + AT_TBL_OFF + wave * 512);
    for (int unit = blockIdx.x; unit < 512; unit += gridDim.x) {
        const int kvh = unit & 7, n = (unit >> 3) & 31, b = unit >> 8, h = kvh * 8 + wave;
        for (int i = lane; i < 128; i += 64) tbl[i] = relb[kBucket[i] * 64 + h] * LOG2E;
        const float sink2 = sinks[h] * LOG2E;
        const int pos0 = n * 128 - 128;
#pragma unroll
        for (int i = 0; i < 4; ++i) { const int c = tid + 512 * i, key = c >> 3, part = c & 7, pos = pos0 + key;
            u32x4 kv = {0u, 0u, 0u, 0u}, vv = {0u, 0u, 0u, 0u};
            if (pos >= 0) { const bf16* src = QKV + (size_t)(b * SEQ + pos) * NQKV + 4096 + kvh * 64 + part * 8; kv = *(const u32x4*)src; vv = *(const u32x4*)(src + 512); }
            *(LAS u32x4*)(lds + AT_K_OFF + key * AT_KSTR + part * 16) = kv;
            LAS unsigned short* vt = (LAS unsigned short*)(lds + AT_V_OFF + (part * 8) * AT_VSTR + key * 2);
#pragma unroll
            for (int e = 0; e < 4; ++e) { vt[(2 * e) * (AT_VSTR / 2)] = (unsigned short)(vv[e] & 0xffffu); vt[(2 * e + 1) * (AT_VSTR / 2)] = (unsigned short)(vv[e] >> 16); } }
        __syncthreads();
        for (int qb = 0; qb < 4; ++qb) {
            const bf16* qp = QKV + (size_t)(b * SEQ + n * 128 + 32 * qb + qc) * NQKV + h * 64 + 8 * hh;
            bf16x8 qf[4];
#pragma unroll
            for (int ks = 0; ks < 4; ++ks) qf[ks] = *(const bf16x8*)(qp + 16 * ks);
            f32x16 s[5];
#pragma unroll
            for (int jt = 0; jt < 5; ++jt) {
#pragma unroll
                for (int r = 0; r < 16; ++r) s[jt][r] = 0.f;
#pragma unroll
                for (int ks = 0; ks < 4; ++ks) { const bf16x8 kf = *(const LAS bf16x8*)(lds + AT_K_OFF + (32 * (qb + jt) + qc) * AT_KSTR + (16 * ks + 8 * hh) * 2);
                    s[jt] = __builtin_amdgcn_mfma_f32_32x32x16_bf16(kf, qf[ks], s[jt], 0, 0, 0); } }
            float mx = sink2;
#pragma unroll
            for (int jt = 0; jt < 5; ++jt) { const bool tile_dead = (n == 0) && (qb + jt < 4);
#pragma unroll
                for (int r = 0; r < 16; ++r) { const int krow = (r & 3) + 8 * (r >> 2) + 4 * hh, dist = 128 + qc - krow - 32 * jt;
                    bool valid = (jt == 0) ? (krow > qc) : ((jt == 4) ? (krow <= qc) : true); valid = valid && !tile_dead;
                    float t = s[jt][r] * (0.125f * LOG2E) + tbl[dist & 127]; t = valid ? t : -1e30f; s[jt][r] = t; mx = fmaxf(mx, t); } }
            mx = fmaxf(mx, __shfl_xor(mx, 32));
            float sum = 0.f;
#pragma unroll
            for (int jt = 0; jt < 5; ++jt)
#pragma unroll
                for (int r = 0; r < 16; ++r) { const float p = __builtin_amdgcn_exp2f(s[jt][r] - mx); s[jt][r] = p; sum += p; }
            sum += __shfl_xor(sum, 32); sum += __builtin_amdgcn_exp2f(sink2 - mx);
            const float inv = 1.0f / sum;
            f32x16 o[2];
#pragma unroll
            for (int dt = 0; dt < 2; ++dt)
#pragma unroll
                for (int r = 0; r < 16; ++r) o[dt][r] = 0.f;
#pragma unroll
            for (int jt = 0; jt < 5; ++jt)
#pragma unroll
                for (int s2 = 0; s2 < 2; ++s2) { u32x4 pw; pw.x = pk2(s[jt][8 * s2 + 0], s[jt][8 * s2 + 1]); pw.y = pk2(s[jt][8 * s2 + 2], s[jt][8 * s2 + 3]); pw.z = pk2(s[jt][8 * s2 + 4], s[jt][8 * s2 + 5]); pw.w = pk2(s[jt][8 * s2 + 6], s[jt][8 * s2 + 7]);
                    const bf16x8 pf = __builtin_bit_cast(bf16x8, pw);
#pragma unroll
                    for (int dt = 0; dt < 2; ++dt) { const LAS unsigned char* vp = lds + AT_V_OFF + (32 * dt + qc) * AT_VSTR + (32 * (qb + jt) + 16 * s2 + 4 * hh) * 2;
                        const u32x2 v0 = *(const LAS u32x2*)vp, v1 = *(const LAS u32x2*)(vp + 16); u32x4 vw; vw.x = v0.x; vw.y = v0.y; vw.z = v1.x; vw.w = v1.y;
                        o[dt] = __builtin_amdgcn_mfma_f32_32x32x16_bf16(__builtin_bit_cast(bf16x8, vw), pf, o[dt], 0, 0, 0); } }
            bf16* op = O + (size_t)(b * SEQ + n * 128 + 32 * qb + qc) * 4096 + h * 64;
#pragma unroll
            for (int dt = 0; dt < 2; ++dt)
#pragma unroll
                for (int g4 = 0; g4 < 4; ++g4) { u32x2 w; w.x = pk2(o[dt][4 * g4] * inv, o[dt][4 * g4 + 1] * inv); w.y = pk2(o[dt][4 * g4 + 2] * inv, o[dt][4 * g4 + 3] * inv);
                    *(u32x2*)(op + 32 * dt + 8 * g4 + 4 * hh) = w; }
        }
        __syncthreads();
    }
}

struct Args { const float* in[24]; float* out; unsigned char* ws; int ph_lo, ph_hi; };
__global__ void __launch_bounds__(NTHR, 2) fwd_kernel(Args args) {
    extern __shared__ __attribute__((aligned(16))) unsigned char lds_raw[];
    LAS unsigned char* lds = (LAS unsigned char*)lds_raw;
    for (int u = threadIdx.x; u < (LDS_BYTES - LDSCTL_OFF) / 4; u += NTHR) ((LAS unsigned*)(lds + LDSCTL_OFF))[u] = 0u;
    __syncthreads();
#if MK_ONE_LAUNCH
    const XcdBarrier bar = xcd_barrier_post((unsigned*)(ws_ptr() + WS_CTL) + CW_BAR, (volatile LAS unsigned*)(lds + MISC_OFF) + 8);
#define GRID_BAR() xcd_barrier(bar)
#else
#define GRID_BAR() do {} while (0)
#endif
    const int lo = args.ph_lo, hi = args.ph_hi;
#define IN(k) (lo <= (k) && (k) < hi)
#define SEAM() GRID_BAR()
#define WSP(off) (ws_ptr() + (off))
#define MODS_L(l) ((const float*)WSP(WS_MODSL) + (size_t)(l) * 2 * 6 * 4096)
#define XRES(l) ((l) == 0 ? in_ptr<0>() : (const float*)WSP(WS_X))

    if (IN(0)) phase0(lds);
    SEAM();
    if (IN(1)) phase1();
    SEAM();
    if (IN(2)) phase_modulate(in_ptr<0>(), MODS_L(0), 0, 1, (bf16*)WSP(WS_H));
    SEAM();

    for (int l = 0; l < 4; ++l) {
        const int pb = 3 + 8 * l, j = l >> 1;
        if ((l & 1) == 0) {
            if (IN(pb + 0)) phase_ssm_local(j, lds, l ? XS_L2S1_LO : XS_L0S1_LO, l ? XS_L2S1_HI : XS_L0S1_HI, l ? XS_L2S1X_LO : XS_L0S1X_LO, XS_X);
            SEAM();
            if (IN(pb + 1)) phase_ssm_carry(j);
            SEAM();
            if (IN(pb + 2)) phase_ssm_scan(j, lds, l ? XS_L2S3_LO : XS_L0S3_LO, l ? XS_L2S3_HI : XS_L0S3_HI, l ? XS_L2S3X_LO : XS_L0S3X_LO, XS_X);
            SEAM();
            if (IN(pb + 3)) {
                pg8::Gemm g{(const bf16*)WSP(WS_U), (const bf16*)WSP(WS_WGLU + j * SZ_WGLU), MROWS, 8192, 4096}; pg8::StaticOrder S; S.init(MROWS, 8192, gridDim.x, (int)blockIdx.x);
                pg8::EpiGLUY E{(bf16*)WSP(WS_Z), MODS_L(l) + 2 * 4096};
                pg8::gemm_phase<pg8::EpiGLUY, pg8::StaticOrder, true, true, 4096>(lds, g, S, E);
            }
            SEAM();
        } else {
            if (IN(pb + 0)) {
                pg8::Gemm g{(const bf16*)WSP(WS_H), (const bf16*)WSP(WS_WQKV + j * SZ_WQKV), MROWS, NQKV, 4096}; pg8::StaticOrder S; S.init(MROWS, NQKV, gridDim.x, (int)blockIdx.x);
                pg8::EpiQKV E{(bf16*)WSP(WS_QKV), NQKV, in_ptr<10>() + j * NQKV};
                pg8::gemm_phase<pg8::EpiQKV, pg8::StaticOrder, true, true, 4096>(lds, g, S, E);
                host_tail(lds, (MROWS / 256) * (NQKV / 256), l == 1 ? XS_T1Q_LO : XS_T3Q_LO, l == 1 ? XS_T1Q_HI : XS_T3Q_HI);
            }
            SEAM();
            if (IN(pb + 1)) phase_attn(j, lds);
            SEAM();
            if (IN(pb + 2)) {
                pg8::Gemm g{(const bf16*)WSP(WS_O), (const bf16*)WSP(WS_WO + j * SZ_WO), MROWS, 4096, 4096}; pg8::StaticOrder S; S.init(MROWS, 4096, gridDim.x, (int)blockIdx.x);
                pg8::EpiY E{(bf16*)WSP(WS_Z), MODS_L(l) + 2 * 4096};
                pg8::gemm_phase<pg8::EpiY, pg8::StaticOrder, true, true, 4096>(lds, g, S, E);
            }
            SEAM();
        }
        if (IN(pb + 4)) phase_ln1(XRES(l), l != 0, (const bf16*)WSP(WS_Z), in_ptr<5>() + (size_t)(l * 2 + 0) * 4096, in_ptr<6>() + (size_t)(l * 2 + 0) * 4096, MODS_L(l), (bf16*)WSP(WS_H));
        SEAM();
        if (IN(pb + 5)) {
            pg8::Gemm g{(const bf16*)WSP(WS_H), (const bf16*)WSP(WS_WIN + l * SZ_WIN), MROWS, 2 * DFF, 4096}; pg8::StaticOrder S; S.init(MROWS, 2 * DFF, gridDim.x, (int)blockIdx.x);
            pg8::EpiSwiGLU E{(bf16*)WSP(WS_ACT), DFF};
            pg8::gemm_phase<pg8::EpiSwiGLU, pg8::StaticOrder, true, true, 4096>(lds, g, S, E);
            if (l < 3) host_tail(lds, (MROWS / 256) * (2 * DFF / 256), l == 0 ? XS_T0_LO : (l == 1 ? XS_T1_LO : XS_T2_LO), l == 0 ? XS_T0_HI : (l == 1 ? XS_T1_HI : XS_T2_HI));
        }
        SEAM();
        if (IN(pb + 6)) {
            pg8::Gemm g{(const bf16*)WSP(WS_ACT), (const bf16*)WSP(WS_WDN + l * SZ_WDN), MROWS, 4096, DFF}; pg8::StaticOrder S; S.init(MROWS, 4096, gridDim.x, (int)blockIdx.x);
            pg8::EpiY E{(bf16*)WSP(WS_Z + SZ_H), MODS_L(l) + 5 * 4096};
            pg8::gemm_phase<pg8::EpiY, pg8::StaticOrder, true, true, DFF>(lds, g, S, E);
        }
        SEAM();
        if (IN(pb + 7)) phase_ln2(XRES(l), l != 0, l != 3, (const bf16*)WSP(WS_Z), (const bf16*)WSP(WS_Z + SZ_H), in_ptr<5>() + (size_t)(l * 2 + 0) * 4096, in_ptr<6>() + (size_t)(l * 2 + 0) * 4096, in_ptr<5>() + (size_t)(l * 2 + 1) * 4096, in_ptr<6>() + (size_t)(l * 2 + 1) * 4096, (l == 3) ? out_ptr() : (float*)WSP(WS_X), MODS_L(l + 1), (l == 3) ? (bf16*)nullptr : (bf16*)WSP(WS_H));
        if (l < 3) SEAM();
    }
#undef IN
#undef SEAM
#undef GRID_BAR
}

extern "C" void kernel_launch(void* const* d_in, const int* in_sizes, int n_in, void* d_out, int out_size, void* d_ws, size_t ws_size, hipStream_t stream) {
    static int grid = 0;
    if (grid == 0) {
        if (n_in != 24 || out_size != MROWS * DM || ws_size < WS_END) { fprintf(stderr, "kernel_launch: unexpected problem (n_in %d, out %d, ws %zu < %zu)\n", n_in, out_size, ws_size, (size_t)WS_END); grid = -1; return; }
        int dev = 0, cus = 0, per_cu = 0;
        if (hipGetDevice(&dev) != hipSuccess || hipDeviceGetAttribute(&cus, hipDeviceAttributeMultiprocessorCount, dev) != hipSuccess) { grid = -1; return; }
        if (hipFuncSetAttribute((const void*)fwd_kernel, hipFuncAttributeMaxDynamicSharedMemorySize, LDS_BYTES) != hipSuccess) { fprintf(stderr, "kernel_launch: hipFuncSetAttribute failed\n"); grid = -1; return; }
        if (hipOccupancyMaxActiveBlocksPerMultiprocessor(&per_cu, (const void*)fwd_kernel, NTHR, LDS_BYTES) != hipSuccess || per_cu < 1) fprintf(stderr, "kernel_launch: occupancy query says %d\n", per_cu);
        (void)hipGetLastError();
        grid = cus;
    }
    if (grid < 0) return;
    (void)hipMemsetAsync((char*)d_ws + WS_CTL, 0, CTL_BYTES, stream);
    Args a{};
    for (int i = 0; i < 24; ++i) a.in[i] = (const float*)d_in[i];
    a.out = (float*)d_out; a.ws = (unsigned char*)d_ws;
#if MK_ONE_LAUNCH
    a.ph_lo = 0; a.ph_hi = N_PHASES;
    hipLaunchKernelGGL(fwd_kernel, dim3(grid), dim3(NTHR), LDS_BYTES, stream, a);
#else
    for (int ph = 0; ph < N_PHASES; ++ph) {
        if (ph >= 3 && ((ph - 3) & 7) == 3 && (((ph - 3) >> 3) & 1)) continue;
        a.ph_lo = ph; a.ph_hi = ph + 1;
        hipLaunchKernelGGL(fwd_kernel, dim3(grid), dim3(NTHR), LDS_BYTES, stream, a);
    }
#endif
}
```

```cpp
#include <hip/hip_runtime.h>
#include <cstdio>
#include <cstdint>
namespace pg8 {
#define PG8_LAS __attribute__((address_space(3)))
typedef unsigned short bf16_t;
typedef short bf16x8 __attribute__((ext_vector_type(8)));
typedef float f32x4 __attribute__((ext_vector_type(4)));
typedef unsigned u32x4 __attribute__((ext_vector_type(4)));
constexpr int BM = 256, BK = 64, HALF = 128, HTB = HALF * BK * 2  , STAGE_BYTES = 8 * HTB, NXCD = 8, WGM = 8;

__host__ __device__ __forceinline__ int lds_byte(int r, int c) { const int st = (r >> 4) * 2 + (c >> 5), rr = r & 15, cc = c & 31, ob = rr * 64 + cc * 2; return st * 1024 + (ob ^ (((ob >> 9) & 1) << 5)); }
__host__ __device__ __forceinline__ void stage_rc(int b, int& R, int& C) { const int st = b / 1024, sb = b % 1024, swz = sb ^ (((sb >> 9) & 1) << 5); R = (st >> 1) * 16 + swz / 64; C = (st & 1) * 32 + (swz % 64) / 2; }
__host__ __device__ __forceinline__ int perm32(int rho) { const int n = rho >> 4, i = rho & 15; return 8 * (i >> 2) + 4 * n + (i & 3); }

struct Unit { int pm, pn; };
struct Gemm { const bf16_t* A; const bf16_t* Bt; int M, N, K; };

struct StaticOrder {
    int nM, nN, nwg, G, c;
    __host__ __device__ void init(int M, int N, int G_, int c_) { nM = M / BM; nN = N / BM; nwg = nM * nN; G = G_; c = c_; }
    __host__ __device__ bool next(int i, Unit& u) const {
        const long L = (long)i * G + c; if (L >= nwg) return false;
        int wgid = (int)L; { const int q = nwg / NXCD, r = nwg % NXCD, xcd = wgid % NXCD, off = wgid / NXCD; wgid = (xcd < r ? xcd * (q + 1) : r * (q + 1) + (xcd - r) * q) + off; }
        const int nig = WGM * nN, gid = wgid / nig, fm = gid * WGM, gsz = (nM - fm) < WGM ? (nM - fm) : WGM;
        u.pm = fm + ((wgid % nig) % gsz); u.pn = (wgid % nig) / gsz; return true;
    }
    __device__ __forceinline__ void a_ready(const Unit&) const {}
    __device__ __forceinline__ void done(const Unit&) const {}
};
__device__ __forceinline__ unsigned cvt_pk_bf16(float lo, float hi) { unsigned r; asm volatile("v_cvt_pk_bf16_f32 %0, %1, %2" : "=v"(r) : "v"(lo), "v"(hi)); return r; }
typedef float f32x2 __attribute__((ext_vector_type(2)));
__device__ __forceinline__ float fast_sigmoid(float v) { return __builtin_amdgcn_rcpf(1.0f + __builtin_amdgcn_exp2f(-1.44269504089f * v)); }
constexpr float ALPHA_RES = 1.681792830507429f;

struct EpiQKV {
    static constexpr bool PERM = true, AFTER_DRAIN = false;
    bf16_t* O; int ldc; const float* bias;
    __device__ __forceinline__ void operator()(const f32x4 (&acc)[2][2][4][2], const Unit& u, int wr, int wc, int fr, int fq) const {
        const int row0 = u.pm * BM + wr * 64 + fr, col0 = u.pn * BM + wc * 32 + 8 * fq;
        f32x4 bv[2][2];
#pragma unroll
        for (int bj = 0; bj < 2; ++bj)
#pragma unroll
            for (int n = 0; n < 2; ++n) bv[bj][n] = *(const f32x4*)(bias + col0 + bj * HALF + 4 * n);
#pragma unroll
        for (int ai = 0; ai < 2; ++ai)
#pragma unroll
            for (int m = 0; m < 4; ++m) { bf16_t* rowp = O + (size_t)(row0 + ai * HALF + m * 16) * ldc + col0;
#pragma unroll
                for (int bj = 0; bj < 2; ++bj) { const f32x4 v0 = acc[ai][bj][m][0] + bv[bj][0], v1 = acc[ai][bj][m][1] + bv[bj][1];
                    u32x4 w; w.x = cvt_pk_bf16(v0[0], v0[1]); w.y = cvt_pk_bf16(v0[2], v0[3]); w.z = cvt_pk_bf16(v1[0], v1[1]); w.w = cvt_pk_bf16(v1[2], v1[3]);
                    *(u32x4*)(rowp + bj * HALF) = w; } }
    }
};
struct EpiSwiGLU {
    static constexpr bool PERM = true, AFTER_DRAIN = false;
    bf16_t* O; int ldc;
    __device__ __forceinline__ void operator()(const f32x4 (&acc)[2][2][4][2], const Unit& u, int wr, int wc, int fr, int fq) const {
        const int row0 = u.pm * BM + wr * 64 + fr, col0 = u.pn * HALF + wc * 32 + 8 * fq;
#pragma unroll
        for (int ai = 0; ai < 2; ++ai)
#pragma unroll
            for (int m = 0; m < 4; ++m) { bf16_t* rowp = O + (size_t)(row0 + ai * HALF + m * 16) * ldc + col0;
                float t[8], gu[8];
#pragma unroll
                for (int i = 0; i < 8; ++i) { const float g = acc[ai][0][m][i >> 2][i & 3]; t[i] = -1.44269504089f * g; gu[i] = g * acc[ai][1][m][i >> 2][i & 3]; }
#pragma unroll
                for (int i = 0; i < 8; ++i) t[i] = __builtin_amdgcn_exp2f(t[i]);
#pragma unroll
                for (int i = 0; i < 8; ++i) t[i] = t[i] + 1.0f;
#pragma unroll
                for (int i = 0; i < 8; ++i) t[i] = __builtin_amdgcn_rcpf(t[i]);
#pragma unroll
                for (int i = 0; i < 8; ++i) t[i] = t[i] * gu[i];
                asm volatile("" : "+v"(t[0]), "+v"(t[1]), "+v"(t[2]), "+v"(t[3]), "+v"(t[4]), "+v"(t[5]), "+v"(t[6]), "+v"(t[7]));
                u32x4 w; w.x = cvt_pk_bf16(t[0], t[1]); w.y = cvt_pk_bf16(t[2], t[3]); w.z = cvt_pk_bf16(t[4], t[5]); w.w = cvt_pk_bf16(t[6], t[7]);
                *(u32x4*)rowp = w; }
    }
};
struct EpiGLUY {
    static constexpr bool PERM = true, AFTER_DRAIN = false;
    bf16_t* Y; const float* gmod;
    __device__ __forceinline__ void operator()(const f32x4 (&acc)[2][2][4][2], const Unit& u, int wr, int wc, int fr, int fq) const {
        const int row0 = u.pm * BM + wr * 64 + fr, col0 = u.pn * HALF + wc * 32 + 8 * fq, b = u.pm >> 4;
        f32x4 gm[2];
#pragma unroll
        for (int n = 0; n < 2; ++n) gm[n] = *(const f32x4*)(gmod + (size_t)b * 6 * 4096 + col0 + 4 * n) + 1.0f;
#pragma unroll
        for (int ai = 0; ai < 2; ++ai)
#pragma unroll
            for (int m = 0; m < 4; ++m) { float r[8], t[8];
#pragma unroll
                for (int i = 0; i < 8; ++i) { t[i] = -1.44269504089f * acc[ai][1][m][i >> 2][i & 3]; r[i] = gm[i >> 2][i & 3] * acc[ai][0][m][i >> 2][i & 3]; }
#pragma unroll
                for (int i = 0; i < 8; ++i) t[i] = __builtin_amdgcn_exp2f(t[i]);
#pragma unroll
                for (int i = 0; i < 8; ++i) t[i] = t[i] + 1.0f;
#pragma unroll
                for (int i = 0; i < 8; ++i) t[i] = __builtin_amdgcn_rcpf(t[i]);
#pragma unroll
                for (int i = 0; i < 8; ++i) r[i] = r[i] * t[i];
                asm volatile("" : "+v"(r[0]), "+v"(r[1]), "+v"(r[2]), "+v"(r[3]), "+v"(r[4]), "+v"(r[5]), "+v"(r[6]), "+v"(r[7]));
                u32x4 w; w.x = cvt_pk_bf16(r[0], r[1]); w.y = cvt_pk_bf16(r[2], r[3]); w.z = cvt_pk_bf16(r[4], r[5]); w.w = cvt_pk_bf16(r[6], r[7]);
                *(u32x4*)(Y + (size_t)(row0 + ai * HALF + m * 16) * 4096 + col0) = w; }
    }
};
struct EpiY {
    static constexpr bool PERM = true, AFTER_DRAIN = false;
    bf16_t* Y; const float* gmod;
    __device__ __forceinline__ void operator()(const f32x4 (&acc)[2][2][4][2], const Unit& u, int wr, int wc, int fr, int fq) const {
        const int row0 = u.pm * BM + wr * 64 + fr, col0 = u.pn * BM + wc * 32 + 8 * fq, b = u.pm >> 4;
        f32x4 gm[2][2];
#pragma unroll
        for (int bj = 0; bj < 2; ++bj)
#pragma unroll
            for (int n = 0; n < 2; ++n) gm[bj][n] = *(const f32x4*)(gmod + (size_t)b * 6 * 4096 + col0 + bj * HALF + 4 * n) + 1.0f;
#pragma unroll
        for (int ai = 0; ai < 2; ++ai)
#pragma unroll
            for (int m = 0; m < 4; ++m) { bf16_t* rowp = Y + (size_t)(row0 + ai * HALF + m * 16) * 4096 + col0;
#pragma unroll
                for (int bj = 0; bj < 2; ++bj) { const f32x4 v0 = acc[ai][bj][m][0] * gm[bj][0], v1 = acc[ai][bj][m][1] * gm[bj][1];
                    u32x4 w; w.x = cvt_pk_bf16(v0[0], v0[1]); w.y = cvt_pk_bf16(v0[2], v0[3]); w.z = cvt_pk_bf16(v1[0], v1[1]); w.w = cvt_pk_bf16(v1[2], v1[3]);
                    *(u32x4*)(rowp + bj * HALF) = w; } }
    }
};
template <class Epi, class Sched, bool ALIGN_EPI, bool SP2, int KD>
__device__ __forceinline__ void gemm_phase(PG8_LAS unsigned char* lds, const Gemm g, const Sched& S, const Epi& E) {
    int tid_ = threadIdx.x; asm volatile("" : "+v"(tid_));
    const int tid = tid_, wid = __builtin_amdgcn_readfirstlane(tid >> 6), lane = tid & 63, wr = wid >> 2, wc = wid & 3, fr = lane & 15, fq = lane >> 4;
    constexpr int K = KD, nt = K / BK; static_assert(KD % 128 == 0 && KD >= 256, "K");
    unsigned voffA[2], voffB[2];
#pragma unroll
    for (int i = 0; i < 2; ++i) { int R, C; stage_rc(tid * 16 + i * 8192, R, C); const int Rb = Epi::PERM ? ((R & ~31) + perm32(R & 31)) : R;
        voffA[i] = (unsigned)(R * K + C) * 2u; voffB[i] = (unsigned)(Rb * K + C) * 2u; }
    const size_t kstep = (size_t)(BK * 2);
    const size_t hstep = (size_t)HALF * K * 2;
    const size_t tstep = 2 * hstep;
    const unsigned ldsw = (unsigned)wid * 1024u;
    const int aoff = lds_byte(wr * 64 + fr, fq * 8), boff = lds_byte(wc * 32 + fr, fq * 8);
#define PG8_SA(b, h) (((b) * 2 + (h)) * HTB)
#define PG8_SB(b, h) ((4 + (b) * 2 + (h)) * HTB)
#define PG8_STAGE(bufoff, gbase, voff) do { _Pragma("unroll") for (int _i = 0; _i < 2; ++_i) \
        __builtin_amdgcn_global_load_lds((const unsigned*)((const char*)(gbase) + (voff)[_i]), (PG8_LAS unsigned*)(lds + (bufoff) + ldsw + _i * 8192), 16, 0, 0); } while (0)
#define PG8_LDA(dst, b, h) do { _Pragma("unroll") for (int m = 0; m < 4; ++m) _Pragma("unroll") for (int k = 0; k < 2; ++k) dst[m][k] = *(const PG8_LAS bf16x8*)(lds + PG8_SA(b, h) + aoff + m * 2048 + k * 1024); } while (0)
#define PG8_LDB(dst, b, h) do { _Pragma("unroll") for (int n = 0; n < 2; ++n) _Pragma("unroll") for (int k = 0; k < 2; ++k) dst[n][k] = *(const PG8_LAS bf16x8*)(lds + PG8_SB(b, h) + boff + n * 2048 + k * 1024); } while (0)
#define PG8_MMA(ai, bj, At, Bt) do { __builtin_amdgcn_s_setprio(1); _Pragma("unroll") for (int m = 0; m < 4; ++m) _Pragma("unroll") for (int n = 0; n < 2; ++n) _Pragma("unroll") for (int k = 0; k < 2; ++k) \
        acc[ai][bj][m][n] = __builtin_amdgcn_mfma_f32_16x16x32_bf16(Bt[n][k], At[m][k], acc[ai][bj][m][n], 0, 0, 0); __builtin_amdgcn_s_setprio(0); } while (0)
#define PG8_WAIT_V(n) asm volatile("s_waitcnt vmcnt(" #n ")" ::: "memory")
#define PG8_WAIT_L(n) asm volatile("s_waitcnt lgkmcnt(" #n ")" ::: "memory")
#define PG8_BAR __builtin_amdgcn_s_barrier()
#define PG8_SCHED __builtin_amdgcn_sched_barrier(0)
    Unit cur, nxt; int ui = 0;
    if (!S.next(0, cur)) return;
    f32x4 acc[2][2][4][2];
#pragma unroll
    for (int a = 0; a < 2; ++a)
#pragma unroll
        for (int b = 0; b < 2; ++b)
#pragma unroll
            for (int m = 0; m < 4; ++m)
#pragma unroll
                for (int n = 0; n < 2; ++n) acc[a][b][m][n] = (f32x4){0.f, 0.f, 0.f, 0.f};
    bf16x8 At[4][2], B0[2][2], B1[2][2];
    const char* cA = (const char*)g.A + (size_t)cur.pm * tstep; const char* cB = (const char*)g.Bt + (size_t)cur.pn * tstep;
    S.a_ready(cur);
    if constexpr (SP2) {
        PG8_STAGE(PG8_SB(0, 0), cB, voffB); PG8_STAGE(PG8_SB(0, 1), cB + hstep, voffB); PG8_STAGE(PG8_SA(0, 0), cA, voffA); PG8_STAGE(PG8_SA(0, 1), cA + hstep, voffA);
        if (wr == 1) PG8_BAR;
        PG8_WAIT_V(2); PG8_BAR;
        PG8_STAGE(PG8_SB(1, 0), cB + kstep, voffB); PG8_STAGE(PG8_SA(1, 0), cA + kstep, voffA); PG8_STAGE(PG8_SB(1, 1), cB + hstep + kstep, voffB);
        PG8_WAIT_V(6); PG8_BAR;
    } else {
        PG8_STAGE(PG8_SB(0, 0), cB, voffB); PG8_STAGE(PG8_SA(0, 0), cA, voffA); PG8_STAGE(PG8_SB(0, 1), cB + hstep, voffB); PG8_STAGE(PG8_SA(0, 1), cA + hstep, voffA);
        if (wr == 1) PG8_BAR;
        PG8_WAIT_V(4); PG8_BAR;
        PG8_STAGE(PG8_SB(1, 0), cB + kstep, voffB); PG8_STAGE(PG8_SA(1, 0), cA + kstep, voffA); PG8_STAGE(PG8_SB(1, 1), cB + hstep + kstep, voffB);
        PG8_WAIT_V(6); PG8_BAR;
    }
    for (;;) {
        const bool has_next = S.next(ui + 1, nxt);
        const char* nA = has_next ? (const char*)g.A + (size_t)nxt.pm * tstep : cA; const char* nB = has_next ? (const char*)g.Bt + (size_t)nxt.pn * tstep : cB;
        for (int t = 0; t < nt; t += 2) {
            const bool last = (t == nt - 2);
            const char* a1 = cA + (size_t)(t + 1) * kstep;
            const char* a2 = last ? nA : cA + (size_t)(t + 2) * kstep; const char* b2 = last ? nB : cB + (size_t)(t + 2) * kstep;
            const char* a3 = a2 + kstep; const char* b3 = b2 + kstep;
            if (last && has_next) S.a_ready(nxt);
            if constexpr (SP2) {
            PG8_LDB(B0, 0, 0); PG8_LDB(B1, 0, 1); PG8_SCHED; PG8_LDA(At, 0, 0); PG8_STAGE(PG8_SA(1, 1), a1 + hstep, voffA);
            PG8_WAIT_V(8); PG8_WAIT_L(0); PG8_BAR; PG8_MMA(0, 0, At, B0); PG8_MMA(0, 1, At, B1); PG8_BAR; PG8_SCHED;
            PG8_LDA(At, 0, 1); PG8_STAGE(PG8_SB(0, 0), b2, voffB); PG8_STAGE(PG8_SB(0, 1), b2 + hstep, voffB); PG8_STAGE(PG8_SA(0, 0), a2, voffA);
            PG8_WAIT_V(8); PG8_WAIT_L(0); PG8_BAR; PG8_MMA(1, 0, At, B0); PG8_MMA(1, 1, At, B1); PG8_BAR; PG8_SCHED;
            PG8_LDB(B0, 1, 0); PG8_LDB(B1, 1, 1); PG8_SCHED; PG8_LDA(At, 1, 0); PG8_STAGE(PG8_SA(0, 1), a2 + hstep, voffA);
            PG8_WAIT_V(8); PG8_WAIT_L(0); PG8_BAR; PG8_MMA(0, 0, At, B0); PG8_MMA(0, 1, At, B1); PG8_BAR; PG8_SCHED;
            PG8_LDA(At, 1, 1); PG8_STAGE(PG8_SB(1, 0), b3, voffB); PG8_STAGE(PG8_SB(1, 1), b3 + hstep, voffB); PG8_STAGE(PG8_SA(1, 0), a3, voffA);
            PG8_WAIT_V(8); PG8_WAIT_L(0); PG8_BAR; PG8_MMA(1, 0, At, B0); PG8_MMA(1, 1, At, B1); PG8_BAR; PG8_SCHED;
            } else {
            PG8_LDB(B0, 0, 0); PG8_SCHED; PG8_LDA(At, 0, 0); PG8_STAGE(PG8_SA(1, 1), a1 + hstep, voffA);
            PG8_WAIT_L(8); PG8_BAR; PG8_WAIT_L(0); PG8_MMA(0, 0, At, B0); PG8_BAR; PG8_SCHED;
            PG8_LDB(B1, 0, 1); PG8_STAGE(PG8_SB(0, 0), b2, voffB);
            PG8_BAR; PG8_WAIT_L(0); PG8_MMA(0, 1, At, B1); PG8_BAR;
            PG8_LDA(At, 0, 1); PG8_STAGE(PG8_SA(0, 0), a2, voffA);
            PG8_BAR; PG8_WAIT_L(0); PG8_MMA(1, 0, At, B0); PG8_BAR; PG8_SCHED;
            PG8_STAGE(PG8_SB(0, 1), b2 + hstep, voffB);
            PG8_WAIT_V(6); PG8_BAR; PG8_MMA(1, 1, At, B1); PG8_BAR;
            PG8_LDB(B0, 1, 0); PG8_SCHED; PG8_LDA(At, 1, 0); PG8_STAGE(PG8_SA(0, 1), a2 + hstep, voffA);
            PG8_WAIT_L(8); PG8_BAR; PG8_WAIT_L(0); PG8_MMA(0, 0, At, B0); PG8_BAR; PG8_SCHED;
            PG8_LDB(B1, 1, 1); PG8_STAGE(PG8_SB(1, 0), b3, voffB);
            PG8_BAR; PG8_WAIT_L(0); PG8_MMA(0, 1, At, B1); PG8_BAR;
            PG8_LDA(At, 1, 1); PG8_STAGE(PG8_SA(1, 0), a3, voffA);
            PG8_BAR; PG8_WAIT_L(0); PG8_MMA(1, 0, At, B0); PG8_BAR; PG8_SCHED;
            PG8_STAGE(PG8_SB(1, 1), b3 + hstep, voffB);
            PG8_WAIT_V(6); PG8_BAR; PG8_MMA(1, 1, At, B1); PG8_BAR;
            }
        }
        if constexpr (ALIGN_EPI) { if (wr == 0) PG8_BAR; }
        if constexpr (!Epi::AFTER_DRAIN) { E(acc, cur, wr, wc, fr, fq); S.done(cur); }
        if (!has_next) break;
#pragma unroll
        for (int a = 0; a < 2; ++a)
#pragma unroll
            for (int b = 0; b < 2; ++b)
#pragma unroll
                for (int m = 0; m < 4; ++m)
#pragma unroll
                    for (int n = 0; n < 2; ++n) acc[a][b][m][n] = (f32x4){0.f, 0.f, 0.f, 0.f};
        cur = nxt; cA = nA; cB = nB; ++ui;
        if constexpr (ALIGN_EPI) { if (wr == 1) PG8_BAR; }
    }
    PG8_WAIT_V(0);
    if constexpr (!ALIGN_EPI) { if (wr == 0) PG8_BAR; }
    PG8_BAR;
    if constexpr (Epi::AFTER_DRAIN) { E.fused(acc, cur, wr, wc, fr, fq, lds, wid, lane); S.done(cur); }
#undef PG8_SA
#undef PG8_SB
#undef PG8_STAGE
#undef PG8_LDA
#undef PG8_LDB
#undef PG8_MMA
#undef PG8_WAIT_V
#undef PG8_WAIT_L
#undef PG8_BAR
#undef PG8_SCHED
}
}

#ifndef MK_ONE_LAUNCH
#define MK_ONE_LAUNCH 1
#endif
constexpr int NWAVES = 8, NTHR = 512;
constexpr int DM = 4096, SEQ = 4096, MROWS = 8192, DFF = 11008, NQKV = 5120;
constexpr int TC = 64, NCHUNK = 64;
constexpr float LN_EPS = 1e-5f;
constexpr int N_PHASES = 3 + 8 * 4;

#define GAS __attribute__((address_space(1)))
#define LAS __attribute__((address_space(3)))
typedef unsigned short bf16;
typedef float f32x4 __attribute__((ext_vector_type(4)));
typedef unsigned u32x4 __attribute__((ext_vector_type(4)));
typedef unsigned u32x2 __attribute__((ext_vector_type(2)));
typedef short bf16x8 __attribute__((ext_vector_type(8)));

constexpr size_t MiB = 1u << 20;
constexpr size_t alignup(size_t x) { return (x + MiB - 1) & ~(MiB - 1); }
constexpr size_t WS_CTL = 0, CTL_BYTES = 1 * MiB;
constexpr size_t WS_MODP = 1 * MiB,                    SZ_MODP = 64ull * 2 * 24576 * 4;
constexpr size_t WS_MODSL = alignup(WS_MODP + SZ_MODP), SZ_MODSL = 4ull * 2 * 6 * 4096 * 4;
constexpr size_t WS_ABAR = alignup(WS_MODSL + SZ_MODSL), SZ_ABAR = 2ull * 256 * 2 * 64 * 4;
constexpr size_t WS_ABART = alignup(WS_ABAR + SZ_ABAR);
constexpr size_t WS_BBAR = alignup(WS_ABART + SZ_ABAR), SZ_BBAR = 2ull * 256 * 8 * 64 * 16;
constexpr size_t WS_E = alignup(WS_BBAR + SZ_BBAR),     SZ_E = 2ull * 64 * 256 * 2 * 64 * 4;
constexpr size_t SZ_WIN = 22016ull * 4096 * 2, SZ_WDN = 4096ull * 11008 * 2, SZ_WGLU = 8192ull * 4096 * 2, SZ_WQKV = 5120ull * 4096 * 2, SZ_WO = 4096ull * 4096 * 2;
constexpr size_t WS_SP = alignup(WS_E + SZ_E);
constexpr size_t WS_WIN = alignup(WS_SP + SZ_E);
constexpr size_t WS_WDN = alignup(WS_WIN + 4 * SZ_WIN);
constexpr size_t WS_WGLU = alignup(WS_WDN + 4 * SZ_WDN);
constexpr size_t WS_WQKV = alignup(WS_WGLU + 2 * SZ_WGLU);
constexpr size_t WS_WO = alignup(WS_WQKV + 2 * SZ_WQKV);
constexpr size_t WS_H = alignup(WS_WO + 2 * SZ_WO),    SZ_H = 8192ull * 4096 * 2;
constexpr size_t WS_ACT = alignup(WS_H + SZ_H),        SZ_ACT = 8192ull * 11008 * 2;
constexpr size_t WS_Z = alignup(WS_ACT + SZ_ACT),      SZ_Z = 8192ull * 4096 * 4;
constexpr size_t WS_X = alignup(WS_Z + SZ_Z);
constexpr size_t WS_X2 = alignup(WS_X + SZ_Z);
constexpr size_t WS_QKV = alignup(WS_X2 + SZ_Z),        SZ_QKV = 8192ull * 5120 * 2;
constexpr size_t WS_O = alignup(WS_QKV + SZ_QKV);
constexpr size_t WS_U = alignup(WS_O + SZ_H);
constexpr size_t WS_END = alignup(WS_U + SZ_H);
constexpr int CW_BAR = 4096;

constexpr int RING_BYTES = 131072, LDSCTL_OFF = RING_BYTES, MISC_OFF = LDSCTL_OFF + 320, LDS_BYTES = 147456;

__device__ __forceinline__ unsigned pk2(float lo, float hi) { return pg8::cvt_pk_bf16(lo, hi); }
__device__ __forceinline__ float bf_lo(unsigned w) { return __uint_as_float(w << 16); }
__device__ __forceinline__ float bf_hi(unsigned w) { return __uint_as_float(w & 0xffff0000u); }
__device__ __forceinline__ float wave_sum(float v) {
#pragma unroll
    for (int o = 1; o < 64; o <<= 1) v += __shfl_xor(v, o);
    return v;
}

#define XB_TMO      128
#define XB_XCNT(j)  (256  + 64 * (j))
#define XB_XSUB(j)  (1280 + 64 * (j))
#define XB_XGEN(j)  (2304 + 64 * (j))
#define XB_TOP      3328
#define XB_TOPGEN   3392
#define XCD_BAR_WORDS 3456
#define XB_SPIN_CAP (1u << 20)

__device__ __forceinline__ unsigned xb_ld(unsigned* p)              { return __hip_atomic_load(p, __ATOMIC_RELAXED, __HIP_MEMORY_SCOPE_AGENT); }
__device__ __forceinline__ unsigned xb_add(unsigned* p, unsigned v) { return __hip_atomic_fetch_add(p, v, __ATOMIC_RELAXED, __HIP_MEMORY_SCOPE_AGENT); }
__device__ __forceinline__ unsigned xb_xcc_id() { return (unsigned)__builtin_amdgcn_s_getreg((3 << 11) | 20) & 0xFu; }
#define XB_SPIN(cond, bar) do { unsigned _sp = 0; while (cond) { __builtin_amdgcn_s_sleep(1); \
    if ((++_sp & 255u) == 0u) { if (xb_ld(&(bar)[XB_TMO])) break; if (_sp > XB_SPIN_CAP) { atomicAdd(&(bar)[XB_TMO], 1u); break; } } } } while (0)

struct XcdBarrier { unsigned* bar; unsigned x; volatile LAS unsigned* st; };
__device__ __forceinline__ XcdBarrier xcd_barrier_post(unsigned* bar, volatile LAS unsigned* st) {
    XcdBarrier b; b.bar = bar; b.x = xb_xcc_id(); b.st = st;
    if (threadIdx.x == 0) (void)xb_add(&bar[XB_XCNT(b.x)], 1u);
    return b;
}
__device__ __forceinline__ void xcd_barrier_complete(unsigned* bar, unsigned x, unsigned& nloc, unsigned& nx) {
    const unsigned G = gridDim.x * gridDim.y * gridDim.z;
    unsigned sum, cnt, mine, sp = 0u;
    for (;;) {
        sum = 0u; cnt = 0u; mine = 0u;
#pragma unroll
        for (unsigned j = 0; j < 16; ++j) { const unsigned c = xb_ld(&bar[XB_XCNT(j)]); sum += c; cnt += (c > 0u) ? 1u : 0u; mine = (j == x) ? c : mine; }
        if (sum == G) break;
        __builtin_amdgcn_s_sleep(1);
        if ((++sp & 255u) == 0u) { if (xb_ld(&bar[XB_TMO])) break; if (sp > XB_SPIN_CAP) { atomicAdd(&bar[XB_TMO], 1u); break; } }
    }
    nloc = mine > 0u ? mine : 1u; nx = cnt > 0u ? cnt : 1u;
}
__device__ __forceinline__ void xcd_barrier(const XcdBarrier& b) {
    asm volatile("s_waitcnt vmcnt(0)" ::: "memory");
    __syncthreads();
    if (threadIdx.x == 0) {
        unsigned* bar = b.bar;
        __builtin_amdgcn_s_waitcnt(0);
        unsigned nloc = b.st[0], nx = b.st[1];
        if (nloc == 0u) { xcd_barrier_complete(bar, b.x, nloc, nx); b.st[0] = nloc; b.st[1] = nx; }
        const unsigned old = xb_add(&bar[XB_XSUB(b.x)], 1u);
        const unsigned gen = old / nloc;
        if (old + 1u == (gen + 1u) * nloc) {
            __builtin_amdgcn_fence(__ATOMIC_RELEASE, "agent");
            asm volatile("s_waitcnt vmcnt(0)" ::: "memory");
            const unsigned og = xb_add(&bar[XB_TOP], 1u);
            const unsigned tg = og / nx;
            if (og + 1u == (tg + 1u) * nx) xb_add(&bar[XB_TOPGEN], 1u);
            else XB_SPIN(xb_ld(&bar[XB_TOPGEN]) == tg, bar);
            __builtin_amdgcn_fence(__ATOMIC_ACQUIRE, "agent");
            xb_add(&bar[XB_XGEN(b.x)], 1u);
            asm volatile("s_waitcnt vmcnt(0)" ::: "memory");
        } else {
            XB_SPIN(xb_ld(&bar[XB_XGEN(b.x)]) == gen, bar);
            __builtin_amdgcn_fence(__ATOMIC_ACQUIRE, "agent");
            asm volatile("s_waitcnt vmcnt(0)" ::: "memory");
        }
    }
    __syncthreads();
}

__device__ const unsigned char kBucket[128] = {0, 1, 2, 3, 4, 5, 6, 7, 8, 9, 10, 11, 12, 13, 14, 15, 16, 16, 16, 17, 17, 18, 18, 18, 19, 19, 19, 20, 20, 20, 20, 21, 21, 21, 21, 22, 22, 22, 22, 22, 23, 23, 23, 23, 23, 23,
    24, 24, 24, 24, 24, 24, 25, 25, 25, 25, 25, 25, 25, 26, 26, 26, 26, 26, 26, 26, 26, 27, 27, 27, 27, 27, 27, 27, 27, 27, 27, 28, 28, 28, 28, 28, 28, 28, 28, 28, 28, 29, 29, 29, 29, 29, 29, 29, 29, 29, 29, 29, 29,
    30, 30, 30, 30, 30, 30, 30, 30, 30, 30, 30, 30, 30, 30, 31, 31, 31, 31, 31, 31, 31, 31, 31, 31, 31, 31, 31, 31, 31};

__device__ __forceinline__ void p0_transpose_item(const float* W, int K, int N, int ldw, bf16* WT, int mode, LAS float* scr, int item, int lane) {
    const int nblk = N / 32, kb = item / nblk, nb = item % nblk, k0 = 64 * kb, n0 = 32 * nb;
    const int r0 = mode == 0 ? n0 : (256 * (n0 >> 7) + 128 * (mode - 1) + (n0 & 127));
    f32x4 v[8];
#pragma unroll
    for (int i = 0; i < 8; ++i) v[i] = __builtin_nontemporal_load((const f32x4*)(W + (size_t)(k0 + 8 * i + (lane >> 3)) * ldw + n0 + 4 * (lane & 7)));
#pragma unroll
    for (int i = 0; i < 8; ++i) { LAS float* d = scr + (8 * i + (lane >> 3)) * 33 + 4 * (lane & 7); d[0] = v[i][0]; d[1] = v[i][1]; d[2] = v[i][2]; d[3] = v[i][3]; }
    asm volatile("s_waitcnt lgkmcnt(0)" ::: "memory");
    const int c = lane & 7;
#pragma unroll
    for (int j = 0; j < 4; ++j) { const int n = (lane >> 3) + 8 * j; const LAS float* s = scr + (8 * c) * 33 + n;
        u32x4 o; o.x = pk2(s[0 * 33], s[1 * 33]); o.y = pk2(s[2 * 33], s[3 * 33]); o.z = pk2(s[4 * 33], s[5 * 33]); o.w = pk2(s[6 * 33], s[7 * 33]);
        __builtin_nontemporal_store(o, (u32x4*)(WT + (size_t)(r0 + n) * K + k0 + 8 * c)); }
    asm volatile("s_waitcnt lgkmcnt(0)" ::: "memory");
}

template <int I> __device__ __forceinline__ const float* in_ptr() {
    unsigned long long v; const unsigned long long kav = (unsigned long long)__builtin_amdgcn_kernarg_segment_ptr();
    const unsigned ka_lo = __builtin_amdgcn_readfirstlane((unsigned)kav), ka_hi = __builtin_amdgcn_readfirstlane((unsigned)(kav >> 32));
    const unsigned long long ka = ((unsigned long long)ka_hi << 32) | ka_lo;
    asm volatile("s_load_dwordx2 %0, %1, %2\n\ts_waitcnt lgkmcnt(0)" : "=s"(v) : "s"(ka), "n"(I * 8));
    return (const float*)(const GAS float*)v;
}
__device__ __forceinline__ unsigned char* ws_ptr() { return (unsigned char*)in_ptr<25>(); }
__device__ __forceinline__ float* out_ptr() { return (float*)in_ptr<24>(); }
#define PHASE_IDS() int tid_ = threadIdx.x; asm volatile("" : "+v"(tid_)); const int tid = tid_, lane = tid & 63, wave = __builtin_amdgcn_readfirstlane(tid >> 6); (void)lane; (void)wave; unsigned char* const ws = ws_ptr(); (void)ws
constexpr int XP_IT_A = 64 * 344, XP_IT_SQ = 64 * 128, XP_IT_QKV = 64 * 160, XP_PER_L = 3 * XP_IT_A, XP_PER_J = 3 * XP_IT_SQ + XP_IT_QKV;
static_assert((11008 / 64) * (4096 / 32) == XP_IT_A, "w_down items");
constexpr int XG_MIX0 = 0, XG_FFN0 = XG_MIX0 + XP_PER_J, XG_FFN1 = XG_FFN0 + XP_PER_L, XG_GLU1 = XG_FFN1 + XP_PER_L, XG_FFN2 = XG_GLU1 + 2 * XP_IT_SQ, XG_QKVO1 = XG_FFN2 + XP_PER_L,
              XG_FFN3 = XG_QKVO1 + XP_IT_QKV + XP_IT_SQ, XG_END = XG_FFN3 + XP_PER_L;
static_assert(XG_FFN0 == 34816 && XG_FFN1 == 100864 && XG_GLU1 == 166912 && XG_FFN2 == 183296 && XG_QKVO1 == 249344 && XG_FFN3 == 267776 && XG_END == 333824, "conversion list");
constexpr int XS_P0A_LO = 0, XS_P0A_HI = XG_FFN0;
constexpr int XS_L0S1_LO = XG_FFN0, XS_L0S1_HI = XG_FFN0 + XP_PER_L / 2, XS_L0S3_LO = XS_L0S1_HI, XS_L0S3_HI = XG_FFN1;
constexpr int XS_T0_LO = XG_FFN1, XS_T0_HI = XG_FFN1 + 16384;
constexpr int XS_T1Q_LO = XS_T0_HI, XS_T1Q_HI = XS_T0_HI + 32768;
constexpr int XS_X = 8448;
constexpr int XS_L0S1X_LO = XS_T1Q_HI, XS_L0S3X_LO = XS_T1Q_HI + XS_X;
constexpr int XS_P0B_LO = XS_T1Q_HI + 2 * XS_X, XS_P0B_HI = XG_GLU1;
constexpr int XS_T1_LO = XG_GLU1, XS_T1_HI = XG_FFN2;
constexpr int XS_L2S1_LO = XG_FFN2, XS_L2S1_HI = XG_FFN2 + XP_PER_L / 2, XS_L2S3_LO = XS_L2S1_HI, XS_L2S3_HI = XG_QKVO1;
constexpr int XS_T2_LO = XG_QKVO1, XS_T2_HI = XG_QKVO1 + 16384;
constexpr int XS_T3Q_LO = XS_T2_HI, XS_T3Q_HI = XS_T2_HI + 32768;
constexpr int XS_L2S1X_LO = XS_T3Q_HI, XS_L2S3X_LO = XS_T3Q_HI + XS_X;
constexpr int XS_P0C_LO = XS_T3Q_HI + 2 * XS_X, XS_P0C_HI = XG_END;
static_assert(XS_P0B_LO <= XS_P0B_HI && XS_P0C_LO <= XS_P0C_HI && XS_T1Q_HI < XG_GLU1 && XS_T2_HI > XG_QKVO1 + XP_IT_QKV && XS_T2_HI < XG_FFN3 && XS_T3Q_HI < XG_END, "conversion deal");
__device__ __forceinline__ void xpose_global_item(int idx, LAS float* scr, int lane) {
    unsigned char* const ws = ws_ptr();
    const float* W; bf16* WT; int K = 4096, N = 4096, ldw = 4096, mode = 0, r;
    const bool mix = idx < XG_FFN0 || (idx >= XG_GLU1 && idx < XG_FFN2) || (idx >= XG_QKVO1 && idx < XG_FFN3);
    if (!mix) {
        int l, base;
        if (idx < XG_FFN1) { l = 0; base = XG_FFN0; } else if (idx < XG_GLU1) { l = 1; base = XG_FFN1; } else if (idx < XG_QKVO1) { l = 2; base = XG_FFN2; } else { l = 3; base = XG_FFN3; }
        r = idx - base; const int which = r / XP_IT_A; r -= which * XP_IT_A;
        if (which < 2) { W = in_ptr<7>() + (size_t)l * 4096 * 22016 + which * 11008; N = 11008; ldw = 22016; WT = (bf16*)(ws + WS_WIN + l * SZ_WIN); mode = 1 + which; }
        else { W = in_ptr<8>() + (size_t)l * 11008 * 4096; K = 11008; WT = (bf16*)(ws + WS_WDN + l * SZ_WDN); }
    } else {
        int j;
        if (idx < XG_FFN0) { j = 0; r = idx; } else if (idx < XG_FFN2) { j = 1; r = idx - XG_GLU1; } else { j = 1; r = idx - XG_QKVO1 + 2 * XP_IT_SQ; }
        if (r < XP_IT_SQ) { W = in_ptr<22>() + (size_t)j * 4096 * 4096; WT = (bf16*)(ws + WS_WGLU + j * SZ_WGLU); mode = 1; }
        else if (r < 2 * XP_IT_SQ) { W = in_ptr<23>() + (size_t)j * 4096 * 4096; WT = (bf16*)(ws + WS_WGLU + j * SZ_WGLU); mode = 2; r -= XP_IT_SQ; }
        else if (r < 2 * XP_IT_SQ + XP_IT_QKV) { W = in_ptr<9>() + (size_t)j * 4096 * 5120; N = 5120; ldw = 5120; WT = (bf16*)(ws + WS_WQKV + j * SZ_WQKV); r -= 2 * XP_IT_SQ; }
        else { W = in_ptr<11>() + (size_t)j * 4096 * 4096; WT = (bf16*)(ws + WS_WO + j * SZ_WO); r -= 2 * XP_IT_SQ + XP_IT_QKV; }
    }
    p0_transpose_item(W, K, N, ldw, WT, mode, scr, r, lane);
}
__device__ __forceinline__ void host_tail(LAS unsigned char* lds, int nunits, int lo, int hi) {
    PHASE_IDS();
    const int first = nunits % (int)gridDim.x;
    if ((int)blockIdx.x < first) return;
    const int nw = ((int)gridDim.x - first) * NWAVES, w = ((int)blockIdx.x - first) * NWAVES + wave;
    LAS float* scr = (LAS float*)(lds + wave * 16384);
    for (int it = lo + w; it < hi; it += nw) xpose_global_item(it, scr, lane);
}

__device__ __forceinline__ void phase0(LAS unsigned char* lds) {
    PHASE_IDS();
    const int gw = blockIdx.x * NWAVES + wave, ngw = gridDim.x * NWAVES, gtid = blockIdx.x * NTHR + tid, gthr = gridDim.x * NTHR;
    {
        LAS float* sc = (LAS float*)lds;
        const float* c = in_ptr<1>();
        for (int i = tid; i < 2 * 4096; i += NTHR) { const float v = c[i]; sc[i] = v / (1.0f + expf(-v)); }
        __syncthreads();
        const float* w_ada = in_ptr<2>(); float* modp = (float*)(ws + WS_MODP);
        for (int it = gw; it < 96 * 64; it += ngw) {
            const int cb = it % 96, ks = it / 96;
            const float* wp = w_ada + (size_t)(ks * 64) * 24576 + cb * 256 + lane * 4;
            f32x4 a0 = {0.f, 0.f, 0.f, 0.f}, a1 = {0.f, 0.f, 0.f, 0.f};
#pragma unroll 8
            for (int k = 0; k < 64; ++k) { const f32x4 w = __builtin_nontemporal_load((const f32x4*)(wp + (size_t)k * 24576)); const float s0 = sc[ks * 64 + k], s1 = sc[4096 + ks * 64 + k]; a0 += s0 * w; a1 += s1 * w; }
            *(f32x4*)(modp + ((size_t)ks * 2 + 0) * 24576 + cb * 256 + lane * 4) = a0;
            *(f32x4*)(modp + ((size_t)ks * 2 + 1) * 24576 + cb * 256 + lane * 4) = a1;
        }
        __syncthreads();
    }
    {
        const float* a_re = in_ptr<14>(); const float* a_im = in_ptr<15>(); const float* log_dt = in_ptr<16>(); const float* b_re = in_ptr<17>(); const float* b_im = in_ptr<18>();
        float* ABAR = (float*)(ws + WS_ABAR); float* ABART = (float*)(ws + WS_ABART); u32x4* BFRAG = (u32x4*)(ws + WS_BBAR);
        for (int i = gtid; i < 2 * 256 * 64; i += gthr) {
            const int p = i & 63, jg = i >> 6;
            const float are = a_re[i], aim = a_im[i], dt = expf(log_dt[jg]);
            const float mag = expf(are * dt), ang = aim * dt;
            const float abr = mag * cosf(ang), abi = mag * sinf(ang);
            const float den = are * are + aim * aim, nr = abr - 1.0f;
            const float kre = (nr * are + abi * aim) / den, kim = (abi * are - nr * aim) / den;
            ABAR[(jg * 2 + 0) * 64 + p] = abr; ABAR[(jg * 2 + 1) * 64 + p] = abi;
            float tr = abr, ti = abi;
#pragma unroll
            for (int q = 0; q < 6; ++q) { const float n2 = tr * tr - ti * ti, i2 = 2.0f * tr * ti; tr = n2; ti = i2; }
            ABART[(jg * 2 + 0) * 64 + p] = tr; ABART[(jg * 2 + 1) * 64 + p] = ti;
            const f32x4* br = (const f32x4*)(b_re + (size_t)i * 16); const f32x4* bi = (const f32x4*)(b_im + (size_t)i * 16);
            float vr[16], vi[16];
#pragma unroll
            for (int q = 0; q < 4; ++q) { const f32x4 r = br[q], m = bi[q];
#pragma unroll
                for (int e = 0; e < 4; ++e) { vr[q * 4 + e] = kre * r[e] - kim * m[e]; vi[q * 4 + e] = kre * m[e] + kim * r[e]; } }
            u32x4* fr_re = BFRAG + ((size_t)jg * 8 + (p >> 4)) * 64 + (p & 15); u32x4* fr_im = fr_re + 4 * 64;
#pragma unroll
            for (int q = 0; q < 2; ++q) { u32x4 w; w.x = pk2(vr[8 * q + 0], vr[8 * q + 1]); w.y = pk2(vr[8 * q + 2], vr[8 * q + 3]); w.z = pk2(vr[8 * q + 4], vr[8 * q + 5]); w.w = pk2(vr[8 * q + 6], vr[8 * q + 7]); fr_re[16 * q] = w;
                w.x = pk2(vi[8 * q + 0], vi[8 * q + 1]); w.y = pk2(vi[8 * q + 2], vi[8 * q + 3]); w.z = pk2(vi[8 * q + 4], vi[8 * q + 5]); w.w = pk2(vi[8 * q + 6], vi[8 * q + 7]); fr_im[16 * q] = w; }
            const u32x4 z4 = {0u, 0u, 0u, 0u}; fr_re[32] = z4; fr_re[48] = z4; fr_im[32] = z4; fr_im[48] = z4;
        }
    }
    {
        LAS float* scr = (LAS float*)(lds + wave * 16384);
        constexpr int NA = XS_P0A_HI - XS_P0A_LO, NB = XS_P0B_HI - XS_P0B_LO, NC = XS_P0C_HI - XS_P0C_LO;
        for (int it = gw; it < NA + NB + NC; it += ngw) {
            const int idx = it < NA ? XS_P0A_LO + it : (it < NA + NB ? XS_P0B_LO + (it - NA) : XS_P0C_LO + (it - NA - NB));
            xpose_global_item(idx, scr, lane);
        }
    }
}

__device__ __forceinline__ void phase1() {
    PHASE_IDS();
    const int gtid = blockIdx.x * NTHR + tid, gthr = gridDim.x * NTHR;
    const float* modp = (const float*)(ws + WS_MODP); const float* b_ada = in_ptr<3>(); const float* tab = in_ptr<4>(); float* modsl = (float*)(ws + WS_MODSL);
    for (int i = gtid; i < 2 * 24576; i += gthr) {
        const int b = i / 24576, n = i % 24576; float s = b_ada[n];
        for (int ks = 0; ks < 64; ++ks) s += modp[((size_t)ks * 2 + b) * 24576 + n];
#pragma unroll
        for (int l = 0; l < 4; ++l) modsl[((size_t)(l * 2 + b) * 6) * 4096 + n] = s + tab[(size_t)l * 24576 + n];
    }
}
__device__ __forceinline__ void phase_modulate(const float* x, const float* mods, int jh, int js, bf16* H) {
    PHASE_IDS();
    const int gtid = blockIdx.x * NTHR + tid, gthr = gridDim.x * NTHR;
    for (int i = gtid; i < MROWS * 1024; i += gthr) {
        const int row = i >> 10, c4 = (i & 1023) * 4, b = row >> 12;
        const f32x4 xv = __builtin_nontemporal_load((const f32x4*)(x + (size_t)row * 4096 + c4));
        const f32x4 sc = *(const f32x4*)(mods + (size_t)(b * 6 + js) * 4096 + c4), sh = *(const f32x4*)(mods + (size_t)(b * 6 + jh) * 4096 + c4);
        const f32x4 h = xv * (1.0f + sc) + sh;
        u32x2 w; w.x = pk2(h[0], h[1]); w.y = pk2(h[2], h[3]);
        *(u32x2*)(H + (size_t)row * 4096 + c4) = w;
    }
}
#define LN_ROW_STATS(va, vb, mean, rstd) do { float s_ = 0.f; \
    _Pragma("unroll") for (int i = 0; i < 8; ++i) s_ += ((va[i][0] + va[i][1]) + (va[i][2] + va[i][3])) + ((vb[i][0] + vb[i][1]) + (vb[i][2] + vb[i][3])); \
    mean = wave_sum(s_) * (1.0f / 4096.0f); float s2_ = 0.f; \
    _Pragma("unroll") for (int i = 0; i < 8; ++i) { va[i] = va[i] - mean; vb[i] = vb[i] - mean; \
        s2_ += ((va[i][0] * va[i][0] + va[i][1] * va[i][1]) + (va[i][2] * va[i][2] + va[i][3] * va[i][3])) + ((vb[i][0] * vb[i][0] + vb[i][1] * vb[i][1]) + (vb[i][2] * vb[i][2] + vb[i][3] * vb[i][3])); } \
    rstd = 1.0f / sqrtf(wave_sum(s2_) * (1.0f / 4096.0f) + LN_EPS); } while (0)
#define LN_LOAD_Z(va, vb, xr, yr) do { _Pragma("unroll") for (int i = 0; i < 8; ++i) { \
    const f32x4 xa = __builtin_nontemporal_load((const f32x4*)(xr + 512 * i)), xb = __builtin_nontemporal_load((const f32x4*)(xr + 512 * i + 4)); const u32x4 yw = __builtin_nontemporal_load((const u32x4*)(yr + 512 * i)); \
    va[i][0] = pg8::ALPHA_RES * xa[0] + bf_lo(yw.x); va[i][1] = pg8::ALPHA_RES * xa[1] + bf_hi(yw.x); va[i][2] = pg8::ALPHA_RES * xa[2] + bf_lo(yw.y); va[i][3] = pg8::ALPHA_RES * xa[3] + bf_hi(yw.y); \
    vb[i][0] = pg8::ALPHA_RES * xb[0] + bf_lo(yw.z); vb[i][1] = pg8::ALPHA_RES * xb[1] + bf_hi(yw.z); vb[i][2] = pg8::ALPHA_RES * xb[2] + bf_lo(yw.w); vb[i][3] = pg8::ALPHA_RES * xb[3] + bf_hi(yw.w); } } while (0)
__device__ __forceinline__ void ln_stage_vec(LAS unsigned char* lds, int k, const float* src, float add, int tid) {
    for (int q = tid; q < 1024; q += NTHR) { const int c = 4 * q, i = c >> 9, w = c & 511, ln = w >> 3, h = (w >> 2) & 1;
        const f32x4 v = *(const f32x4*)(src + c) + add;
        *(LAS f32x4*)(lds + k * 16384 + i * 2048 + h * 1024 + ln * 16) = v; }
}
#define LN_VEC(k, i, h) (*(const LAS f32x4*)(lds + (k) * 16384 + (i) * 2048 + (h) * 1024 + lane * 16))
__device__ __forceinline__ void phase_ln1(LAS unsigned char* lds, const float* Xin, const bf16* Y1, const float* g, const float* beta, const float* mods, bf16* H) {
    PHASE_IDS();
    ln_stage_vec(lds, 0, g, 0.f, tid); ln_stage_vec(lds, 1, beta, 0.f, tid);
    ln_stage_vec(lds, 2, mods + (size_t)(0 * 6 + 4) * 4096, 1.0f, tid); ln_stage_vec(lds, 3, mods + (size_t)(0 * 6 + 3) * 4096, 0.f, tid);
    ln_stage_vec(lds, 4, mods + (size_t)(1 * 6 + 4) * 4096, 1.0f, tid); ln_stage_vec(lds, 5, mods + (size_t)(1 * 6 + 3) * 4096, 0.f, tid);
    __syncthreads();
    const int gw = blockIdx.x * NWAVES + wave, ngw = gridDim.x * NWAVES;
    for (int row = gw; row < MROWS; row += ngw) {
        const int b = row >> 12;
        const float* xr = Xin + (size_t)row * 4096 + lane * 8; const bf16* yr = Y1 + (size_t)row * 4096 + lane * 8;
        f32x4 va[8], vb[8]; float mean, rstd;
        LN_LOAD_Z(va, vb, xr, yr);
        LN_ROW_STATS(va, vb, mean, rstd);
#pragma unroll
        for (int i = 0; i < 8; ++i) {
            const f32x4 xna = va[i] * rstd * LN_VEC(0, i, 0) + LN_VEC(1, i, 0), xnb = vb[i] * rstd * LN_VEC(0, i, 1) + LN_VEC(1, i, 1);
            const f32x4 ha = xna * LN_VEC(2 + 2 * b, i, 0) + LN_VEC(3 + 2 * b, i, 0), hb = xnb * LN_VEC(2 + 2 * b, i, 1) + LN_VEC(3 + 2 * b, i, 1);
            u32x4 w; w.x = pk2(ha[0], ha[1]); w.y = pk2(ha[2], ha[3]); w.z = pk2(hb[0], hb[1]); w.w = pk2(hb[2], hb[3]);
            *(u32x4*)(H + (size_t)row * 4096 + lane * 8 + 512 * i) = w;
        }
    }
    __syncthreads();
}
__device__ __forceinline__ void phase_ln2(LAS unsigned char* lds, const float* Xin, const bf16* Y1, const bf16* Y2, const float* g1, const float* beta1, const float* g2, const float* beta2, float* Xout, const float* mods, bf16* H) {
    PHASE_IDS();
    ln_stage_vec(lds, 0, g1, 0.f, tid); ln_stage_vec(lds, 1, beta1, 0.f, tid); ln_stage_vec(lds, 2, g2, 0.f, tid); ln_stage_vec(lds, 3, beta2, 0.f, tid);
    if (H) { ln_stage_vec(lds, 4, mods + (size_t)(0 * 6 + 1) * 4096, 1.0f, tid); ln_stage_vec(lds, 5, mods + (size_t)(0 * 6 + 0) * 4096, 0.f, tid);
             ln_stage_vec(lds, 6, mods + (size_t)(1 * 6 + 1) * 4096, 1.0f, tid); ln_stage_vec(lds, 7, mods + (size_t)(1 * 6 + 0) * 4096, 0.f, tid); }
    __syncthreads();
    const int gw = blockIdx.x * NWAVES + wave, ngw = gridDim.x * NWAVES;
    for (int row = gw; row < MROWS; row += ngw) {
        const int b = row >> 12;
        const float* xr = Xin + (size_t)row * 4096 + lane * 8; const bf16* yr = Y1 + (size_t)row * 4096 + lane * 8; const bf16* y2r = Y2 + (size_t)row * 4096 + lane * 8;
        f32x4 va[8], vb[8]; float mean, rstd;
        LN_LOAD_Z(va, vb, xr, yr);
        u32x4 y2w[8];
#pragma unroll
        for (int i = 0; i < 8; ++i) y2w[i] = __builtin_nontemporal_load((const u32x4*)(y2r + 512 * i));
        LN_ROW_STATS(va, vb, mean, rstd);
#pragma unroll
        for (int i = 0; i < 8; ++i) {
            const f32x4 xna = va[i] * rstd * LN_VEC(0, i, 0) + LN_VEC(1, i, 0), xnb = vb[i] * rstd * LN_VEC(0, i, 1) + LN_VEC(1, i, 1);
            const u32x4 yw = y2w[i];
            va[i][0] = pg8::ALPHA_RES * xna[0] + bf_lo(yw.x); va[i][1] = pg8::ALPHA_RES * xna[1] + bf_hi(yw.x); va[i][2] = pg8::ALPHA_RES * xna[2] + bf_lo(yw.y); va[i][3] = pg8::ALPHA_RES * xna[3] + bf_hi(yw.y);
            vb[i][0] = pg8::ALPHA_RES * xnb[0] + bf_lo(yw.z); vb[i][1] = pg8::ALPHA_RES * xnb[1] + bf_hi(yw.z); vb[i][2] = pg8::ALPHA_RES * xnb[2] + bf_lo(yw.w); vb[i][3] = pg8::ALPHA_RES * xnb[3] + bf_hi(yw.w); }
        LN_ROW_STATS(va, vb, mean, rstd);
        float* xo = Xout + (size_t)row * 4096 + lane * 8;
#pragma unroll
        for (int i = 0; i < 8; ++i) {
            const f32x4 xna = va[i] * rstd * LN_VEC(2, i, 0) + LN_VEC(3, i, 0), xnb = vb[i] * rstd * LN_VEC(2, i, 1) + LN_VEC(3, i, 1);
            __builtin_nontemporal_store(xna, (f32x4*)(xo + 512 * i)); __builtin_nontemporal_store(xnb, (f32x4*)(xo + 512 * i + 4));
            if (H) {
                const f32x4 ha = xna * LN_VEC(4 + 2 * b, i, 0) + LN_VEC(5 + 2 * b, i, 0), hb = xnb * LN_VEC(4 + 2 * b, i, 1) + LN_VEC(5 + 2 * b, i, 1);
                u32x4 w; w.x = pk2(ha[0], ha[1]); w.y = pk2(ha[2], ha[3]); w.z = pk2(hb[0], hb[1]); w.w = pk2(hb[2], hb[3]);
                *(u32x4*)(H + (size_t)row * 4096 + lane * 8 + 512 * i) = w;
            }
        }
    }
    __syncthreads();
}

constexpr int SSM_WLDS = 16384, SSM_ST = 2048, SSM_U = 6400, SSM_USTR = 528;
__device__ __forceinline__ void ssm_load_h(const bf16* H, int b, int k, int g, int lane, u32x4& v0, u32x4& v1) {
    const u32x4* src = (const u32x4*)(H + ((size_t)(b * SEQ + k * TC + lane)) * 4096 + g * 16);
    v0 = src[0]; v1 = src[1];
}
__device__ __forceinline__ void ssm_store_h(LAS unsigned char* hs, int lane, const u32x4& v0, const u32x4& v1) { *(LAS u32x4*)(hs + lane * 32) = v0; *(LAS u32x4*)(hs + lane * 32 + 16) = v1; }
__device__ __forceinline__ void ssm_bproj16(const LAS unsigned char* hs, LAS unsigned char* ut, int tg, const bf16x8 (&bf)[8], int fr, int fq) {
    u32x4 aw = {0u, 0u, 0u, 0u};
    if (fq < 2) aw = *(const LAS u32x4*)(hs + (tg * 16 + fr) * 32 + fq * 16);
    const bf16x8 a = __builtin_bit_cast(bf16x8, aw);
#pragma unroll
    for (int tau = 0; tau < 8; ++tau) { f32x4 acc = {0.f, 0.f, 0.f, 0.f};
        acc = __builtin_amdgcn_mfma_f32_16x16x32_bf16(a, bf[tau], acc, 0, 0, 0);
#pragma unroll
        for (int r = 0; r < 4; ++r) *(LAS float*)(ut + (4 * fq + r) * SSM_USTR + (tau * 16 + fr) * 4) = acc[r]; }
}
__device__ __forceinline__ void ssm_update(const LAS unsigned char* ut, int tt, int lane, float are, float aim, float& sre, float& sim) {
    const float ure = *(const LAS float*)(ut + tt * SSM_USTR + lane * 4), uim = *(const LAS float*)(ut + tt * SSM_USTR + 256 + lane * 4);
    const float nre = are * sre - aim * sim + ure, nim = are * sim + aim * sre + uim;
    sre = nre; sim = nim;
}
__device__ __forceinline__ void phase_ssm_local(int j, LAS unsigned char* lds, int xlo, int xhi, int xlo2, int xn2) {
    PHASE_IDS();
    const bf16* H = (const bf16*)(ws + WS_H); float* E = (float*)(ws + WS_E);
    const float* ABAR = (const float*)(ws + WS_ABAR); const u32x4* BFRAG = (const u32x4*)(ws + WS_BBAR);
    LAS unsigned char* hs = lds + wave * SSM_WLDS; LAS unsigned char* ut = hs + SSM_U;
    const int gw = blockIdx.x * NWAVES + wave, ngw = gridDim.x * NWAVES, fr = lane & 15, fq = lane >> 4;
    const int g = gw & 255, jg = j * 256 + g, bstep = ngw >> 8; constexpr int NBK = 2 * (NCHUNK - 1);
    bf16x8 bf[8];
#pragma unroll
    for (int tau = 0; tau < 8; ++tau) bf[tau] = __builtin_bit_cast(bf16x8, BFRAG[((size_t)jg * 8 + tau) * 64 + lane]);
    const float are = ABAR[(jg * 2 + 0) * 64 + lane], aim = ABAR[(jg * 2 + 1) * 64 + lane];
    u32x4 n0 = {0u, 0u, 0u, 0u}, n1 = {0u, 0u, 0u, 0u};
    int xi = gw, itn = 0; const int xtot = xn2 + (xhi - xlo);
    int bk = (gw < (ngw & ~255)) ? (gw >> 8) : NBK;
    if (bk < NBK) ssm_load_h(H, bk / (NCHUNK - 1), bk % (NCHUNK - 1), g, lane, n0, n1);
    for (; bk < NBK; bk += bstep) {
        const int k = bk % (NCHUNK - 1), b = bk / (NCHUNK - 1);
        ssm_store_h(hs, lane, n0, n1);
        { const int nx = bk + bstep; if (nx < NBK) ssm_load_h(H, nx / (NCHUNK - 1), nx % (NCHUNK - 1), g, lane, n0, n1); }
        float sre = 0.f, sim = 0.f;
        for (int tg = 0; tg < TC / 16; ++tg) {
            ssm_bproj16(hs, ut, tg, bf, fr, fq);
#pragma unroll
            for (int tt = 0; tt < 16; ++tt) ssm_update(ut, tt, lane, are, aim, sre, sim);
        }
        float* e = E + (((size_t)(b * NCHUNK + k) * 256 + g) * 2) * 64 + lane;
        e[0] = sre; e[64] = sim;
        if (xi < xtot) { xpose_global_item(xi < xn2 ? xlo2 + xi : xlo + (xi - xn2), (LAS float*)ut, lane); xi += ngw; }
        if ((itn++ & 3) == 3 && xi < xtot) { xpose_global_item(xi < xn2 ? xlo2 + xi : xlo + (xi - xn2), (LAS float*)ut, lane); xi += ngw; }
    }
    for (; xi < xtot; xi += ngw) xpose_global_item(xi < xn2 ? xlo2 + xi : xlo + (xi - xn2), (LAS float*)ut, lane);
}
__device__ __forceinline__ void phase_ssm_carry(int j) {
    PHASE_IDS();
    const float* E = (const float*)(ws + WS_E); float* SP = (float*)(ws + WS_SP); const float* ABART = (const float*)(ws + WS_ABART);
    const int gtid = blockIdx.x * NTHR + tid, gthr = gridDim.x * NTHR;
    for (int i = gtid; i < 2 * 256 * 64; i += gthr) {
        const int p = i & 63, g = (i >> 6) & 255, b = i >> 14, jg = j * 256 + g;
        const float tr = ABART[(jg * 2 + 0) * 64 + p], ti = ABART[(jg * 2 + 1) * 64 + p];
        const size_t base = (((size_t)(b * NCHUNK) * 256 + g) * 2) * 64 + p, kstr = (size_t)256 * 2 * 64;
        float sre = 0.f, sim = 0.f;
        for (int k0 = 0; k0 < NCHUNK; k0 += 8) {
            float er[8], ei[8];
#pragma unroll
            for (int u = 0; u < 8; ++u) { const bool ok = (k0 + u) < NCHUNK - 1; er[u] = ok ? E[base + (size_t)(k0 + u) * kstr] : 0.f; ei[u] = ok ? E[base + (size_t)(k0 + u) * kstr + 64] : 0.f; }
#pragma unroll
            for (int u = 0; u < 8; ++u) { SP[base + (size_t)(k0 + u) * kstr] = sre; SP[base + (size_t)(k0 + u) * kstr + 64] = sim;
                const float nre = tr * sre - ti * sim + er[u], nim = tr * sim + ti * sre + ei[u]; sre = nre; sim = nim; }
        }
    }
}
__device__ __forceinline__ float gelu_tanh(float y) {
    const float a = 0.7978845608028654f * (y + 0.044715f * y * y * y);
    return y * __builtin_amdgcn_rcpf(1.0f + __builtin_amdgcn_exp2f(-2.0f * 1.44269504089f * a));
}
__device__ __forceinline__ void phase_ssm_scan(int j, LAS unsigned char* lds, int xlo, int xhi, int xlo2, int xn2) {
    PHASE_IDS();
    const bf16* H = (const bf16*)(ws + WS_H); const float* SP = (const float*)(ws + WS_SP); bf16* U = (bf16*)(ws + WS_U);
    const float* ABAR = (const float*)(ws + WS_ABAR); const u32x4* BFRAG = (const u32x4*)(ws + WS_BBAR);
    const float* c_re = in_ptr<19>(); const float* c_im = in_ptr<20>(); const float* dsk = in_ptr<21>();
    LAS unsigned char* hs = lds + wave * SSM_WLDS; LAS unsigned char* st = hs + SSM_ST; LAS unsigned char* ut = hs + SSM_U;
    const int gw = blockIdx.x * NWAVES + wave, ngw = gridDim.x * NWAVES, fr = lane & 15, fq = lane >> 4;
    const int g = gw & 255, jg = j * 256 + g, bstep = ngw >> 8; constexpr int NBK = 2 * NCHUNK;
    bf16x8 bf[8];
#pragma unroll
    for (int tau = 0; tau < 8; ++tau) bf[tau] = __builtin_bit_cast(bf16x8, BFRAG[((size_t)jg * 8 + tau) * 64 + lane]);
    const float are = ABAR[(jg * 2 + 0) * 64 + lane], aim = ABAR[(jg * 2 + 1) * 64 + lane];
    bf16x8 cf[4];
#pragma unroll
    for (int s4 = 0; s4 < 4; ++s4) { const float* src = ((s4 >> 1) ? c_im : c_re) + ((size_t)jg * 16 + fr) * 64 + 32 * (s4 & 1) + 8 * fq; const float sg = (s4 >> 1) ? -1.0f : 1.0f;
        const f32x4 a = *(const f32x4*)src * sg, c4 = *(const f32x4*)(src + 4) * sg;
        u32x4 w; w.x = pk2(a[0], a[1]); w.y = pk2(a[2], a[3]); w.z = pk2(c4[0], c4[1]); w.w = pk2(c4[2], c4[3]);
        cf[s4] = __builtin_bit_cast(bf16x8, w); }
    const f32x4 dv4 = *(const f32x4*)(dsk + j * 4096 + g * 16 + 4 * fq);
    u32x4 n0 = {0u, 0u, 0u, 0u}, n1 = {0u, 0u, 0u, 0u}; float nsre = 0.f, nsim = 0.f;
    int xi = gw, itn = 0; const int xtot = xn2 + (xhi - xlo);
    int bk = (gw < (ngw & ~255)) ? (gw >> 8) : NBK;
    if (bk < NBK) { ssm_load_h(H, bk >> 6, bk & (NCHUNK - 1), g, lane, n0, n1); const float* sp = SP + (((size_t)bk * 256 + g) * 2) * 64 + lane; nsre = sp[0]; nsim = sp[64]; }
    for (; bk < NBK; bk += bstep) {
        const int k = bk & (NCHUNK - 1), b = bk >> 6;
        ssm_store_h(hs, lane, n0, n1);
        float sre = nsre, sim = nsim;
        { const int nx = bk + bstep; if (nx < NBK) { ssm_load_h(H, nx >> 6, nx & (NCHUNK - 1), g, lane, n0, n1); const float* sp = SP + (((size_t)nx * 256 + g) * 2) * 64 + lane; nsre = sp[0]; nsim = sp[64]; } }
        for (int tg = 0; tg < TC / 16; ++tg) {
            ssm_bproj16(hs, ut, tg, bf, fr, fq);
            float ur[16], ui[16];
#pragma unroll
            for (int tt = 0; tt < 16; ++tt) { ur[tt] = *(const LAS float*)(ut + tt * SSM_USTR + lane * 4); ui[tt] = *(const LAS float*)(ut + tt * SSM_USTR + 256 + lane * 4); }
#pragma unroll
            for (int tt = 0; tt < 16; ++tt) {
                { const float nre = are * sre - aim * sim + ur[tt], nim = are * sim + aim * sre + ui[tt]; sre = nre; sim = nim; }
                const unsigned w = pk2(sre, sim);
                *(LAS unsigned short*)(st + tt * 272 + lane * 2) = (unsigned short)(w & 0xffffu);
                *(LAS unsigned short*)(st + tt * 272 + 128 + lane * 2) = (unsigned short)(w >> 16);
            }
            f32x4 acc = {0.f, 0.f, 0.f, 0.f};
#pragma unroll
            for (int s4 = 0; s4 < 4; ++s4) { const bf16x8 a = *(const LAS bf16x8*)(st + fr * 272 + 64 * s4 + 16 * fq);
                acc = __builtin_amdgcn_mfma_f32_16x16x32_bf16(cf[s4], a, acc, 0, 0, 0); }
            const int tok = tg * 16 + fr;
            const u32x2 hw = *(const LAS u32x2*)(hs + tok * 32 + fq * 8);
            const float y0 = acc[0] + dv4[0] * bf_lo(hw.x), y1 = acc[1] + dv4[1] * bf_hi(hw.x), y2 = acc[2] + dv4[2] * bf_lo(hw.y), y3 = acc[3] + dv4[3] * bf_hi(hw.y);
            u32x2 w; w.x = pk2(gelu_tanh(y0), gelu_tanh(y1)); w.y = pk2(gelu_tanh(y2), gelu_tanh(y3));
            *(u32x2*)(U + ((size_t)(b * SEQ + k * TC + tok)) * 4096 + g * 16 + 4 * fq) = w;
        }
        if (xi < xtot) { xpose_global_item(xi < xn2 ? xlo2 + xi : xlo + (xi - xn2), (LAS float*)ut, lane); xi += ngw; }
        if ((itn++ & 3) == 3 && xi < xtot) { xpose_global_item(xi < xn2 ? xlo2 + xi : xlo + (xi - xn2), (LAS float*)ut, lane); xi += ngw; }
    }
    for (; xi < xtot; xi += ngw) xpose_global_item(xi < xn2 ? xlo2 + xi : xlo + (xi - xn2), (LAS float*)ut, lane);
}

typedef float f32x16 __attribute__((ext_vector_type(16)));
constexpr int AT_KSTR = 144, AT_VSTR = 520, AT_K_OFF = 0, AT_V_OFF = 256 * AT_KSTR, AT_TBL_OFF = AT_V_OFF + 64 * AT_VSTR;
static_assert(AT_TBL_OFF + 8 * 512 <= RING_BYTES, "attention LDS");
__device__ __forceinline__ void phase_attn(int j, LAS unsigned char* lds) {
    PHASE_IDS();
    const bf16* QKV = (const bf16*)(ws + WS_QKV); bf16* O = (bf16*)(ws + WS_O);
    const float* sinks = in_ptr<12>() + j * 64; const float* relb = in_ptr<13>();
    const int qc = lane & 31, hh = lane >> 5;
    constexpr float LOG2E = 1.44269504089f;
    LAS float* tbl = (LAS float*)(lds + AT_TBL_OFF + wave * 512);
    for (int unit = blockIdx.x; unit < 512; unit += gridDim.x) {
        const int kvh = unit & 7, n = (unit >> 3) & 31, b = unit >> 8, h = kvh * 8 + wave;
        for (int i = lane; i < 128; i += 64) tbl[i] = relb[kBucket[i] * 64 + h] * LOG2E;
        const float sink2 = sinks[h] * LOG2E;
        const int pos0 = n * 128 - 128;
#pragma unroll
        for (int i = 0; i < 4; ++i) { const int c = tid + 512 * i, key = c >> 3, part = c & 7, pos = pos0 + key;
            u32x4 kv = {0u, 0u, 0u, 0u}, vv = {0u, 0u, 0u, 0u};
            if (pos >= 0) { const bf16* src = QKV + (size_t)(b * SEQ + pos) * NQKV + 4096 + kvh * 64 + part * 8; kv = *(const u32x4*)src; vv = *(const u32x4*)(src + 512); }
            *(LAS u32x4*)(lds + AT_K_OFF + key * AT_KSTR + part * 16) = kv;
            LAS unsigned short* vt = (LAS unsigned short*)(lds + AT_V_OFF + (part * 8) * AT_VSTR + key * 2);
#pragma unroll
            for (int e = 0; e < 4; ++e) { vt[(2 * e) * (AT_VSTR / 2)] = (unsigned short)(vv[e] & 0xffffu); vt[(2 * e + 1) * (AT_VSTR / 2)] = (unsigned short)(vv[e] >> 16); } }
        __syncthreads();
        for (int qb = 0; qb < 4; ++qb) {
            const bf16* qp = QKV + (size_t)(b * SEQ + n * 128 + 32 * qb + qc) * NQKV + h * 64 + 8 * hh;
            bf16x8 qf[4];
#pragma unroll
            for (int ks = 0; ks < 4; ++ks) qf[ks] = *(const bf16x8*)(qp + 16 * ks);
            f32x16 s[5];
#pragma unroll
            for (int jt = 0; jt < 5; ++jt) {
#pragma unroll
                for (int r = 0; r < 16; ++r) s[jt][r] = 0.f;
#pragma unroll
                for (int ks = 0; ks < 4; ++ks) { const bf16x8 kf = *(const LAS bf16x8*)(lds + AT_K_OFF + (32 * (qb + jt) + qc) * AT_KSTR + (16 * ks + 8 * hh) * 2);
                    s[jt] = __builtin_amdgcn_mfma_f32_32x32x16_bf16(kf, qf[ks], s[jt], 0, 0, 0); } }
            float mx = sink2;
#pragma unroll
            for (int jt = 0; jt < 5; ++jt) { const bool tile_dead = (n == 0) && (qb + jt < 4);
#pragma unroll
                for (int r = 0; r < 16; ++r) { const int krow = (r & 3) + 8 * (r >> 2) + 4 * hh, dist = 128 + qc - krow - 32 * jt;
                    bool valid = (jt == 0) ? (krow > qc) : ((jt == 4) ? (krow <= qc) : true); valid = valid && !tile_dead;
                    float t = s[jt][r] * (0.125f * LOG2E) + tbl[dist & 127]; t = valid ? t : -1e30f; s[jt][r] = t; mx = fmaxf(mx, t); } }
            mx = fmaxf(mx, __shfl_xor(mx, 32));
            float sum = 0.f;
#pragma unroll
            for (int jt = 0; jt < 5; ++jt)
#pragma unroll
                for (int r = 0; r < 16; ++r) { const float p = __builtin_amdgcn_exp2f(s[jt][r] - mx); s[jt][r] = p; sum += p; }
            sum += __shfl_xor(sum, 32); sum += __builtin_amdgcn_exp2f(sink2 - mx);
            const float inv = 1.0f / sum;
            f32x16 o[2];
#pragma unroll
            for (int dt = 0; dt < 2; ++dt)
#pragma unroll
                for (int r = 0; r < 16; ++r) o[dt][r] = 0.f;
#pragma unroll
            for (int jt = 0; jt < 5; ++jt)
#pragma unroll
                for (int s2 = 0; s2 < 2; ++s2) { u32x4 pw; pw.x = pk2(s[jt][8 * s2 + 0], s[jt][8 * s2 + 1]); pw.y = pk2(s[jt][8 * s2 + 2], s[jt][8 * s2 + 3]); pw.z = pk2(s[jt][8 * s2 + 4], s[jt][8 * s2 + 5]); pw.w = pk2(s[jt][8 * s2 + 6], s[jt][8 * s2 + 7]);
                    const bf16x8 pf = __builtin_bit_cast(bf16x8, pw);
#pragma unroll
                    for (int dt = 0; dt < 2; ++dt) { const LAS unsigned char* vp = lds + AT_V_OFF + (32 * dt + qc) * AT_VSTR + (32 * (qb + jt) + 16 * s2 + 4 * hh) * 2;
                        const u32x2 v0 = *(const LAS u32x2*)vp, v1 = *(const LAS u32x2*)(vp + 16); u32x4 vw; vw.x = v0.x; vw.y = v0.y; vw.z = v1.x; vw.w = v1.y;
                        o[dt] = __builtin_amdgcn_mfma_f32_32x32x16_bf16(__builtin_bit_cast(bf16x8, vw), pf, o[dt], 0, 0, 0); } }
            bf16* op = O + (size_t)(b * SEQ + n * 128 + 32 * qb + qc) * 4096 + h * 64;
#pragma unroll
            for (int dt = 0; dt < 2; ++dt)
#pragma unroll
                for (int g4 = 0; g4 < 4; ++g4) { u32x2 w; w.x = pk2(o[dt][4 * g4] * inv, o[dt][4 * g4 + 1] * inv); w.y = pk2(o[dt][4 * g4 + 2] * inv, o[dt][4 * g4 + 3] * inv);
                    *(u32x2*)(op + 32 * dt + 8 * g4 + 4 * hh) = w; }
        }
        __syncthreads();
    }
}

struct Args { const float* in[24]; float* out; unsigned char* ws; int ph_lo, ph_hi; };
__global__ void __launch_bounds__(NTHR, 2) fwd_kernel(Args args) {
    extern __shared__ __attribute__((aligned(16))) unsigned char lds_raw[];
    LAS unsigned char* lds = (LAS unsigned char*)lds_raw;
    for (int u = threadIdx.x; u < (LDS_BYTES - LDSCTL_OFF) / 4; u += NTHR) ((LAS unsigned*)(lds + LDSCTL_OFF))[u] = 0u;
    __syncthreads();
#if MK_ONE_LAUNCH
    const XcdBarrier bar = xcd_barrier_post((unsigned*)(ws_ptr() + WS_CTL) + CW_BAR, (volatile LAS unsigned*)(lds + MISC_OFF) + 8);
#define GRID_BAR() xcd_barrier(bar)
#else
#define GRID_BAR() do {} while (0)
#endif
    const int lo = args.ph_lo, hi = args.ph_hi;
#define IN(k) (lo <= (k) && (k) < hi)
#define SEAM() GRID_BAR()
#define WSP(off) (ws_ptr() + (off))
#define MODS_L(l) ((const float*)WSP(WS_MODSL) + (size_t)(l) * 2 * 6 * 4096)
#define XRES(l) ((l) == 0 ? in_ptr<0>() : (const float*)WSP(WS_X))

    if (IN(0)) phase0(lds);
    SEAM();
    if (IN(1)) phase1();
    SEAM();
    if (IN(2)) phase_modulate(in_ptr<0>(), MODS_L(0), 0, 1, (bf16*)WSP(WS_H));
    SEAM();

    for (int l = 0; l < 4; ++l) {
        const int pb = 3 + 8 * l, j = l >> 1;
        if ((l & 1) == 0) {
            if (IN(pb + 0)) phase_ssm_local(j, lds, l ? XS_L2S1_LO : XS_L0S1_LO, l ? XS_L2S1_HI : XS_L0S1_HI, l ? XS_L2S1X_LO : XS_L0S1X_LO, XS_X);
            SEAM();
            if (IN(pb + 1)) phase_ssm_carry(j);
            SEAM();
            if (IN(pb + 2)) phase_ssm_scan(j, lds, l ? XS_L2S3_LO : XS_L0S3_LO, l ? XS_L2S3_HI : XS_L0S3_HI, l ? XS_L2S3X_LO : XS_L0S3X_LO, XS_X);
            SEAM();
            if (IN(pb + 3)) {
                pg8::Gemm g{(const bf16*)WSP(WS_U), (const bf16*)WSP(WS_WGLU + j * SZ_WGLU), MROWS, 8192, 4096}; pg8::StaticOrder S; S.init(MROWS, 8192, gridDim.x, (int)blockIdx.x);
                pg8::EpiGLUY E{(bf16*)WSP(WS_Z), MODS_L(l) + 2 * 4096};
                pg8::gemm_phase<pg8::EpiGLUY, pg8::StaticOrder, true, true, 4096>(lds, g, S, E);
            }
            SEAM();
        } else {
            if (IN(pb + 0)) {
                pg8::Gemm g{(const bf16*)WSP(WS_H), (const bf16*)WSP(WS_WQKV + j * SZ_WQKV), MROWS, NQKV, 4096}; pg8::StaticOrder S; S.init(MROWS, NQKV, gridDim.x, (int)blockIdx.x);
                pg8::EpiQKV E{(bf16*)WSP(WS_QKV), NQKV, in_ptr<10>() + j * NQKV};
                pg8::gemm_phase<pg8::EpiQKV, pg8::StaticOrder, true, true, 4096>(lds, g, S, E);
                host_tail(lds, (MROWS / 256) * (NQKV / 256), l == 1 ? XS_T1Q_LO : XS_T3Q_LO, l == 1 ? XS_T1Q_HI : XS_T3Q_HI);
            }
            SEAM();
            if (IN(pb + 1)) phase_attn(j, lds);
            SEAM();
            if (IN(pb + 2)) {
                pg8::Gemm g{(const bf16*)WSP(WS_O), (const bf16*)WSP(WS_WO + j * SZ_WO), MROWS, 4096, 4096}; pg8::StaticOrder S; S.init(MROWS, 4096, gridDim.x, (int)blockIdx.x);
                pg8::EpiY E{(bf16*)WSP(WS_Z), MODS_L(l) + 2 * 4096};
                pg8::gemm_phase<pg8::EpiY, pg8::StaticOrder, true, true, 4096>(lds, g, S, E);
            }
            SEAM();
        }
        if (IN(pb + 4)) phase_ln1(lds, XRES(l), (const bf16*)WSP(WS_Z), in_ptr<5>() + (size_t)(l * 2 + 0) * 4096, in_ptr<6>() + (size_t)(l * 2 + 0) * 4096, MODS_L(l), (bf16*)WSP(WS_H));
        SEAM();
        if (IN(pb + 5)) {
            pg8::Gemm g{(const bf16*)WSP(WS_H), (const bf16*)WSP(WS_WIN + l * SZ_WIN), MROWS, 2 * DFF, 4096}; pg8::StaticOrder S; S.init(MROWS, 2 * DFF, gridDim.x, (int)blockIdx.x);
            pg8::EpiSwiGLU E{(bf16*)WSP(WS_ACT), DFF};
            pg8::gemm_phase<pg8::EpiSwiGLU, pg8::StaticOrder, true, true, 4096>(lds, g, S, E);
            if (l < 3) host_tail(lds, (MROWS / 256) * (2 * DFF / 256), l == 0 ? XS_T0_LO : (l == 1 ? XS_T1_LO : XS_T2_LO), l == 0 ? XS_T0_HI : (l == 1 ? XS_T1_HI : XS_T2_HI));
        }
        SEAM();
        if (IN(pb + 6)) {
            pg8::Gemm g{(const bf16*)WSP(WS_ACT), (const bf16*)WSP(WS_WDN + l * SZ_WDN), MROWS, 4096, DFF}; pg8::StaticOrder S; S.init(MROWS, 4096, gridDim.x, (int)blockIdx.x);
            pg8::EpiY E{(bf16*)WSP(WS_Z + SZ_H), MODS_L(l) + 5 * 4096};
            pg8::gemm_phase<pg8::EpiY, pg8::StaticOrder, true, true, DFF>(lds, g, S, E);
        }
        SEAM();
        if (IN(pb + 7)) phase_ln2(lds, XRES(l), (const bf16*)WSP(WS_Z), (const bf16*)WSP(WS_Z + SZ_H), in_ptr<5>() + (size_t)(l * 2 + 0) * 4096, in_ptr<6>() + (size_t)(l * 2 + 0) * 4096, in_ptr<5>() + (size_t)(l * 2 + 1) * 4096, in_ptr<6>() + (size_t)(l * 2 + 1) * 4096, (l == 3) ? out_ptr() : (float*)WSP(WS_X), MODS_L(l + 1), (l == 3) ? (bf16*)nullptr : (bf16*)WSP(WS_H));
        if (l < 3) SEAM();
    }
#undef IN
#undef SEAM
#undef GRID_BAR
}

extern "C" void kernel_launch(void* const* d_in, const int* in_sizes, int n_in, void* d_out, int out_size, void* d_ws, size_t ws_size, hipStream_t stream) {
    static int grid = 0;
    if (grid == 0) {
        if (n_in != 24 || out_size != MROWS * DM || ws_size < WS_END) { fprintf(stderr, "kernel_launch: unexpected problem (n_in %d, out %d, ws %zu < %zu)\n", n_in, out_size, ws_size, (size_t)WS_END); grid = -1; return; }
        int dev = 0, cus = 0, per_cu = 0;
        if (hipGetDevice(&dev) != hipSuccess || hipDeviceGetAttribute(&cus, hipDeviceAttributeMultiprocessorCount, dev) != hipSuccess) { grid = -1; return; }
        if (hipFuncSetAttribute((const void*)fwd_kernel, hipFuncAttributeMaxDynamicSharedMemorySize, LDS_BYTES) != hipSuccess) { fprintf(stderr, "kernel_launch: hipFuncSetAttribute failed\n"); grid = -1; return; }
        if (hipOccupancyMaxActiveBlocksPerMultiprocessor(&per_cu, (const void*)fwd_kernel, NTHR, LDS_BYTES) != hipSuccess || per_cu < 1) fprintf(stderr, "kernel_launch: occupancy query says %d\n", per_cu);
        (void)hipGetLastError();
        grid = cus;
    }
    if (grid < 0) return;
    (void)hipMemsetAsync((char*)d_ws + WS_CTL, 0, CTL_BYTES, stream);
    Args a{};
    for (int i = 0; i < 24; ++i) a.in[i] = (const float*)d_in[i];
    a.out = (float*)d_out; a.ws = (unsigned char*)d_ws;
#if MK_ONE_LAUNCH
    a.ph_lo = 0; a.ph_hi = N_PHASES;
    hipLaunchKernelGGL(fwd_kernel, dim3(grid), dim3(NTHR), LDS_BYTES, stream, a);
#else
    for (int ph = 0; ph < N_PHASES; ++ph) {
        if (ph >= 3 && ((ph - 3) & 7) == 3 && (((ph - 3) >> 3) & 1)) continue;
        a.ph_lo = ph; a.ph_hi = ph + 1;
        hipLaunchKernelGGL(fwd_kernel, dim3(grid), dim3(NTHR), LDS_BYTES, stream, a);
    }
#endif
}
```

```cpp
#include <hip/hip_runtime.h>
#include <cstdio>
#include <cstdint>
namespace pg8 {
#define PG8_LAS __attribute__((address_space(3)))
typedef unsigned short bf16_t;
typedef short bf16x8 __attribute__((ext_vector_type(8)));
typedef float f32x4 __attribute__((ext_vector_type(4)));
typedef unsigned u32x4 __attribute__((ext_vector_type(4)));
constexpr int BM = 256, BK = 64, HALF = 128, HTB = HALF * BK * 2  , STAGE_BYTES = 8 * HTB, NXCD = 8, WGM = 8;

__host__ __device__ __forceinline__ int lds_byte(int r, int c) { const int st = (r >> 4) * 2 + (c >> 5), rr = r & 15, cc = c & 31, ob = rr * 64 + cc * 2; return st * 1024 + (ob ^ (((ob >> 9) & 1) << 5)); }
__host__ __device__ __forceinline__ void stage_rc(int b, int& R, int& C) { const int st = b / 1024, sb = b % 1024, swz = sb ^ (((sb >> 9) & 1) << 5); R = (st >> 1) * 16 + swz / 64; C = (st & 1) * 32 + (swz % 64) / 2; }
__host__ __device__ __forceinline__ int perm32(int rho) { const int n = rho >> 4, i = rho & 15; return 8 * (i >> 2) + 4 * n + (i & 3); }

struct Unit { int pm, pn; };
struct Gemm { const bf16_t* A; const bf16_t* Bt; int M, N, K; };

struct StaticOrder {
    int nM, nN, nwg, G, c;
    __host__ __device__ void init(int M, int N, int G_, int c_) { nM = M / BM; nN = N / BM; nwg = nM * nN; G = G_; c = c_; }
    __host__ __device__ bool next(int i, Unit& u) const {
        const long L = (long)i * G + c; if (L >= nwg) return false;
        int wgid = (int)L; { const int q = nwg / NXCD, r = nwg % NXCD, xcd = wgid % NXCD, off = wgid / NXCD; wgid = (xcd < r ? xcd * (q + 1) : r * (q + 1) + (xcd - r) * q) + off; }
        const int nig = WGM * nN, gid = wgid / nig, fm = gid * WGM, gsz = (nM - fm) < WGM ? (nM - fm) : WGM;
        u.pm = fm + ((wgid % nig) % gsz); u.pn = (wgid % nig) / gsz; return true;
    }
    __device__ __forceinline__ void a_ready(const Unit&) const {}
    __device__ __forceinline__ void done(const Unit&) const {}
};
__device__ __forceinline__ unsigned cvt_pk_bf16(float lo, float hi) { unsigned r; asm volatile("v_cvt_pk_bf16_f32 %0, %1, %2" : "=v"(r) : "v"(lo), "v"(hi)); return r; }
typedef float f32x2 __attribute__((ext_vector_type(2)));
__device__ __forceinline__ float fast_sigmoid(float v) { return __builtin_amdgcn_rcpf(1.0f + __builtin_amdgcn_exp2f(-1.44269504089f * v)); }
constexpr float ALPHA_RES = 1.681792830507429f;

struct EpiQKV {
    static constexpr bool PERM = true, AFTER_DRAIN = false;
    bf16_t* O; int ldc; const float* bias;
    __device__ __forceinline__ void operator()(const f32x4 (&acc)[2][2][4][2], const Unit& u, int wr, int wc, int fr, int fq) const {
        const int row0 = u.pm * BM + wr * 64 + fr, col0 = u.pn * BM + wc * 32 + 8 * fq;
        f32x4 bv[2][2];
#pragma unroll
        for (int bj = 0; bj < 2; ++bj)
#pragma unroll
            for (int n = 0; n < 2; ++n) bv[bj][n] = *(const f32x4*)(bias + col0 + bj * HALF + 4 * n);
#pragma unroll
        for (int ai = 0; ai < 2; ++ai)
#pragma unroll
            for (int m = 0; m < 4; ++m) { bf16_t* rowp = O + (size_t)(row0 + ai * HALF + m * 16) * ldc + col0;
#pragma unroll
                for (int bj = 0; bj < 2; ++bj) { const f32x4 v0 = acc[ai][bj][m][0] + bv[bj][0], v1 = acc[ai][bj][m][1] + bv[bj][1];
                    u32x4 w; w.x = cvt_pk_bf16(v0[0], v0[1]); w.y = cvt_pk_bf16(v0[2], v0[3]); w.z = cvt_pk_bf16(v1[0], v1[1]); w.w = cvt_pk_bf16(v1[2], v1[3]);
                    *(u32x4*)(rowp + bj * HALF) = w; } }
    }
};
struct EpiSwiGLU {
    static constexpr bool PERM = true, AFTER_DRAIN = false;
    bf16_t* O; int ldc;
    __device__ __forceinline__ void operator()(const f32x4 (&acc)[2][2][4][2], const Unit& u, int wr, int wc, int fr, int fq) const {
        const int row0 = u.pm * BM + wr * 64 + fr, col0 = u.pn * HALF + wc * 32 + 8 * fq;
#pragma unroll
        for (int ai = 0; ai < 2; ++ai)
#pragma unroll
            for (int m = 0; m < 4; ++m) { bf16_t* rowp = O + (size_t)(row0 + ai * HALF + m * 16) * ldc + col0;
                float t[8], gu[8];
#pragma unroll
                for (int i = 0; i < 8; ++i) { const float g = acc[ai][0][m][i >> 2][i & 3]; t[i] = -1.44269504089f * g; gu[i] = g * acc[ai][1][m][i >> 2][i & 3]; }
#pragma unroll
                for (int i = 0; i < 8; ++i) t[i] = __builtin_amdgcn_exp2f(t[i]);
#pragma unroll
                for (int i = 0; i < 8; ++i) t[i] = t[i] + 1.0f;
#pragma unroll
                for (int i = 0; i < 8; ++i) t[i] = __builtin_amdgcn_rcpf(t[i]);
#pragma unroll
                for (int i = 0; i < 8; ++i) t[i] = t[i] * gu[i];
                asm volatile("" : "+v"(t[0]), "+v"(t[1]), "+v"(t[2]), "+v"(t[3]), "+v"(t[4]), "+v"(t[5]), "+v"(t[6]), "+v"(t[7]));
                u32x4 w; w.x = cvt_pk_bf16(t[0], t[1]); w.y = cvt_pk_bf16(t[2], t[3]); w.z = cvt_pk_bf16(t[4], t[5]); w.w = cvt_pk_bf16(t[6], t[7]);
                *(u32x4*)rowp = w; }
    }
};
struct EpiGLUY {
    static constexpr bool PERM = true, AFTER_DRAIN = false;
    bf16_t* Y; const float* gmod;
    __device__ __forceinline__ void operator()(const f32x4 (&acc)[2][2][4][2], const Unit& u, int wr, int wc, int fr, int fq) const {
        const int row0 = u.pm * BM + wr * 64 + fr, col0 = u.pn * HALF + wc * 32 + 8 * fq, b = u.pm >> 4;
        f32x4 gm[2];
#pragma unroll
        for (int n = 0; n < 2; ++n) gm[n] = *(const f32x4*)(gmod + (size_t)b * 6 * 4096 + col0 + 4 * n) + 1.0f;
#pragma unroll
        for (int ai = 0; ai < 2; ++ai)
#pragma unroll
            for (int m = 0; m < 4; ++m) { float r[8], t[8];
#pragma unroll
                for (int i = 0; i < 8; ++i) { t[i] = -1.44269504089f * acc[ai][1][m][i >> 2][i & 3]; r[i] = gm[i >> 2][i & 3] * acc[ai][0][m][i >> 2][i & 3]; }
#pragma unroll
                for (int i = 0; i < 8; ++i) t[i] = __builtin_amdgcn_exp2f(t[i]);
#pragma unroll
                for (int i = 0; i < 8; ++i) t[i] = t[i] + 1.0f;
#pragma unroll
                for (int i = 0; i < 8; ++i) t[i] = __builtin_amdgcn_rcpf(t[i]);
#pragma unroll
                for (int i = 0; i < 8; ++i) r[i] = r[i] * t[i];
                asm volatile("" : "+v"(r[0]), "+v"(r[1]), "+v"(r[2]), "+v"(r[3]), "+v"(r[4]), "+v"(r[5]), "+v"(r[6]), "+v"(r[7]));
                u32x4 w; w.x = cvt_pk_bf16(r[0], r[1]); w.y = cvt_pk_bf16(r[2], r[3]); w.z = cvt_pk_bf16(r[4], r[5]); w.w = cvt_pk_bf16(r[6], r[7]);
                *(u32x4*)(Y + (size_t)(row0 + ai * HALF + m * 16) * 4096 + col0) = w; }
    }
};
struct EpiY {
    static constexpr bool PERM = true, AFTER_DRAIN = false;
    bf16_t* Y; const float* gmod;
    __device__ __forceinline__ void operator()(const f32x4 (&acc)[2][2][4][2], const Unit& u, int wr, int wc, int fr, int fq) const {
        const int row0 = u.pm * BM + wr * 64 + fr, col0 = u.pn * BM + wc * 32 + 8 * fq, b = u.pm >> 4;
        f32x4 gm[2][2];
#pragma unroll
        for (int bj = 0; bj < 2; ++bj)
#pragma unroll
            for (int n = 0; n < 2; ++n) gm[bj][n] = *(const f32x4*)(gmod + (size_t)b * 6 * 4096 + col0 + bj * HALF + 4 * n) + 1.0f;
#pragma unroll
        for (int ai = 0; ai < 2; ++ai)
#pragma unroll
            for (int m = 0; m < 4; ++m) { bf16_t* rowp = Y + (size_t)(row0 + ai * HALF + m * 16) * 4096 + col0;
#pragma unroll
                for (int bj = 0; bj < 2; ++bj) { const f32x4 v0 = acc[ai][bj][m][0] * gm[bj][0], v1 = acc[ai][bj][m][1] * gm[bj][1];
                    u32x4 w; w.x = cvt_pk_bf16(v0[0], v0[1]); w.y = cvt_pk_bf16(v0[2], v0[3]); w.z = cvt_pk_bf16(v1[0], v1[1]); w.w = cvt_pk_bf16(v1[2], v1[3]);
                    *(u32x4*)(rowp + bj * HALF) = w; } }
    }
};
template <class Epi, class Sched, bool ALIGN_EPI, bool SP2, int KD>
__device__ __forceinline__ void gemm_phase(PG8_LAS unsigned char* lds, const Gemm g, const Sched& S, const Epi& E) {
    int tid_ = threadIdx.x; asm volatile("" : "+v"(tid_));
    const int tid = tid_, wid = __builtin_amdgcn_readfirstlane(tid >> 6), lane = tid & 63, wr = wid >> 2, wc = wid & 3, fr = lane & 15, fq = lane >> 4;
    constexpr int K = KD, nt = K / BK; static_assert(KD % 128 == 0 && KD >= 256, "K");
    unsigned voffA[2], voffB[2];
#pragma unroll
    for (int i = 0; i < 2; ++i) { int R, C; stage_rc(tid * 16 + i * 8192, R, C); const int Rb = Epi::PERM ? ((R & ~31) + perm32(R & 31)) : R;
        voffA[i] = (unsigned)(R * K + C) * 2u; voffB[i] = (unsigned)(Rb * K + C) * 2u; }
    const size_t kstep = (size_t)(BK * 2);
    const size_t hstep = (size_t)HALF * K * 2;
    const size_t tstep = 2 * hstep;
    const unsigned ldsw = (unsigned)wid * 1024u;
    const int aoff = lds_byte(wr * 64 + fr, fq * 8), boff = lds_byte(wc * 32 + fr, fq * 8);
#define PG8_SA(b, h) (((b) * 2 + (h)) * HTB)
#define PG8_SB(b, h) ((4 + (b) * 2 + (h)) * HTB)
#define PG8_STAGE(bufoff, gbase, voff) do { _Pragma("unroll") for (int _i = 0; _i < 2; ++_i) \
        __builtin_amdgcn_global_load_lds((const unsigned*)((const char*)(gbase) + (voff)[_i]), (PG8_LAS unsigned*)(lds + (bufoff) + ldsw + _i * 8192), 16, 0, 0); } while (0)
#define PG8_LDA(dst, b, h) do { _Pragma("unroll") for (int m = 0; m < 4; ++m) _Pragma("unroll") for (int k = 0; k < 2; ++k) dst[m][k] = *(const PG8_LAS bf16x8*)(lds + PG8_SA(b, h) + aoff + m * 2048 + k * 1024); } while (0)
#define PG8_LDB(dst, b, h) do { _Pragma("unroll") for (int n = 0; n < 2; ++n) _Pragma("unroll") for (int k = 0; k < 2; ++k) dst[n][k] = *(const PG8_LAS bf16x8*)(lds + PG8_SB(b, h) + boff + n * 2048 + k * 1024); } while (0)
#define PG8_MMA(ai, bj, At, Bt) do { __builtin_amdgcn_s_setprio(1); _Pragma("unroll") for (int m = 0; m < 4; ++m) _Pragma("unroll") for (int n = 0; n < 2; ++n) _Pragma("unroll") for (int k = 0; k < 2; ++k) \
        acc[ai][bj][m][n] = __builtin_amdgcn_mfma_f32_16x16x32_bf16(Bt[n][k], At[m][k], acc[ai][bj][m][n], 0, 0, 0); __builtin_amdgcn_s_setprio(0); } while (0)
#define PG8_WAIT_V(n) asm volatile("s_waitcnt vmcnt(" #n ")" ::: "memory")
#define PG8_WAIT_L(n) asm volatile("s_waitcnt lgkmcnt(" #n ")" ::: "memory")
#define PG8_BAR __builtin_amdgcn_s_barrier()
#define PG8_SCHED __builtin_amdgcn_sched_barrier(0)
    Unit cur, nxt; int ui = 0;
    if (!S.next(0, cur)) return;
    f32x4 acc[2][2][4][2];
#pragma unroll
    for (int a = 0; a < 2; ++a)
#pragma unroll
        for (int b = 0; b < 2; ++b)
#pragma unroll
            for (int m = 0; m < 4; ++m)
#pragma unroll
                for (int n = 0; n < 2; ++n) acc[a][b][m][n] = (f32x4){0.f, 0.f, 0.f, 0.f};
    bf16x8 At[4][2], B0[2][2], B1[2][2];
    const char* cA = (const char*)g.A + (size_t)cur.pm * tstep; const char* cB = (const char*)g.Bt + (size_t)cur.pn * tstep;
    S.a_ready(cur);
    if constexpr (SP2) {
        PG8_STAGE(PG8_SB(0, 0), cB, voffB); PG8_STAGE(PG8_SB(0, 1), cB + hstep, voffB); PG8_STAGE(PG8_SA(0, 0), cA, voffA); PG8_STAGE(PG8_SA(0, 1), cA + hstep, voffA);
        if (wr == 1) PG8_BAR;
        PG8_WAIT_V(2); PG8_BAR;
        PG8_STAGE(PG8_SB(1, 0), cB + kstep, voffB); PG8_STAGE(PG8_SA(1, 0), cA + kstep, voffA); PG8_STAGE(PG8_SB(1, 1), cB + hstep + kstep, voffB);
        PG8_WAIT_V(6); PG8_BAR;
    } else {
        PG8_STAGE(PG8_SB(0, 0), cB, voffB); PG8_STAGE(PG8_SA(0, 0), cA, voffA); PG8_STAGE(PG8_SB(0, 1), cB + hstep, voffB); PG8_STAGE(PG8_SA(0, 1), cA + hstep, voffA);
        if (wr == 1) PG8_BAR;
        PG8_WAIT_V(4); PG8_BAR;
        PG8_STAGE(PG8_SB(1, 0), cB + kstep, voffB); PG8_STAGE(PG8_SA(1, 0), cA + kstep, voffA); PG8_STAGE(PG8_SB(1, 1), cB + hstep + kstep, voffB);
        PG8_WAIT_V(6); PG8_BAR;
    }
    for (;;) {
        const bool has_next = S.next(ui + 1, nxt);
        const char* nA = has_next ? (const char*)g.A + (size_t)nxt.pm * tstep : cA; const char* nB = has_next ? (const char*)g.Bt + (size_t)nxt.pn * tstep : cB;
        for (int t = 0; t < nt; t += 2) {
            const bool last = (t == nt - 2);
            const char* a1 = cA + (size_t)(t + 1) * kstep;
            const char* a2 = last ? nA : cA + (size_t)(t + 2) * kstep; const char* b2 = last ? nB : cB + (size_t)(t + 2) * kstep;
            const char* a3 = a2 + kstep; const char* b3 = b2 + kstep;
            if (last && has_next) S.a_ready(nxt);
            if constexpr (SP2) {
            PG8_LDB(B0, 0, 0); PG8_LDB(B1, 0, 1); PG8_SCHED; PG8_LDA(At, 0, 0); PG8_STAGE(PG8_SA(1, 1), a1 + hstep, voffA);
            PG8_WAIT_V(8); PG8_WAIT_L(0); PG8_BAR; PG8_MMA(0, 0, At, B0); PG8_MMA(0, 1, At, B1); PG8_BAR; PG8_SCHED;
            PG8_LDA(At, 0, 1); PG8_STAGE(PG8_SB(0, 0), b2, voffB); PG8_STAGE(PG8_SB(0, 1), b2 + hstep, voffB); PG8_STAGE(PG8_SA(0, 0), a2, voffA);
            PG8_WAIT_V(8); PG8_WAIT_L(0); PG8_BAR; PG8_MMA(1, 0, At, B0); PG8_MMA(1, 1, At, B1); PG8_BAR; PG8_SCHED;
            PG8_LDB(B0, 1, 0); PG8_LDB(B1, 1, 1); PG8_SCHED; PG8_LDA(At, 1, 0); PG8_STAGE(PG8_SA(0, 1), a2 + hstep, voffA);
            PG8_WAIT_V(8); PG8_WAIT_L(0); PG8_BAR; PG8_MMA(0, 0, At, B0); PG8_MMA(0, 1, At, B1); PG8_BAR; PG8_SCHED;
            PG8_LDA(At, 1, 1); PG8_STAGE(PG8_SB(1, 0), b3, voffB); PG8_STAGE(PG8_SB(1, 1), b3 + hstep, voffB); PG8_STAGE(PG8_SA(1, 0), a3, voffA);
            PG8_WAIT_V(8); PG8_WAIT_L(0); PG8_BAR; PG8_MMA(1, 0, At, B0); PG8_MMA(1, 1, At, B1); PG8_BAR; PG8_SCHED;
            } else {
            PG8_LDB(B0, 0, 0); PG8_SCHED; PG8_LDA(At, 0, 0); PG8_STAGE(PG8_SA(1, 1), a1 + hstep, voffA);
            PG8_WAIT_L(8); PG8_BAR; PG8_WAIT_L(0); PG8_MMA(0, 0, At, B0); PG8_BAR; PG8_SCHED;
            PG8_LDB(B1, 0, 1); PG8_STAGE(PG8_SB(0, 0), b2, voffB);
            PG8_BAR; PG8_WAIT_L(0); PG8_MMA(0, 1, At, B1); PG8_BAR;
            PG8_LDA(At, 0, 1); PG8_STAGE(PG8_SA(0, 0), a2, voffA);
            PG8_BAR; PG8_WAIT_L(0); PG8_MMA(1, 0, At, B0); PG8_BAR; PG8_SCHED;
            PG8_STAGE(PG8_SB(0, 1), b2 + hstep, voffB);
            PG8_WAIT_V(6); PG8_BAR; PG8_MMA(1, 1, At, B1); PG8_BAR;
            PG8_LDB(B0, 1, 0); PG8_SCHED; PG8_LDA(At, 1, 0); PG8_STAGE(PG8_SA(0, 1), a2 + hstep, voffA);
            PG8_WAIT_L(8); PG8_BAR; PG8_WAIT_L(0); PG8_MMA(0, 0, At, B0); PG8_BAR; PG8_SCHED;
            PG8_LDB(B1, 1, 1); PG8_STAGE(PG8_SB(1, 0), b3, voffB);
            PG8_BAR; PG8_WAIT_L(0); PG8_MMA(0, 1, At, B1); PG8_BAR;
            PG8_LDA(At, 1, 1); PG8_STAGE(PG8_SA(1, 0), a3, voffA);
            PG8_BAR; PG8_WAIT_L(0); PG8_MMA(1, 0, At, B0); PG8_BAR; PG8_SCHED;
            PG8_STAGE(PG8_SB(1, 1), b3 + hstep, voffB);
            PG8_WAIT_V(6); PG8_BAR; PG8_MMA(1, 1, At, B1); PG8_BAR;
            }
        }
        if constexpr (ALIGN_EPI) { if (wr == 0) PG8_BAR; }
        if constexpr (!Epi::AFTER_DRAIN) { E(acc, cur, wr, wc, fr, fq); S.done(cur); }
        if (!has_next) break;
#pragma unroll
        for (int a = 0; a < 2; ++a)
#pragma unroll
            for (int b = 0; b < 2; ++b)
#pragma unroll
                for (int m = 0; m < 4; ++m)
#pragma unroll
                    for (int n = 0; n < 2; ++n) acc[a][b][m][n] = (f32x4){0.f, 0.f, 0.f, 0.f};
        cur = nxt; cA = nA; cB = nB; ++ui;
        if constexpr (ALIGN_EPI) { if (wr == 1) PG8_BAR; }
    }
    PG8_WAIT_V(0);
    if constexpr (!ALIGN_EPI) { if (wr == 0) PG8_BAR; }
    PG8_BAR;
    if constexpr (Epi::AFTER_DRAIN) { E.fused(acc, cur, wr, wc, fr, fq, lds, wid, lane); S.done(cur); }
#undef PG8_SA
#undef PG8_SB
#undef PG8_STAGE
#undef PG8_LDA
#undef PG8_LDB
#undef PG8_MMA
#undef PG8_WAIT_V
#undef PG8_WAIT_L
#undef PG8_BAR
#undef PG8_SCHED
}
}

#ifndef MK_ONE_LAUNCH
#define MK_ONE_LAUNCH 1
#endif
constexpr int NWAVES = 8, NTHR = 512;
constexpr int DM = 4096, SEQ = 4096, MROWS = 8192, DFF = 11008, NQKV = 5120;
constexpr int TC = 64, NCHUNK = 64;
constexpr float LN_EPS = 1e-5f;
constexpr int N_PHASES = 3 + 8 * 4;

#define GAS __attribute__((address_space(1)))
#define LAS __attribute__((address_space(3)))
typedef unsigned short bf16;
typedef float f32x4 __attribute__((ext_vector_type(4)));
typedef unsigned u32x4 __attribute__((ext_vector_type(4)));
typedef unsigned u32x2 __attribute__((ext_vector_type(2)));
typedef short bf16x8 __attribute__((ext_vector_type(8)));

constexpr size_t MiB = 1u << 20;
constexpr size_t alignup(size_t x) { return (x + MiB - 1) & ~(MiB - 1); }
constexpr size_t WS_CTL = 0, CTL_BYTES = 1 * MiB;
constexpr size_t WS_MODP = 1 * MiB,                    SZ_MODP = 64ull * 2 * 24576 * 4;
constexpr size_t WS_MODSL = alignup(WS_MODP + SZ_MODP), SZ_MODSL = 4ull * 2 * 6 * 4096 * 4;
constexpr size_t WS_ABAR = alignup(WS_MODSL + SZ_MODSL), SZ_ABAR = 2ull * 256 * 2 * 64 * 4;
constexpr size_t WS_ABART = alignup(WS_ABAR + SZ_ABAR);
constexpr size_t WS_BBAR = alignup(WS_ABART + SZ_ABAR), SZ_BBAR = 2ull * 256 * 8 * 64 * 16;
constexpr size_t WS_E = alignup(WS_BBAR + SZ_BBAR),     SZ_E = 2ull * 64 * 256 * 2 * 64 * 4;
constexpr size_t SZ_WIN = 22016ull * 4096 * 2, SZ_WDN = 4096ull * 11008 * 2, SZ_WGLU = 8192ull * 4096 * 2, SZ_WQKV = 5120ull * 4096 * 2, SZ_WO = 4096ull * 4096 * 2;
constexpr size_t WS_SP = alignup(WS_E + SZ_E);
constexpr size_t WS_WIN = alignup(WS_SP + SZ_E);
constexpr size_t WS_WDN = alignup(WS_WIN + 4 * SZ_WIN);
constexpr size_t WS_WGLU = alignup(WS_WDN + 4 * SZ_WDN);
constexpr size_t WS_WQKV = alignup(WS_WGLU + 2 * SZ_WGLU);
constexpr size_t WS_WO = alignup(WS_WQKV + 2 * SZ_WQKV);
constexpr size_t WS_H = alignup(WS_WO + 2 * SZ_WO),    SZ_H = 8192ull * 4096 * 2;
constexpr size_t WS_ACT = alignup(WS_H + SZ_H),        SZ_ACT = 8192ull * 11008 * 2;
constexpr size_t WS_Z = alignup(WS_ACT + SZ_ACT),      SZ_Z = 8192ull * 4096 * 4;
constexpr size_t WS_X = alignup(WS_Z + SZ_Z);
constexpr size_t WS_X2 = alignup(WS_X + SZ_Z);
constexpr size_t WS_QKV = alignup(WS_X2 + SZ_Z),        SZ_QKV = 8192ull * 5120 * 2;
constexpr size_t WS_O = alignup(WS_QKV + SZ_QKV);
constexpr size_t WS_U = alignup(WS_O + SZ_H);
constexpr size_t WS_END = alignup(WS_U + SZ_H);
constexpr int CW_BAR = 4096;

constexpr int RING_BYTES = 131072, LDSCTL_OFF = RING_BYTES, MISC_OFF = LDSCTL_OFF + 320, LDS_BYTES = 147456;

__device__ __forceinline__ unsigned pk2(float lo, float hi) { return pg8::cvt_pk_bf16(lo, hi); }
__device__ __forceinline__ float bf_lo(unsigned w) { return __uint_as_float(w << 16); }
__device__ __forceinline__ float bf_hi(unsigned w) { return __uint_as_float(w & 0xffff0000u); }
__device__ __forceinline__ float wave_sum(float v) {
#pragma unroll
    for (int o = 1; o < 64; o <<= 1) v += __shfl_xor(v, o);
    return v;
}

#define XB_TMO      128
#define XB_XCNT(j)  (256  + 64 * (j))
#define XB_XSUB(j)  (1280 + 64 * (j))
#define XB_XGEN(j)  (2304 + 64 * (j))
#define XB_TOP      3328
#define XB_TOPGEN   3392
#define XCD_BAR_WORDS 3456
#define XB_SPIN_CAP (1u << 20)

__device__ __forceinline__ unsigned xb_ld(unsigned* p)              { return __hip_atomic_load(p, __ATOMIC_RELAXED, __HIP_MEMORY_SCOPE_AGENT); }
__device__ __forceinline__ unsigned xb_add(unsigned* p, unsigned v) { return __hip_atomic_fetch_add(p, v, __ATOMIC_RELAXED, __HIP_MEMORY_SCOPE_AGENT); }
__device__ __forceinline__ unsigned xb_xcc_id() { return (unsigned)__builtin_amdgcn_s_getreg((3 << 11) | 20) & 0xFu; }
#define XB_SPIN(cond, bar) do { unsigned _sp = 0; while (cond) { __builtin_amdgcn_s_sleep(1); \
    if ((++_sp & 255u) == 0u) { if (xb_ld(&(bar)[XB_TMO])) break; if (_sp > XB_SPIN_CAP) { atomicAdd(&(bar)[XB_TMO], 1u); break; } } } } while (0)

struct XcdBarrier { unsigned* bar; unsigned x; volatile LAS unsigned* st; };
__device__ __forceinline__ XcdBarrier xcd_barrier_post(unsigned* bar, volatile LAS unsigned* st) {
    XcdBarrier b; b.bar = bar; b.x = xb_xcc_id(); b.st = st;
    if (threadIdx.x == 0) (void)xb_add(&bar[XB_XCNT(b.x)], 1u);
    return b;
}
__device__ __forceinline__ void xcd_barrier_complete(unsigned* bar, unsigned x, unsigned& nloc, unsigned& nx) {
    const unsigned G = gridDim.x * gridDim.y * gridDim.z;
    unsigned sum, cnt, mine, sp = 0u;
    for (;;) {
        sum = 0u; cnt = 0u; mine = 0u;
#pragma unroll
        for (unsigned j = 0; j < 16; ++j) { const unsigned c = xb_ld(&bar[XB_XCNT(j)]); sum += c; cnt += (c > 0u) ? 1u : 0u; mine = (j == x) ? c : mine; }
        if (sum == G) break;
        __builtin_amdgcn_s_sleep(1);
        if ((++sp & 255u) == 0u) { if (xb_ld(&bar[XB_TMO])) break; if (sp > XB_SPIN_CAP) { atomicAdd(&bar[XB_TMO], 1u); break; } }
    }
    nloc = mine > 0u ? mine : 1u; nx = cnt > 0u ? cnt : 1u;
}
__device__ __forceinline__ void xcd_barrier(const XcdBarrier& b) {
    asm volatile("s_waitcnt vmcnt(0)" ::: "memory");
    __syncthreads();
    if (threadIdx.x == 0) {
        unsigned* bar = b.bar;
        __builtin_amdgcn_s_waitcnt(0);
        unsigned nloc = b.st[0], nx = b.st[1];
        if (nloc == 0u) { xcd_barrier_complete(bar, b.x, nloc, nx); b.st[0] = nloc; b.st[1] = nx; }
        const unsigned old = xb_add(&bar[XB_XSUB(b.x)], 1u);
        const unsigned gen = old / nloc;
        if (old + 1u == (gen + 1u) * nloc) {
            __builtin_amdgcn_fence(__ATOMIC_RELEASE, "agent");
            asm volatile("s_waitcnt vmcnt(0)" ::: "memory");
            const unsigned og = xb_add(&bar[XB_TOP], 1u);
            const unsigned tg = og / nx;
            if (og + 1u == (tg + 1u) * nx) xb_add(&bar[XB_TOPGEN], 1u);
            else XB_SPIN(xb_ld(&bar[XB_TOPGEN]) == tg, bar);
            __builtin_amdgcn_fence(__ATOMIC_ACQUIRE, "agent");
            xb_add(&bar[XB_XGEN(b.x)], 1u);
            asm volatile("s_waitcnt vmcnt(0)" ::: "memory");
        } else {
            XB_SPIN(xb_ld(&bar[XB_XGEN(b.x)]) == gen, bar);
            __builtin_amdgcn_fence(__ATOMIC_ACQUIRE, "agent");
            asm volatile("s_waitcnt vmcnt(0)" ::: "memory");
        }
    }
    __syncthreads();
}

__device__ const unsigned char kBucket[128] = {0, 1, 2, 3, 4, 5, 6, 7, 8, 9, 10, 11, 12, 13, 14, 15, 16, 16, 16, 17, 17, 18, 18, 18, 19, 19, 19, 20, 20, 20, 20, 21, 21, 21, 21, 22, 22, 22, 22, 22, 23, 23, 23, 23, 23, 23,
    24, 24, 24, 24, 24, 24, 25, 25, 25, 25, 25, 25, 25, 26, 26, 26, 26, 26, 26, 26, 26, 27, 27, 27, 27, 27, 27, 27, 27, 27, 27, 28, 28, 28, 28, 28, 28, 28, 28, 28, 28, 29, 29, 29, 29, 29, 29, 29, 29, 29, 29, 29, 29,
    30, 30, 30, 30, 30, 30, 30, 30, 30, 30, 30, 30, 30, 30, 31, 31, 31, 31, 31, 31, 31, 31, 31, 31, 31, 31, 31, 31, 31};

__device__ __forceinline__ void p0_transpose_item(const float* W, int K, int N, int ldw, bf16* WT, int mode, LAS float* scr, int item, int lane) {
    const int nblk = N / 32, kb = item / nblk, nb = item % nblk, k0 = 64 * kb, n0 = 32 * nb;
    const int r0 = mode == 0 ? n0 : (256 * (n0 >> 7) + 128 * (mode - 1) + (n0 & 127));
    f32x4 v[8];
#pragma unroll
    for (int i = 0; i < 8; ++i) v[i] = __builtin_nontemporal_load((const f32x4*)(W + (size_t)(k0 + 8 * i + (lane >> 3)) * ldw + n0 + 4 * (lane & 7)));
#pragma unroll
    for (int i = 0; i < 8; ++i) { LAS float* d = scr + (8 * i + (lane >> 3)) * 33 + 4 * (lane & 7); d[0] = v[i][0]; d[1] = v[i][1]; d[2] = v[i][2]; d[3] = v[i][3]; }
    asm volatile("s_waitcnt lgkmcnt(0)" ::: "memory");
    const int c = lane & 7;
#pragma unroll
    for (int j = 0; j < 4; ++j) { const int n = (lane >> 3) + 8 * j; const LAS float* s = scr + (8 * c) * 33 + n;
        u32x4 o; o.x = pk2(s[0 * 33], s[1 * 33]); o.y = pk2(s[2 * 33], s[3 * 33]); o.z = pk2(s[4 * 33], s[5 * 33]); o.w = pk2(s[6 * 33], s[7 * 33]);
        __builtin_nontemporal_store(o, (u32x4*)(WT + (size_t)(r0 + n) * K + k0 + 8 * c)); }
    asm volatile("s_waitcnt lgkmcnt(0)" ::: "memory");
}

template <int I> __device__ __forceinline__ const float* in_ptr() {
    unsigned long long v; const unsigned long long kav = (unsigned long long)__builtin_amdgcn_kernarg_segment_ptr();
    const unsigned ka_lo = __builtin_amdgcn_readfirstlane((unsigned)kav), ka_hi = __builtin_amdgcn_readfirstlane((unsigned)(kav >> 32));
    const unsigned long long ka = ((unsigned long long)ka_hi << 32) | ka_lo;
    asm volatile("s_load_dwordx2 %0, %1, %2\n\ts_waitcnt lgkmcnt(0)" : "=s"(v) : "s"(ka), "n"(I * 8));
    return (const float*)(const GAS float*)v;
}
__device__ __forceinline__ unsigned char* ws_ptr() { return (unsigned char*)in_ptr<25>(); }
__device__ __forceinline__ float* out_ptr() { return (float*)in_ptr<24>(); }
#define PHASE_IDS() int tid_ = threadIdx.x; asm volatile("" : "+v"(tid_)); const int tid = tid_, lane = tid & 63, wave = __builtin_amdgcn_readfirstlane(tid >> 6); (void)lane; (void)wave; unsigned char* const ws = ws_ptr(); (void)ws
constexpr int XP_IT_A = 64 * 344, XP_IT_SQ = 64 * 128, XP_IT_QKV = 64 * 160, XP_PER_L = 3 * XP_IT_A, XP_PER_J = 3 * XP_IT_SQ + XP_IT_QKV;
static_assert((11008 / 64) * (4096 / 32) == XP_IT_A, "w_down items");
constexpr int XG_MIX0 = 0, XG_FFN0 = XG_MIX0 + XP_PER_J, XG_FFN1 = XG_FFN0 + XP_PER_L, XG_GLU1 = XG_FFN1 + XP_PER_L, XG_FFN2 = XG_GLU1 + 2 * XP_IT_SQ, XG_QKVO1 = XG_FFN2 + XP_PER_L,
              XG_FFN3 = XG_QKVO1 + XP_IT_QKV + XP_IT_SQ, XG_END = XG_FFN3 + XP_PER_L;
static_assert(XG_FFN0 == 34816 && XG_FFN1 == 100864 && XG_GLU1 == 166912 && XG_FFN2 == 183296 && XG_QKVO1 == 249344 && XG_FFN3 == 267776 && XG_END == 333824, "conversion list");
constexpr int XS_P0A_LO = 0, XS_P0A_HI = XG_FFN0;
constexpr int XS_L0S1_LO = XG_FFN0, XS_L0S1_HI = XG_FFN0 + XP_PER_L / 2, XS_L0S3_LO = XS_L0S1_HI, XS_L0S3_HI = XG_FFN1;
constexpr int XS_T0_LO = XG_FFN1, XS_T0_HI = XG_FFN1 + 16384;
constexpr int XS_T1Q_LO = XS_T0_HI, XS_T1Q_HI = XS_T0_HI + 32768;
constexpr int XS_X = 8448;
constexpr int XS_L0S1X_LO = XS_T1Q_HI, XS_L0S3X_LO = XS_T1Q_HI + XS_X;
constexpr int XS_P0B_LO = XS_T1Q_HI + 2 * XS_X, XS_P0B_HI = XG_GLU1;
constexpr int XS_T1_LO = XG_GLU1, XS_T1_HI = XG_FFN2;
constexpr int XS_L2S1_LO = XG_FFN2, XS_L2S1_HI = XG_FFN2 + XP_PER_L / 2, XS_L2S3_LO = XS_L2S1_HI, XS_L2S3_HI = XG_QKVO1;
constexpr int XS_T2_LO = XG_QKVO1, XS_T2_HI = XG_QKVO1 + 16384;
constexpr int XS_T3Q_LO = XS_T2_HI, XS_T3Q_HI = XS_T2_HI + 32768;
constexpr int XS_L2S1X_LO = XS_T3Q_HI, XS_L2S3X_LO = XS_T3Q_HI + XS_X;
constexpr int XS_P0C_LO = XS_T3Q_HI + 2 * XS_X, XS_P0C_HI = XG_END;
static_assert(XS_P0B_LO <= XS_P0B_HI && XS_P0C_LO <= XS_P0C_HI && XS_T1Q_HI < XG_GLU1 && XS_T2_HI > XG_QKVO1 + XP_IT_QKV && XS_T2_HI < XG_FFN3 && XS_T3Q_HI < XG_END, "conversion deal");
__device__ __forceinline__ void xpose_global_item(int idx, LAS float* scr, int lane) {
    unsigned char* const ws = ws_ptr();
    const float* W; bf16* WT; int K = 4096, N = 4096, ldw = 4096, mode = 0, r;
    const bool mix = idx < XG_FFN0 || (idx >= XG_GLU1 && idx < XG_FFN2) || (idx >= XG_QKVO1 && idx < XG_FFN3);
    if (!mix) {
        int l, base;
        if (idx < XG_FFN1) { l = 0; base = XG_FFN0; } else if (idx < XG_GLU1) { l = 1; base = XG_FFN1; } else if (idx < XG_QKVO1) { l = 2; base = XG_FFN2; } else { l = 3; base = XG_FFN3; }
        r = idx - base; const int which = r / XP_IT_A; r -= which * XP_IT_A;
        if (which < 2) { W = in_ptr<7>() + (size_t)l * 4096 * 22016 + which * 11008; N = 11008; ldw = 22016; WT = (bf16*)(ws + WS_WIN + l * SZ_WIN); mode = 1 + which; }
        else { W = in_ptr<8>() + (size_t)l * 11008 * 4096; K = 11008; WT = (bf16*)(ws + WS_WDN + l * SZ_WDN); }
    } else {
        int j;
        if (idx < XG_FFN0) { j = 0; r = idx; } else if (idx < XG_FFN2) { j = 1; r = idx - XG_GLU1; } else { j = 1; r = idx - XG_QKVO1 + 2 * XP_IT_SQ; }
        if (r < XP_IT_SQ) { W = in_ptr<22>() + (size_t)j * 4096 * 4096; WT = (bf16*)(ws + WS_WGLU + j * SZ_WGLU); mode = 1; }
        else if (r < 2 * XP_IT_SQ) { W = in_ptr<23>() + (size_t)j * 4096 * 4096; WT = (bf16*)(ws + WS_WGLU + j * SZ_WGLU); mode = 2; r -= XP_IT_SQ; }
        else if (r < 2 * XP_IT_SQ + XP_IT_QKV) { W = in_ptr<9>() + (size_t)j * 4096 * 5120; N = 5120; ldw = 5120; WT = (bf16*)(ws + WS_WQKV + j * SZ_WQKV); r -= 2 * XP_IT_SQ; }
        else { W = in_ptr<11>() + (size_t)j * 4096 * 4096; WT = (bf16*)(ws + WS_WO + j * SZ_WO); r -= 2 * XP_IT_SQ + XP_IT_QKV; }
    }
    p0_transpose_item(W, K, N, ldw, WT, mode, scr, r, lane);
}
__device__ __forceinline__ void host_tail(LAS unsigned char* lds, int nunits, int lo, int hi) {
    PHASE_IDS();
    const int first = nunits % (int)gridDim.x;
    if ((int)blockIdx.x < first) return;
    const int nw = ((int)gridDim.x - first) * NWAVES, w = ((int)blockIdx.x - first) * NWAVES + wave;
    LAS float* scr = (LAS float*)(lds + wave * 16384);
    for (int it = lo + w; it < hi; it += nw) xpose_global_item(it, scr, lane);
}

__device__ __forceinline__ void phase0(LAS unsigned char* lds) {
    PHASE_IDS();
    const int gw = blockIdx.x * NWAVES + wave, ngw = gridDim.x * NWAVES, gtid = blockIdx.x * NTHR + tid, gthr = gridDim.x * NTHR;
    {
        LAS float* sc = (LAS float*)lds;
        const float* c = in_ptr<1>();
        for (int i = tid; i < 2 * 4096; i += NTHR) { const float v = c[i]; sc[i] = v / (1.0f + expf(-v)); }
        __syncthreads();
        const float* w_ada = in_ptr<2>(); float* modp = (float*)(ws + WS_MODP);
        for (int it = gw; it < 96 * 64; it += ngw) {
            const int cb = it % 96, ks = it / 96;
            const float* wp = w_ada + (size_t)(ks * 64) * 24576 + cb * 256 + lane * 4;
            f32x4 a0 = {0.f, 0.f, 0.f, 0.f}, a1 = {0.f, 0.f, 0.f, 0.f};
#pragma unroll 8
            for (int k = 0; k < 64; ++k) { const f32x4 w = __builtin_nontemporal_load((const f32x4*)(wp + (size_t)k * 24576)); const float s0 = sc[ks * 64 + k], s1 = sc[4096 + ks * 64 + k]; a0 += s0 * w; a1 += s1 * w; }
            *(f32x4*)(modp + ((size_t)ks * 2 + 0) * 24576 + cb * 256 + lane * 4) = a0;
            *(f32x4*)(modp + ((size_t)ks * 2 + 1) * 24576 + cb * 256 + lane * 4) = a1;
        }
        __syncthreads();
    }
    {
        const float* a_re = in_ptr<14>(); const float* a_im = in_ptr<15>(); const float* log_dt = in_ptr<16>(); const float* b_re = in_ptr<17>(); const float* b_im = in_ptr<18>();
        float* ABAR = (float*)(ws + WS_ABAR); float* ABART = (float*)(ws + WS_ABART); u32x4* BFRAG = (u32x4*)(ws + WS_BBAR);
        for (int i = gtid; i < 2 * 256 * 64; i += gthr) {
            const int p = i & 63, jg = i >> 6;
            const float are = a_re[i], aim = a_im[i], dt = expf(log_dt[jg]);
            const float mag = expf(are * dt), ang = aim * dt;
            const float abr = mag * cosf(ang), abi = mag * sinf(ang);
            const float den = are * are + aim * aim, nr = abr - 1.0f;
            const float kre = (nr * are + abi * aim) / den, kim = (abi * are - nr * aim) / den;
            ABAR[(jg * 2 + 0) * 64 + p] = abr; ABAR[(jg * 2 + 1) * 64 + p] = abi;
            float tr = abr, ti = abi;
#pragma unroll
            for (int q = 0; q < 6; ++q) { const float n2 = tr * tr - ti * ti, i2 = 2.0f * tr * ti; tr = n2; ti = i2; }
            ABART[(jg * 2 + 0) * 64 + p] = tr; ABART[(jg * 2 + 1) * 64 + p] = ti;
            const f32x4* br = (const f32x4*)(b_re + (size_t)i * 16); const f32x4* bi = (const f32x4*)(b_im + (size_t)i * 16);
            float vr[16], vi[16];
#pragma unroll
            for (int q = 0; q < 4; ++q) { const f32x4 r = br[q], m = bi[q];
#pragma unroll
                for (int e = 0; e < 4; ++e) { vr[q * 4 + e] = kre * r[e] - kim * m[e]; vi[q * 4 + e] = kre * m[e] + kim * r[e]; } }
            u32x4* fr_re = BFRAG + ((size_t)jg * 8 + (p >> 4)) * 64 + (p & 15); u32x4* fr_im = fr_re + 4 * 64;
#pragma unroll
            for (int q = 0; q < 2; ++q) { u32x4 w; w.x = pk2(vr[8 * q + 0], vr[8 * q + 1]); w.y = pk2(vr[8 * q + 2], vr[8 * q + 3]); w.z = pk2(vr[8 * q + 4], vr[8 * q + 5]); w.w = pk2(vr[8 * q + 6], vr[8 * q + 7]); fr_re[16 * q] = w;
                w.x = pk2(vi[8 * q + 0], vi[8 * q + 1]); w.y = pk2(vi[8 * q + 2], vi[8 * q + 3]); w.z = pk2(vi[8 * q + 4], vi[8 * q + 5]); w.w = pk2(vi[8 * q + 6], vi[8 * q + 7]); fr_im[16 * q] = w; }
            const u32x4 z4 = {0u, 0u, 0u, 0u}; fr_re[32] = z4; fr_re[48] = z4; fr_im[32] = z4; fr_im[48] = z4;
        }
    }
    {
        LAS float* scr = (LAS float*)(lds + wave * 16384);
        constexpr int NA = XS_P0A_HI - XS_P0A_LO, NB = XS_P0B_HI - XS_P0B_LO, NC = XS_P0C_HI - XS_P0C_LO;
        for (int it = gw; it < NA + NB + NC; it += ngw) {
            const int idx = it < NA ? XS_P0A_LO + it : (it < NA + NB ? XS_P0B_LO + (it - NA) : XS_P0C_LO + (it - NA - NB));
            xpose_global_item(idx, scr, lane);
        }
    }
}

__device__ __forceinline__ void phase1() {
    PHASE_IDS();
    const int gtid = blockIdx.x * NTHR + tid, gthr = gridDim.x * NTHR;
    const float* modp = (const float*)(ws + WS_MODP); const float* b_ada = in_ptr<3>(); const float* tab = in_ptr<4>(); float* modsl = (float*)(ws + WS_MODSL);
    for (int i = gtid; i < 2 * 24576; i += gthr) {
        const int b = i / 24576, n = i % 24576; float s = b_ada[n];
        for (int ks = 0; ks < 64; ++ks) s += modp[((size_t)ks * 2 + b) * 24576 + n];
#pragma unroll
        for (int l = 0; l < 4; ++l) modsl[((size_t)(l * 2 + b) * 6) * 4096 + n] = s + tab[(size_t)l * 24576 + n];
    }
}
#define LN_ROW_STATS(va, vb, mean, rstd) do { float s_ = 0.f; \
    _Pragma("unroll") for (int i = 0; i < 8; ++i) s_ += ((va[i][0] + va[i][1]) + (va[i][2] + va[i][3])) + ((vb[i][0] + vb[i][1]) + (vb[i][2] + vb[i][3])); \
    mean = wave_sum(s_) * (1.0f / 4096.0f); float s2_ = 0.f; \
    _Pragma("unroll") for (int i = 0; i < 8; ++i) { va[i] = va[i] - mean; vb[i] = vb[i] - mean; \
        s2_ += ((va[i][0] * va[i][0] + va[i][1] * va[i][1]) + (va[i][2] * va[i][2] + va[i][3] * va[i][3])) + ((vb[i][0] * vb[i][0] + vb[i][1] * vb[i][1]) + (vb[i][2] * vb[i][2] + vb[i][3] * vb[i][3])); } \
    rstd = 1.0f / sqrtf(wave_sum(s2_) * (1.0f / 4096.0f) + LN_EPS); } while (0)
#define LN_LOAD_Z(va, vb, xr, yr) do { _Pragma("unroll") for (int i = 0; i < 8; ++i) { \
    const f32x4 xa = __builtin_nontemporal_load((const f32x4*)(xr + 512 * i)), xb = __builtin_nontemporal_load((const f32x4*)(xr + 512 * i + 4)); const u32x4 yw = __builtin_nontemporal_load((const u32x4*)(yr + 512 * i)); \
    va[i][0] = pg8::ALPHA_RES * xa[0] + bf_lo(yw.x); va[i][1] = pg8::ALPHA_RES * xa[1] + bf_hi(yw.x); va[i][2] = pg8::ALPHA_RES * xa[2] + bf_lo(yw.y); va[i][3] = pg8::ALPHA_RES * xa[3] + bf_hi(yw.y); \
    vb[i][0] = pg8::ALPHA_RES * xb[0] + bf_lo(yw.z); vb[i][1] = pg8::ALPHA_RES * xb[1] + bf_hi(yw.z); vb[i][2] = pg8::ALPHA_RES * xb[2] + bf_lo(yw.w); vb[i][3] = pg8::ALPHA_RES * xb[3] + bf_hi(yw.w); } } while (0)
__device__ __forceinline__ void ln_stage_vec(LAS unsigned char* lds, int k, const float* src, float add, int tid) {
    for (int q = tid; q < 1024; q += NTHR) { const int c = 4 * q, i = c >> 9, w = c & 511, ln = w >> 3, h = (w >> 2) & 1;
        const f32x4 v = *(const f32x4*)(src + c) + add;
        *(LAS f32x4*)(lds + k * 16384 + i * 2048 + h * 1024 + ln * 16) = v; }
}
#define LN_VEC(k, i, h) (*(const LAS f32x4*)(lds + (k) * 16384 + (i) * 2048 + (h) * 1024 + lane * 16))
__device__ __forceinline__ void phase_ln1(LAS unsigned char* lds, const float* Xin, const bf16* Y1, const float* g, const float* beta, const float* mods, bf16* H) {
    PHASE_IDS();
    ln_stage_vec(lds, 0, g, 0.f, tid); ln_stage_vec(lds, 1, beta, 0.f, tid);
    ln_stage_vec(lds, 2, mods + (size_t)(0 * 6 + 4) * 4096, 1.0f, tid); ln_stage_vec(lds, 3, mods + (size_t)(0 * 6 + 3) * 4096, 0.f, tid);
    ln_stage_vec(lds, 4, mods + (size_t)(1 * 6 + 4) * 4096, 1.0f, tid); ln_stage_vec(lds, 5, mods + (size_t)(1 * 6 + 3) * 4096, 0.f, tid);
    __syncthreads();
    const int gw = blockIdx.x * NWAVES + wave, ngw = gridDim.x * NWAVES;
    for (int row = gw; row < MROWS; row += ngw) {
        const int b = row >> 12;
        const float* xr = Xin + (size_t)row * 4096 + lane * 8; const bf16* yr = Y1 + (size_t)row * 4096 + lane * 8;
        f32x4 va[8], vb[8]; float mean, rstd;
        LN_LOAD_Z(va, vb, xr, yr);
        LN_ROW_STATS(va, vb, mean, rstd);
#pragma unroll
        for (int i = 0; i < 8; ++i) {
            const f32x4 xna = va[i] * rstd * LN_VEC(0, i, 0) + LN_VEC(1, i, 0), xnb = vb[i] * rstd * LN_VEC(0, i, 1) + LN_VEC(1, i, 1);
            const f32x4 ha = xna * LN_VEC(2 + 2 * b, i, 0) + LN_VEC(3 + 2 * b, i, 0), hb = xnb * LN_VEC(2 + 2 * b, i, 1) + LN_VEC(3 + 2 * b, i, 1);
            u32x4 w; w.x = pk2(ha[0], ha[1]); w.y = pk2(ha[2], ha[3]); w.z = pk2(hb[0], hb[1]); w.w = pk2(hb[2], hb[3]);
            *(u32x4*)(H + (size_t)row * 4096 + lane * 8 + 512 * i) = w;
        }
    }
    __syncthreads();
}
__device__ __forceinline__ void phase_ln2(LAS unsigned char* lds, const float* Xin, const bf16* Y1, const bf16* Y2, const float* g1, const float* beta1, const float* g2, const float* beta2, float* Xout, const float* mods, bf16* H) {
    PHASE_IDS();
    ln_stage_vec(lds, 0, g1, 0.f, tid); ln_stage_vec(lds, 1, beta1, 0.f, tid); ln_stage_vec(lds, 2, g2, 0.f, tid); ln_stage_vec(lds, 3, beta2, 0.f, tid);
    if (H) { ln_stage_vec(lds, 4, mods + (size_t)(0 * 6 + 1) * 4096, 1.0f, tid); ln_stage_vec(lds, 5, mods + (size_t)(0 * 6 + 0) * 4096, 0.f, tid);
             ln_stage_vec(lds, 6, mods + (size_t)(1 * 6 + 1) * 4096, 1.0f, tid); ln_stage_vec(lds, 7, mods + (size_t)(1 * 6 + 0) * 4096, 0.f, tid); }
    __syncthreads();
    const int gw = blockIdx.x * NWAVES + wave, ngw = gridDim.x * NWAVES;
    for (int row = gw; row < MROWS; row += ngw) {
        const int b = row >> 12;
        const float* xr = Xin + (size_t)row * 4096 + lane * 8; const bf16* yr = Y1 + (size_t)row * 4096 + lane * 8; const bf16* y2r = Y2 + (size_t)row * 4096 + lane * 8;
        f32x4 va[8], vb[8]; float mean, rstd;
        LN_LOAD_Z(va, vb, xr, yr);
        u32x4 y2w[8];
#pragma unroll
        for (int i = 0; i < 8; ++i) y2w[i] = __builtin_nontemporal_load((const u32x4*)(y2r + 512 * i));
        LN_ROW_STATS(va, vb, mean, rstd);
#pragma unroll
        for (int i = 0; i < 8; ++i) {
            const f32x4 xna = va[i] * rstd * LN_VEC(0, i, 0) + LN_VEC(1, i, 0), xnb = vb[i] * rstd * LN_VEC(0, i, 1) + LN_VEC(1, i, 1);
            const u32x4 yw = y2w[i];
            va[i][0] = pg8::ALPHA_RES * xna[0] + bf_lo(yw.x); va[i][1] = pg8::ALPHA_RES * xna[1] + bf_hi(yw.x); va[i][2] = pg8::ALPHA_RES * xna[2] + bf_lo(yw.y); va[i][3] = pg8::ALPHA_RES * xna[3] + bf_hi(yw.y);
            vb[i][0] = pg8::ALPHA_RES * xnb[0] + bf_lo(yw.z); vb[i][1] = pg8::ALPHA_RES * xnb[1] + bf_hi(yw.z); vb[i][2] = pg8::ALPHA_RES * xnb[2] + bf_lo(yw.w); vb[i][3] = pg8::ALPHA_RES * xnb[3] + bf_hi(yw.w); }
        LN_ROW_STATS(va, vb, mean, rstd);
        float* xo = Xout + (size_t)row * 4096 + lane * 8;
#pragma unroll
        for (int i = 0; i < 8; ++i) {
            const f32x4 xna = va[i] * rstd * LN_VEC(2, i, 0) + LN_VEC(3, i, 0), xnb = vb[i] * rstd * LN_VEC(2, i, 1) + LN_VEC(3, i, 1);
            __builtin_nontemporal_store(xna, (f32x4*)(xo + 512 * i)); __builtin_nontemporal_store(xnb, (f32x4*)(xo + 512 * i + 4));
            if (H) {
                const f32x4 ha = xna * LN_VEC(4 + 2 * b, i, 0) + LN_VEC(5 + 2 * b, i, 0), hb = xnb * LN_VEC(4 + 2 * b, i, 1) + LN_VEC(5 + 2 * b, i, 1);
                u32x4 w; w.x = pk2(ha[0], ha[1]); w.y = pk2(ha[2], ha[3]); w.z = pk2(hb[0], hb[1]); w.w = pk2(hb[2], hb[3]);
                *(u32x4*)(H + (size_t)row * 4096 + lane * 8 + 512 * i) = w;
            }
        }
    }
    __syncthreads();
}

__device__ __forceinline__ void phase_modulate(LAS unsigned char* lds, const float* x, const float* mods, bf16* H) {
    PHASE_IDS();
    ln_stage_vec(lds, 0, mods + (size_t)(0 * 6 + 1) * 4096, 1.0f, tid); ln_stage_vec(lds, 1, mods + (size_t)(0 * 6 + 0) * 4096, 0.f, tid);
    ln_stage_vec(lds, 2, mods + (size_t)(1 * 6 + 1) * 4096, 1.0f, tid); ln_stage_vec(lds, 3, mods + (size_t)(1 * 6 + 0) * 4096, 0.f, tid);
    __syncthreads();
    const int gw = blockIdx.x * NWAVES + wave, ngw = gridDim.x * NWAVES;
    for (int row = gw; row < MROWS; row += ngw) {
        const int b = row >> 12; const float* xr = x + (size_t)row * 4096 + lane * 8;
        f32x4 xa[8], xb[8];
#pragma unroll
        for (int i = 0; i < 8; ++i) { xa[i] = __builtin_nontemporal_load((const f32x4*)(xr + 512 * i)); xb[i] = __builtin_nontemporal_load((const f32x4*)(xr + 512 * i + 4)); }
#pragma unroll
        for (int i = 0; i < 8; ++i) { const f32x4 ha = xa[i] * LN_VEC(2 * b, i, 0) + LN_VEC(2 * b + 1, i, 0), hb = xb[i] * LN_VEC(2 * b, i, 1) + LN_VEC(2 * b + 1, i, 1);
            u32x4 w; w.x = pk2(ha[0], ha[1]); w.y = pk2(ha[2], ha[3]); w.z = pk2(hb[0], hb[1]); w.w = pk2(hb[2], hb[3]);
            *(u32x4*)(H + (size_t)row * 4096 + lane * 8 + 512 * i) = w; }
    }
    __syncthreads();
}

constexpr int SSM_WLDS = 16384, SSM_ST = 2048, SSM_U = 6400, SSM_USTR = 528;
__device__ __forceinline__ void ssm_load_h(const bf16* H, int b, int k, int g, int lane, u32x4& v0, u32x4& v1) {
    const u32x4* src = (const u32x4*)(H + ((size_t)(b * SEQ + k * TC + lane)) * 4096 + g * 16);
    v0 = src[0]; v1 = src[1];
}
__device__ __forceinline__ void ssm_store_h(LAS unsigned char* hs, int lane, const u32x4& v0, const u32x4& v1) { *(LAS u32x4*)(hs + lane * 32) = v0; *(LAS u32x4*)(hs + lane * 32 + 16) = v1; }
__device__ __forceinline__ void ssm_bproj16(const LAS unsigned char* hs, LAS unsigned char* ut, int tg, const bf16x8 (&bf)[8], int fr, int fq) {
    u32x4 aw = {0u, 0u, 0u, 0u};
    if (fq < 2) aw = *(const LAS u32x4*)(hs + (tg * 16 + fr) * 32 + fq * 16);
    const bf16x8 a = __builtin_bit_cast(bf16x8, aw);
#pragma unroll
    for (int tau = 0; tau < 8; ++tau) { f32x4 acc = {0.f, 0.f, 0.f, 0.f};
        acc = __builtin_amdgcn_mfma_f32_16x16x32_bf16(a, bf[tau], acc, 0, 0, 0);
#pragma unroll
        for (int r = 0; r < 4; ++r) *(LAS float*)(ut + (4 * fq + r) * SSM_USTR + (tau * 16 + fr) * 4) = acc[r]; }
}
__device__ __forceinline__ void ssm_update(const LAS unsigned char* ut, int tt, int lane, float are, float aim, float& sre, float& sim) {
    const float ure = *(const LAS float*)(ut + tt * SSM_USTR + lane * 4), uim = *(const LAS float*)(ut + tt * SSM_USTR + 256 + lane * 4);
    const float nre = are * sre - aim * sim + ure, nim = are * sim + aim * sre + uim;
    sre = nre; sim = nim;
}
__device__ __forceinline__ void phase_ssm_local(int j, LAS unsigned char* lds, int xlo, int xhi, int xlo2, int xn2) {
    PHASE_IDS();
    const bf16* H = (const bf16*)(ws + WS_H); float* E = (float*)(ws + WS_E);
    const float* ABAR = (const float*)(ws + WS_ABAR); const u32x4* BFRAG = (const u32x4*)(ws + WS_BBAR);
    LAS unsigned char* hs = lds + wave * SSM_WLDS; LAS unsigned char* ut = hs + SSM_U;
    const int gw = blockIdx.x * NWAVES + wave, ngw = gridDim.x * NWAVES, fr = lane & 15, fq = lane >> 4;
    const int g = gw & 255, jg = j * 256 + g, bstep = ngw >> 8; constexpr int NBK = 2 * (NCHUNK - 1);
    bf16x8 bf[8];
#pragma unroll
    for (int tau = 0; tau < 8; ++tau) bf[tau] = __builtin_bit_cast(bf16x8, BFRAG[((size_t)jg * 8 + tau) * 64 + lane]);
    const float are = ABAR[(jg * 2 + 0) * 64 + lane], aim = ABAR[(jg * 2 + 1) * 64 + lane];
    u32x4 n0 = {0u, 0u, 0u, 0u}, n1 = {0u, 0u, 0u, 0u};
    int xi = gw, itn = 0; const int xtot = xn2 + (xhi - xlo);
    int bk = (gw < (ngw & ~255)) ? (gw >> 8) : NBK;
    if (bk < NBK) ssm_load_h(H, bk / (NCHUNK - 1), bk % (NCHUNK - 1), g, lane, n0, n1);
    for (; bk < NBK; bk += bstep) {
        const int k = bk % (NCHUNK - 1), b = bk / (NCHUNK - 1);
        ssm_store_h(hs, lane, n0, n1);
        { const int nx = bk + bstep; if (nx < NBK) ssm_load_h(H, nx / (NCHUNK - 1), nx % (NCHUNK - 1), g, lane, n0, n1); }
        float sre = 0.f, sim = 0.f;
        for (int tg = 0; tg < TC / 16; ++tg) {
            ssm_bproj16(hs, ut, tg, bf, fr, fq);
#pragma unroll
            for (int tt = 0; tt < 16; ++tt) ssm_update(ut, tt, lane, are, aim, sre, sim);
        }
        float* e = E + (((size_t)(b * NCHUNK + k) * 256 + g) * 2) * 64 + lane;
        e[0] = sre; e[64] = sim;
        if (xi < xtot) { xpose_global_item(xi < xn2 ? xlo2 + xi : xlo + (xi - xn2), (LAS float*)ut, lane); xi += ngw; }
        if ((itn++ & 3) == 3 && xi < xtot) { xpose_global_item(xi < xn2 ? xlo2 + xi : xlo + (xi - xn2), (LAS float*)ut, lane); xi += ngw; }
    }
    for (; xi < xtot; xi += ngw) xpose_global_item(xi < xn2 ? xlo2 + xi : xlo + (xi - xn2), (LAS float*)ut, lane);
}
__device__ __forceinline__ void phase_ssm_carry(int j) {
    PHASE_IDS();
    const float* E = (const float*)(ws + WS_E); float* SP = (float*)(ws + WS_SP); const float* ABART = (const float*)(ws + WS_ABART);
    const int gtid = blockIdx.x * NTHR + tid, gthr = gridDim.x * NTHR;
    for (int i = gtid; i < 2 * 256 * 64; i += gthr) {
        const int p = i & 63, g = (i >> 6) & 255, b = i >> 14, jg = j * 256 + g;
        const float tr = ABART[(jg * 2 + 0) * 64 + p], ti = ABART[(jg * 2 + 1) * 64 + p];
        const size_t base = (((size_t)(b * NCHUNK) * 256 + g) * 2) * 64 + p, kstr = (size_t)256 * 2 * 64;
        float sre = 0.f, sim = 0.f;
        for (int k0 = 0; k0 < NCHUNK; k0 += 8) {
            float er[8], ei[8];
#pragma unroll
            for (int u = 0; u < 8; ++u) { const bool ok = (k0 + u) < NCHUNK - 1; er[u] = ok ? E[base + (size_t)(k0 + u) * kstr] : 0.f; ei[u] = ok ? E[base + (size_t)(k0 + u) * kstr + 64] : 0.f; }
#pragma unroll
            for (int u = 0; u < 8; ++u) { SP[base + (size_t)(k0 + u) * kstr] = sre; SP[base + (size_t)(k0 + u) * kstr + 64] = sim;
                const float nre = tr * sre - ti * sim + er[u], nim = tr * sim + ti * sre + ei[u]; sre = nre; sim = nim; }
        }
    }
}
__device__ __forceinline__ float gelu_tanh(float y) {
    const float a = 0.7978845608028654f * (y + 0.044715f * y * y * y);
    return y * __builtin_amdgcn_rcpf(1.0f + __builtin_amdgcn_exp2f(-2.0f * 1.44269504089f * a));
}
__device__ __forceinline__ void phase_ssm_scan(int j, LAS unsigned char* lds, int xlo, int xhi, int xlo2, int xn2) {
    PHASE_IDS();
    const bf16* H = (const bf16*)(ws + WS_H); const float* SP = (const float*)(ws + WS_SP); bf16* U = (bf16*)(ws + WS_U);
    const float* ABAR = (const float*)(ws + WS_ABAR); const u32x4* BFRAG = (const u32x4*)(ws + WS_BBAR);
    const float* c_re = in_ptr<19>(); const float* c_im = in_ptr<20>(); const float* dsk = in_ptr<21>();
    LAS unsigned char* hs = lds + wave * SSM_WLDS; LAS unsigned char* st = hs + SSM_ST; LAS unsigned char* ut = hs + SSM_U;
    const int gw = blockIdx.x * NWAVES + wave, ngw = gridDim.x * NWAVES, fr = lane & 15, fq = lane >> 4;
    const int g = gw & 255, jg = j * 256 + g, bstep = ngw >> 8; constexpr int NBK = 2 * NCHUNK;
    bf16x8 bf[8];
#pragma unroll
    for (int tau = 0; tau < 8; ++tau) bf[tau] = __builtin_bit_cast(bf16x8, BFRAG[((size_t)jg * 8 + tau) * 64 + lane]);
    const float are = ABAR[(jg * 2 + 0) * 64 + lane], aim = ABAR[(jg * 2 + 1) * 64 + lane];
    bf16x8 cf[4];
#pragma unroll
    for (int s4 = 0; s4 < 4; ++s4) { const float* src = ((s4 >> 1) ? c_im : c_re) + ((size_t)jg * 16 + fr) * 64 + 32 * (s4 & 1) + 8 * fq; const float sg = (s4 >> 1) ? -1.0f : 1.0f;
        const f32x4 a = *(const f32x4*)src * sg, c4 = *(const f32x4*)(src + 4) * sg;
        u32x4 w; w.x = pk2(a[0], a[1]); w.y = pk2(a[2], a[3]); w.z = pk2(c4[0], c4[1]); w.w = pk2(c4[2], c4[3]);
        cf[s4] = __builtin_bit_cast(bf16x8, w); }
    const f32x4 dv4 = *(const f32x4*)(dsk + j * 4096 + g * 16 + 4 * fq);
    u32x4 n0 = {0u, 0u, 0u, 0u}, n1 = {0u, 0u, 0u, 0u}; float nsre = 0.f, nsim = 0.f;
    int xi = gw, itn = 0; const int xtot = xn2 + (xhi - xlo);
    int bk = (gw < (ngw & ~255)) ? (gw >> 8) : NBK;
    if (bk < NBK) { ssm_load_h(H, bk >> 6, bk & (NCHUNK - 1), g, lane, n0, n1); const float* sp = SP + (((size_t)bk * 256 + g) * 2) * 64 + lane; nsre = sp[0]; nsim = sp[64]; }
    for (; bk < NBK; bk += bstep) {
        const int k = bk & (NCHUNK - 1), b = bk >> 6;
        ssm_store_h(hs, lane, n0, n1);
        float sre = nsre, sim = nsim;
        { const int nx = bk + bstep; if (nx < NBK) { ssm_load_h(H, nx >> 6, nx & (NCHUNK - 1), g, lane, n0, n1); const float* sp = SP + (((size_t)nx * 256 + g) * 2) * 64 + lane; nsre = sp[0]; nsim = sp[64]; } }
        for (int tg = 0; tg < TC / 16; ++tg) {
            ssm_bproj16(hs, ut, tg, bf, fr, fq);
            float ur[16], ui[16];
#pragma unroll
            for (int tt = 0; tt < 16; ++tt) { ur[tt] = *(const LAS float*)(ut + tt * SSM_USTR + lane * 4); ui[tt] = *(const LAS float*)(ut + tt * SSM_USTR + 256 + lane * 4); }
#pragma unroll
            for (int tt = 0; tt < 16; ++tt) {
                { const float nre = are * sre - aim * sim + ur[tt], nim = are * sim + aim * sre + ui[tt]; sre = nre; sim = nim; }
                const unsigned w = pk2(sre, sim);
                *(LAS unsigned short*)(st + tt * 272 + lane * 2) = (unsigned short)(w & 0xffffu);
                *(LAS unsigned short*)(st + tt * 272 + 128 + lane * 2) = (unsigned short)(w >> 16);
            }
            f32x4 acc = {0.f, 0.f, 0.f, 0.f};
#pragma unroll
            for (int s4 = 0; s4 < 4; ++s4) { const bf16x8 a = *(const LAS bf16x8*)(st + fr * 272 + 64 * s4 + 16 * fq);
                acc = __builtin_amdgcn_mfma_f32_16x16x32_bf16(cf[s4], a, acc, 0, 0, 0); }
            const int tok = tg * 16 + fr;
            const u32x2 hw = *(const LAS u32x2*)(hs + tok * 32 + fq * 8);
            const float y0 = acc[0] + dv4[0] * bf_lo(hw.x), y1 = acc[1] + dv4[1] * bf_hi(hw.x), y2 = acc[2] + dv4[2] * bf_lo(hw.y), y3 = acc[3] + dv4[3] * bf_hi(hw.y);
            u32x2 w; w.x = pk2(gelu_tanh(y0), gelu_tanh(y1)); w.y = pk2(gelu_tanh(y2), gelu_tanh(y3));
            *(u32x2*)(U + ((size_t)(b * SEQ + k * TC + tok)) * 4096 + g * 16 + 4 * fq) = w;
        }
        if (xi < xtot) { xpose_global_item(xi < xn2 ? xlo2 + xi : xlo + (xi - xn2), (LAS float*)ut, lane); xi += ngw; }
        if ((itn++ & 3) == 3 && xi < xtot) { xpose_global_item(xi < xn2 ? xlo2 + xi : xlo + (xi - xn2), (LAS float*)ut, lane); xi += ngw; }
    }
    for (; xi < xtot; xi += ngw) xpose_global_item(xi < xn2 ? xlo2 + xi : xlo + (xi - xn2), (LAS float*)ut, lane);
}

typedef float f32x16 __attribute__((ext_vector_type(16)));
constexpr int AT_KSTR = 144, AT_VSTR = 520, AT_K_OFF = 0, AT_V_OFF = 256 * AT_KSTR, AT_TBL_OFF = AT_V_OFF + 64 * AT_VSTR;
static_assert(AT_TBL_OFF + 8 * 512 <= RING_BYTES, "attention LDS");
__device__ __forceinline__ void phase_attn(int j, LAS unsigned char* lds) {
    PHASE_IDS();
    const bf16* QKV = (const bf16*)(ws + WS_QKV); bf16* O = (bf16*)(ws + WS_O);
    const float* sinks = in_ptr<12>() + j * 64; const float* relb = in_ptr<13>();
    const int qc = lane & 31, hh = lane >> 5;
    constexpr float LOG2E = 1.44269504089f;
    LAS float* tbl = (LAS float*)(lds + AT_TBL_OFF + wave * 512);
    for (int unit = blockIdx.x; unit < 512; unit += gridDim.x) {
        const int kvh = unit & 7, n = (unit >> 3) & 31, b = unit >> 8, h = kvh * 8 + wave;
        for (int i = lane; i < 128; i += 64) tbl[i] = relb[kBucket[i] * 64 + h] * LOG2E;
        const float sink2 = sinks[h] * LOG2E;
        const int pos0 = n * 128 - 128;
#pragma unroll
        for (int i = 0; i < 4; ++i) { const int c = tid + 512 * i, key = c >> 3, part = c & 7, pos = pos0 + key;
            u32x4 kv = {0u, 0u, 0u, 0u}, vv = {0u, 0u, 0u, 0u};
            if (pos >= 0) { const bf16* src = QKV + (size_t)(b * SEQ + pos) * NQKV + 4096 + kvh * 64 + part * 8; kv = *(const u32x4*)src; vv = *(const u32x4*)(src + 512); }
            *(LAS u32x4*)(lds + AT_K_OFF + key * AT_KSTR + part * 16) = kv;
            LAS unsigned short* vt = (LAS unsigned short*)(lds + AT_V_OFF + (part * 8) * AT_VSTR + key * 2);
#pragma unroll
            for (int e = 0; e < 4; ++e) { vt[(2 * e) * (AT_VSTR / 2)] = (unsigned short)(vv[e] & 0xffffu); vt[(2 * e + 1) * (AT_VSTR / 2)] = (unsigned short)(vv[e] >> 16); } }
        __syncthreads();
        for (int qb = 0; qb < 4; ++qb) {
            const bf16* qp = QKV + (size_t)(b * SEQ + n * 128 + 32 * qb + qc) * NQKV + h * 64 + 8 * hh;
            bf16x8 qf[4];
#pragma unroll
            for (int ks = 0; ks < 4; ++ks) qf[ks] = *(const bf16x8*)(qp + 16 * ks);
            f32x16 s[5];
#pragma unroll
            for (int jt = 0; jt < 5; ++jt) {
#pragma unroll
                for (int r = 0; r < 16; ++r) s[jt][r] = 0.f;
#pragma unroll
                for (int ks = 0; ks < 4; ++ks) { const bf16x8 kf = *(const LAS bf16x8*)(lds + AT_K_OFF + (32 * (qb + jt) + qc) * AT_KSTR + (16 * ks + 8 * hh) * 2);
                    s[jt] = __builtin_amdgcn_mfma_f32_32x32x16_bf16(kf, qf[ks], s[jt], 0, 0, 0); } }
            float mx = sink2;
#pragma unroll
            for (int jt = 0; jt < 5; ++jt) { const bool tile_dead = (n == 0) && (qb + jt < 4);
#pragma unroll
                for (int r = 0; r < 16; ++r) { const int krow = (r & 3) + 8 * (r >> 2) + 4 * hh, dist = 128 + qc - krow - 32 * jt;
                    bool valid = (jt == 0) ? (krow > qc) : ((jt == 4) ? (krow <= qc) : true); valid = valid && !tile_dead;
                    float t = s[jt][r] * (0.125f * LOG2E) + tbl[dist & 127]; t = valid ? t : -1e30f; s[jt][r] = t; mx = fmaxf(mx, t); } }
            mx = fmaxf(mx, __shfl_xor(mx, 32));
            float sum = 0.f;
#pragma unroll
            for (int jt = 0; jt < 5; ++jt)
#pragma unroll
                for (int r = 0; r < 16; ++r) { const float p = __builtin_amdgcn_exp2f(s[jt][r] - mx); s[jt][r] = p; sum += p; }
            sum += __shfl_xor(sum, 32); sum += __builtin_amdgcn_exp2f(sink2 - mx);
            const float inv = 1.0f / sum;
            f32x16 o[2];
#pragma unroll
            for (int dt = 0; dt < 2; ++dt)
#pragma unroll
                for (int r = 0; r < 16; ++r) o[dt][r] = 0.f;
#pragma unroll
            for (int jt = 0; jt < 5; ++jt)
#pragma unroll
                for (int s2 = 0; s2 < 2; ++s2) { u32x4 pw; pw.x = pk2(s[jt][8 * s2 + 0], s[jt][8 * s2 + 1]); pw.y = pk2(s[jt][8 * s2 + 2], s[jt][8 * s2 + 3]); pw.z = pk2(s[jt][8 * s2 + 4], s[jt][8 * s2 + 5]); pw.w = pk2(s[jt][8 * s2 + 6], s[jt][8 * s2 + 7]);
                    const bf16x8 pf = __builtin_bit_cast(bf16x8, pw);
#pragma unroll
                    for (int dt = 0; dt < 2; ++dt) { const LAS unsigned char* vp = lds + AT_V_OFF + (32 * dt + qc) * AT_VSTR + (32 * (qb + jt) + 16 * s2 + 4 * hh) * 2;
                        const u32x2 v0 = *(const LAS u32x2*)vp, v1 = *(const LAS u32x2*)(vp + 16); u32x4 vw; vw.x = v0.x; vw.y = v0.y; vw.z = v1.x; vw.w = v1.y;
                        o[dt] = __builtin_amdgcn_mfma_f32_32x32x16_bf16(__builtin_bit_cast(bf16x8, vw), pf, o[dt], 0, 0, 0); } }
            bf16* op = O + (size_t)(b * SEQ + n * 128 + 32 * qb + qc) * 4096 + h * 64;
#pragma unroll
            for (int dt = 0; dt < 2; ++dt)
#pragma unroll
                for (int g4 = 0; g4 < 4; ++g4) { u32x2 w; w.x = pk2(o[dt][4 * g4] * inv, o[dt][4 * g4 + 1] * inv); w.y = pk2(o[dt][4 * g4 + 2] * inv, o[dt][4 * g4 + 3] * inv);
                    *(u32x2*)(op + 32 * dt + 8 * g4 + 4 * hh) = w; }
        }
        __syncthreads();
    }
}

struct Args { const float* in[24]; float* out; unsigned char* ws; int ph_lo, ph_hi; };
__global__ void __launch_bounds__(NTHR, 2) fwd_kernel(Args args) {
    extern __shared__ __attribute__((aligned(16))) unsigned char lds_raw[];
    LAS unsigned char* lds = (LAS unsigned char*)lds_raw;
    for (int u = threadIdx.x; u < (LDS_BYTES - LDSCTL_OFF) / 4; u += NTHR) ((LAS unsigned*)(lds + LDSCTL_OFF))[u] = 0u;
    __syncthreads();
#if MK_ONE_LAUNCH
    const XcdBarrier bar = xcd_barrier_post((unsigned*)(ws_ptr() + WS_CTL) + CW_BAR, (volatile LAS unsigned*)(lds + MISC_OFF) + 8);
#define GRID_BAR() xcd_barrier(bar)
#else
#define GRID_BAR() do {} while (0)
#endif
    const int lo = args.ph_lo, hi = args.ph_hi;
#define IN(k) (lo <= (k) && (k) < hi)
#define SEAM() GRID_BAR()
#define WSP(off) (ws_ptr() + (off))
#define MODS_L(l) ((const float*)WSP(WS_MODSL) + (size_t)(l) * 2 * 6 * 4096)
#define XRES(l) ((l) == 0 ? in_ptr<0>() : (const float*)WSP(WS_X))

    if (IN(0)) phase0(lds);
    SEAM();
    if (IN(1)) phase1();
    SEAM();
    if (IN(2)) phase_modulate(lds, in_ptr<0>(), MODS_L(0), (bf16*)WSP(WS_H));
    SEAM();

    for (int l = 0; l < 4; ++l) {
        const int pb = 3 + 8 * l, j = l >> 1;
        if ((l & 1) == 0) {
            if (IN(pb + 0)) phase_ssm_local(j, lds, l ? XS_L2S1_LO : XS_L0S1_LO, l ? XS_L2S1_HI : XS_L0S1_HI, l ? XS_L2S1X_LO : XS_L0S1X_LO, XS_X);
            SEAM();
            if (IN(pb + 1)) phase_ssm_carry(j);
            SEAM();
            if (IN(pb + 2)) phase_ssm_scan(j, lds, l ? XS_L2S3_LO : XS_L0S3_LO, l ? XS_L2S3_HI : XS_L0S3_HI, l ? XS_L2S3X_LO : XS_L0S3X_LO, XS_X);
            SEAM();
            if (IN(pb + 3)) {
                pg8::Gemm g{(const bf16*)WSP(WS_U), (const bf16*)WSP(WS_WGLU + j * SZ_WGLU), MROWS, 8192, 4096}; pg8::StaticOrder S; S.init(MROWS, 8192, gridDim.x, (int)blockIdx.x);
                pg8::EpiGLUY E{(bf16*)WSP(WS_Z), MODS_L(l) + 2 * 4096};
                pg8::gemm_phase<pg8::EpiGLUY, pg8::StaticOrder, true, true, 4096>(lds, g, S, E);
            }
            SEAM();
        } else {
            if (IN(pb + 0)) {
                pg8::Gemm g{(const bf16*)WSP(WS_H), (const bf16*)WSP(WS_WQKV + j * SZ_WQKV), MROWS, NQKV, 4096}; pg8::StaticOrder S; S.init(MROWS, NQKV, gridDim.x, (int)blockIdx.x);
                pg8::EpiQKV E{(bf16*)WSP(WS_QKV), NQKV, in_ptr<10>() + j * NQKV};
                pg8::gemm_phase<pg8::EpiQKV, pg8::StaticOrder, true, true, 4096>(lds, g, S, E);
                host_tail(lds, (MROWS / 256) * (NQKV / 256), l == 1 ? XS_T1Q_LO : XS_T3Q_LO, l == 1 ? XS_T1Q_HI : XS_T3Q_HI);
            }
            SEAM();
            if (IN(pb + 1)) phase_attn(j, lds);
            SEAM();
            if (IN(pb + 2)) {
                pg8::Gemm g{(const bf16*)WSP(WS_O), (const bf16*)WSP(WS_WO + j * SZ_WO), MROWS, 4096, 4096}; pg8::StaticOrder S; S.init(MROWS, 4096, gridDim.x, (int)blockIdx.x);
                pg8::EpiY E{(bf16*)WSP(WS_Z), MODS_L(l) + 2 * 4096};
                pg8::gemm_phase<pg8::EpiY, pg8::StaticOrder, true, true, 4096>(lds, g, S, E);
            }
            SEAM();
        }
        if (IN(pb + 4)) phase_ln1(lds, XRES(l), (const bf16*)WSP(WS_Z), in_ptr<5>() + (size_t)(l * 2 + 0) * 4096, in_ptr<6>() + (size_t)(l * 2 + 0) * 4096, MODS_L(l), (bf16*)WSP(WS_H));
        SEAM();
        if (IN(pb + 5)) {
            pg8::Gemm g{(const bf16*)WSP(WS_H), (const bf16*)WSP(WS_WIN + l * SZ_WIN), MROWS, 2 * DFF, 4096}; pg8::StaticOrder S; S.init(MROWS, 2 * DFF, gridDim.x, (int)blockIdx.x);
            pg8::EpiSwiGLU E{(bf16*)WSP(WS_ACT), DFF};
            pg8::gemm_phase<pg8::EpiSwiGLU, pg8::StaticOrder, true, true, 4096>(lds, g, S, E);
            if (l < 3) host_tail(lds, (MROWS / 256) * (2 * DFF / 256), l == 0 ? XS_T0_LO : (l == 1 ? XS_T1_LO : XS_T2_LO), l == 0 ? XS_T0_HI : (l == 1 ? XS_T1_HI : XS_T2_HI));
        }
        SEAM();
        if (IN(pb + 6)) {
            pg8::Gemm g{(const bf16*)WSP(WS_ACT), (const bf16*)WSP(WS_WDN + l * SZ_WDN), MROWS, 4096, DFF}; pg8::StaticOrder S; S.init(MROWS, 4096, gridDim.x, (int)blockIdx.x);
            pg8::EpiY E{(bf16*)WSP(WS_Z + SZ_H), MODS_L(l) + 5 * 4096};
            pg8::gemm_phase<pg8::EpiY, pg8::StaticOrder, true, true, DFF>(lds, g, S, E);
        }
        SEAM();
        if (IN(pb + 7)) phase_ln2(lds, XRES(l), (const bf16*)WSP(WS_Z), (const bf16*)WSP(WS_Z + SZ_H), in_ptr<5>() + (size_t)(l * 2 + 0) * 4096, in_ptr<6>() + (size_t)(l * 2 + 0) * 4096, in_ptr<5>() + (size_t)(l * 2 + 1) * 4096, in_ptr<6>() + (size_t)(l * 2 + 1) * 4096, (l == 3) ? out_ptr() : (float*)WSP(WS_X), MODS_L(l + 1), (l == 3) ? (bf16*)nullptr : (bf16*)WSP(WS_H));
        if (l < 3) SEAM();
    }
#undef IN
#undef SEAM
#undef GRID_BAR
}

extern "C" void kernel_launch(void* const* d_in, const int* in_sizes, int n_in, void* d_out, int out_size, void* d_ws, size_t ws_size, hipStream_t stream) {
    static int grid = 0;
    if (grid == 0) {
        if (n_in != 24 || out_size != MROWS * DM || ws_size < WS_END) { fprintf(stderr, "kernel_launch: unexpected problem (n_in %d, out %d, ws %zu < %zu)\n", n_in, out_size, ws_size, (size_t)WS_END); grid = -1; return; }
        int dev = 0, cus = 0, per_cu = 0;
        if (hipGetDevice(&dev) != hipSuccess || hipDeviceGetAttribute(&cus, hipDeviceAttributeMultiprocessorCount, dev) != hipSuccess) { grid = -1; return; }
        if (hipFuncSetAttribute((const void*)fwd_kernel, hipFuncAttributeMaxDynamicSharedMemorySize, LDS_BYTES) != hipSuccess) { fprintf(stderr, "kernel_launch: hipFuncSetAttribute failed\n"); grid = -1; return; }
        if (hipOccupancyMaxActiveBlocksPerMultiprocessor(&per_cu, (const void*)fwd_kernel, NTHR, LDS_BYTES) != hipSuccess || per_cu < 1) fprintf(stderr, "kernel_launch: occupancy query says %d\n", per_cu);
        (void)hipGetLastError();
        grid = cus;
    }
    if (grid < 0) return;
    (void)hipMemsetAsync((char*)d_ws + WS_CTL, 0, CTL_BYTES, stream);
    Args a{};
    for (int i = 0; i < 24; ++i) a.in[i] = (const float*)d_in[i];
    a.out = (float*)d_out; a.ws = (unsigned char*)d_ws;
#if MK_ONE_LAUNCH
    a.ph_lo = 0; a.ph_hi = N_PHASES;
    hipLaunchKernelGGL(fwd_kernel, dim3(grid), dim3(NTHR), LDS_BYTES, stream, a);
#else
    for (int ph = 0; ph < N_PHASES; ++ph) {
        if (ph >= 3 && ((ph - 3) & 7) == 3 && (((ph - 3) >> 3) & 1)) continue;
        a.ph_lo = ph; a.ph_hi = ph + 1;
        hipLaunchKernelGGL(fwd_kernel, dim3(grid), dim3(NTHR), LDS_BYTES, stream, a);
    }
#endif
}
```

```cpp
#include <hip/hip_runtime.h>
#include <cstdio>
#include <cstdint>
namespace pg8 {
#define PG8_LAS __attribute__((address_space(3)))
typedef unsigned short bf16_t;
typedef short bf16x8 __attribute__((ext_vector_type(8)));
typedef float f32x4 __attribute__((ext_vector_type(4)));
typedef unsigned u32x4 __attribute__((ext_vector_type(4)));
constexpr int BM = 256, BK = 64, HALF = 128, HTB = HALF * BK * 2  , STAGE_BYTES = 8 * HTB, NXCD = 8, WGM = 8;

__host__ __device__ __forceinline__ int lds_byte(int r, int c) { const int st = (r >> 4) * 2 + (c >> 5), rr = r & 15, cc = c & 31, ob = rr * 64 + cc * 2; return st * 1024 + (ob ^ (((ob >> 9) & 1) << 5)); }
__host__ __device__ __forceinline__ void stage_rc(int b, int& R, int& C) { const int st = b / 1024, sb = b % 1024, swz = sb ^ (((sb >> 9) & 1) << 5); R = (st >> 1) * 16 + swz / 64; C = (st & 1) * 32 + (swz % 64) / 2; }
__host__ __device__ __forceinline__ int perm32(int rho) { const int n = rho >> 4, i = rho & 15; return 8 * (i >> 2) + 4 * n + (i & 3); }

struct Unit { int pm, pn; };
struct Gemm { const bf16_t* A; const bf16_t* Bt; int M, N, K; };

struct StaticOrder {
    int nM, nN, nwg, G, c;
    __host__ __device__ void init(int M, int N, int G_, int c_) { nM = M / BM; nN = N / BM; nwg = nM * nN; G = G_; c = c_; }
    __host__ __device__ bool next(int i, Unit& u) const {
        const long L = (long)i * G + c; if (L >= nwg) return false;
        int wgid = (int)L; { const int q = nwg / NXCD, r = nwg % NXCD, xcd = wgid % NXCD, off = wgid / NXCD; wgid = (xcd < r ? xcd * (q + 1) : r * (q + 1) + (xcd - r) * q) + off; }
        const int nig = WGM * nN, gid = wgid / nig, fm = gid * WGM, gsz = (nM - fm) < WGM ? (nM - fm) : WGM;
        u.pm = fm + ((wgid % nig) % gsz); u.pn = (wgid % nig) / gsz; return true;
    }
    __device__ __forceinline__ void a_ready(const Unit&) const {}
    __device__ __forceinline__ void done(const Unit&) const {}
};
__device__ __forceinline__ unsigned cvt_pk_bf16(float lo, float hi) { unsigned r; asm volatile("v_cvt_pk_bf16_f32 %0, %1, %2" : "=v"(r) : "v"(lo), "v"(hi)); return r; }
typedef float f32x2 __attribute__((ext_vector_type(2)));
__device__ __forceinline__ float fast_sigmoid(float v) { return __builtin_amdgcn_rcpf(1.0f + __builtin_amdgcn_exp2f(-1.44269504089f * v)); }
constexpr float ALPHA_RES = 1.681792830507429f;

struct EpiQKV {
    static constexpr bool PERM = true, AFTER_DRAIN = false;
    bf16_t* O; int ldc; const float* bias;
    __device__ __forceinline__ void operator()(const f32x4 (&acc)[2][2][4][2], const Unit& u, int wr, int wc, int fr, int fq) const {
        const int row0 = u.pm * BM + wr * 64 + fr, col0 = u.pn * BM + wc * 32 + 8 * fq;
        f32x4 bv[2][2];
#pragma unroll
        for (int bj = 0; bj < 2; ++bj)
#pragma unroll
            for (int n = 0; n < 2; ++n) bv[bj][n] = *(const f32x4*)(bias + col0 + bj * HALF + 4 * n);
#pragma unroll
        for (int ai = 0; ai < 2; ++ai)
#pragma unroll
            for (int m = 0; m < 4; ++m) { bf16_t* rowp = O + (size_t)(row0 + ai * HALF + m * 16) * ldc + col0;
#pragma unroll
                for (int bj = 0; bj < 2; ++bj) { const f32x4 v0 = acc[ai][bj][m][0] + bv[bj][0], v1 = acc[ai][bj][m][1] + bv[bj][1];
                    u32x4 w; w.x = cvt_pk_bf16(v0[0], v0[1]); w.y = cvt_pk_bf16(v0[2], v0[3]); w.z = cvt_pk_bf16(v1[0], v1[1]); w.w = cvt_pk_bf16(v1[2], v1[3]);
                    *(u32x4*)(rowp + bj * HALF) = w; } }
    }
};
struct EpiSwiGLU {
    static constexpr bool PERM = true, AFTER_DRAIN = false;
    bf16_t* O; int ldc;
    __device__ __forceinline__ void operator()(const f32x4 (&acc)[2][2][4][2], const Unit& u, int wr, int wc, int fr, int fq) const {
        const int row0 = u.pm * BM + wr * 64 + fr, col0 = u.pn * HALF + wc * 32 + 8 * fq;
#pragma unroll
        for (int ai = 0; ai < 2; ++ai)
#pragma unroll
            for (int m = 0; m < 4; ++m) { bf16_t* rowp = O + (size_t)(row0 + ai * HALF + m * 16) * ldc + col0;
                float t[8], gu[8];
#pragma unroll
                for (int i = 0; i < 8; ++i) { const float g = acc[ai][0][m][i >> 2][i & 3]; t[i] = -1.44269504089f * g; gu[i] = g * acc[ai][1][m][i >> 2][i & 3]; }
#pragma unroll
                for (int i = 0; i < 8; ++i) t[i] = __builtin_amdgcn_exp2f(t[i]);
#pragma unroll
                for (int i = 0; i < 8; ++i) t[i] = t[i] + 1.0f;
#pragma unroll
                for (int i = 0; i < 8; ++i) t[i] = __builtin_amdgcn_rcpf(t[i]);
#pragma unroll
                for (int i = 0; i < 8; ++i) t[i] = t[i] * gu[i];
                asm volatile("" : "+v"(t[0]), "+v"(t[1]), "+v"(t[2]), "+v"(t[3]), "+v"(t[4]), "+v"(t[5]), "+v"(t[6]), "+v"(t[7]));
                u32x4 w; w.x = cvt_pk_bf16(t[0], t[1]); w.y = cvt_pk_bf16(t[2], t[3]); w.z = cvt_pk_bf16(t[4], t[5]); w.w = cvt_pk_bf16(t[6], t[7]);
                *(u32x4*)rowp = w; }
    }
};
struct EpiGLUY {
    static constexpr bool PERM = true, AFTER_DRAIN = false;
    bf16_t* Y; const float* gmod;
    __device__ __forceinline__ void operator()(const f32x4 (&acc)[2][2][4][2], const Unit& u, int wr, int wc, int fr, int fq) const {
        const int row0 = u.pm * BM + wr * 64 + fr, col0 = u.pn * HALF + wc * 32 + 8 * fq, b = u.pm >> 4;
        f32x4 gm[2];
#pragma unroll
        for (int n = 0; n < 2; ++n) gm[n] = *(const f32x4*)(gmod + (size_t)b * 6 * 4096 + col0 + 4 * n) + 1.0f;
#pragma unroll
        for (int ai = 0; ai < 2; ++ai)
#pragma unroll
            for (int m = 0; m < 4; ++m) { float r[8], t[8];
#pragma unroll
                for (int i = 0; i < 8; ++i) { t[i] = -1.44269504089f * acc[ai][1][m][i >> 2][i & 3]; r[i] = gm[i >> 2][i & 3] * acc[ai][0][m][i >> 2][i & 3]; }
#pragma unroll
                for (int i = 0; i < 8; ++i) t[i] = __builtin_amdgcn_exp2f(t[i]);
#pragma unroll
                for (int i = 0; i < 8; ++i) t[i] = t[i] + 1.0f;
#pragma unroll
                for (int i = 0; i < 8; ++i) t[i] = __builtin_amdgcn_rcpf(t[i]);
#pragma unroll
                for (int i = 0; i < 8; ++i) r[i] = r[i] * t[i];
                asm volatile("" : "+v"(r[0]), "+v"(r[1]), "+v"(r[2]), "+v"(r[3]), "+v"(r[4]), "+v"(r[5]), "+v"(r[6]), "+v"(r[7]));
                u32x4 w; w.x = cvt_pk_bf16(r[0], r[1]); w.y = cvt_pk_bf16(r[2], r[3]); w.z = cvt_pk_bf16(r[4], r[5]); w.w = cvt_pk_bf16(r[6], r[7]);
                *(u32x4*)(Y + (size_t)(row0 + ai * HALF + m * 16) * 4096 + col0) = w; }
    }
};
struct EpiY {
    static constexpr bool PERM = true, AFTER_DRAIN = false;
    bf16_t* Y; const float* gmod;
    __device__ __forceinline__ void operator()(const f32x4 (&acc)[2][2][4][2], const Unit& u, int wr, int wc, int fr, int fq) const {
        const int row0 = u.pm * BM + wr * 64 + fr, col0 = u.pn * BM + wc * 32 + 8 * fq, b = u.pm >> 4;
        f32x4 gm[2][2];
#pragma unroll
        for (int bj = 0; bj < 2; ++bj)
#pragma unroll
            for (int n = 0; n < 2; ++n) gm[bj][n] = *(const f32x4*)(gmod + (size_t)b * 6 * 4096 + col0 + bj * HALF + 4 * n) + 1.0f;
#pragma unroll
        for (int ai = 0; ai < 2; ++ai)
#pragma unroll
            for (int m = 0; m < 4; ++m) { bf16_t* rowp = Y + (size_t)(row0 + ai * HALF + m * 16) * 4096 + col0;
#pragma unroll
                for (int bj = 0; bj < 2; ++bj) { const f32x4 v0 = acc[ai][bj][m][0] * gm[bj][0], v1 = acc[ai][bj][m][1] * gm[bj][1];
                    u32x4 w; w.x = cvt_pk_bf16(v0[0], v0[1]); w.y = cvt_pk_bf16(v0[2], v0[3]); w.z = cvt_pk_bf16(v1[0], v1[1]); w.w = cvt_pk_bf16(v1[2], v1[3]);
                    *(u32x4*)(rowp + bj * HALF) = w; } }
    }
};
template <class Epi, class Sched, bool ALIGN_EPI, bool SP2, int KD>
__device__ __forceinline__ void gemm_phase(PG8_LAS unsigned char* lds, const Gemm g, const Sched& S, const Epi& E) {
    int tid_ = threadIdx.x; asm volatile("" : "+v"(tid_));
    const int tid = tid_, wid = __builtin_amdgcn_readfirstlane(tid >> 6), lane = tid & 63, wr = wid >> 2, wc = wid & 3, fr = lane & 15, fq = lane >> 4;
    constexpr int K = KD, nt = K / BK; static_assert(KD % 128 == 0 && KD >= 256, "K");
    unsigned voffA[2], voffB[2];
#pragma unroll
    for (int i = 0; i < 2; ++i) { int R, C; stage_rc(tid * 16 + i * 8192, R, C); const int Rb = Epi::PERM ? ((R & ~31) + perm32(R & 31)) : R;
        voffA[i] = (unsigned)(R * K + C) * 2u; voffB[i] = (unsigned)(Rb * K + C) * 2u; }
    const size_t kstep = (size_t)(BK * 2);
    const size_t hstep = (size_t)HALF * K * 2;
    const size_t tstep = 2 * hstep;
    const unsigned ldsw = (unsigned)wid * 1024u;
    const int aoff = lds_byte(wr * 64 + fr, fq * 8), boff = lds_byte(wc * 32 + fr, fq * 8);
#define PG8_SA(b, h) (((b) * 2 + (h)) * HTB)
#define PG8_SB(b, h) ((4 + (b) * 2 + (h)) * HTB)
#define PG8_STAGE(bufoff, gbase, voff) do { _Pragma("unroll") for (int _i = 0; _i < 2; ++_i) \
        __builtin_amdgcn_global_load_lds((const unsigned*)((const char*)(gbase) + (voff)[_i]), (PG8_LAS unsigned*)(lds + (bufoff) + ldsw + _i * 8192), 16, 0, 0); } while (0)
#define PG8_LDA(dst, b, h) do { _Pragma("unroll") for (int m = 0; m < 4; ++m) _Pragma("unroll") for (int k = 0; k < 2; ++k) dst[m][k] = *(const PG8_LAS bf16x8*)(lds + PG8_SA(b, h) + aoff + m * 2048 + k * 1024); } while (0)
#define PG8_LDB(dst, b, h) do { _Pragma("unroll") for (int n = 0; n < 2; ++n) _Pragma("unroll") for (int k = 0; k < 2; ++k) dst[n][k] = *(const PG8_LAS bf16x8*)(lds + PG8_SB(b, h) + boff + n * 2048 + k * 1024); } while (0)
#define PG8_MMA(ai, bj, At, Bt) do { __builtin_amdgcn_s_setprio(1); _Pragma("unroll") for (int m = 0; m < 4; ++m) _Pragma("unroll") for (int n = 0; n < 2; ++n) _Pragma("unroll") for (int k = 0; k < 2; ++k) \
        acc[ai][bj][m][n] = __builtin_amdgcn_mfma_f32_16x16x32_bf16(Bt[n][k], At[m][k], acc[ai][bj][m][n], 0, 0, 0); __builtin_amdgcn_s_setprio(0); } while (0)
#define PG8_WAIT_V(n) asm volatile("s_waitcnt vmcnt(" #n ")" ::: "memory")
#define PG8_WAIT_L(n) asm volatile("s_waitcnt lgkmcnt(" #n ")" ::: "memory")
#define PG8_BAR __builtin_amdgcn_s_barrier()
#define PG8_SCHED __builtin_amdgcn_sched_barrier(0)
    Unit cur, nxt; int ui = 0;
    if (!S.next(0, cur)) return;
    f32x4 acc[2][2][4][2];
#pragma unroll
    for (int a = 0; a < 2; ++a)
#pragma unroll
        for (int b = 0; b < 2; ++b)
#pragma unroll
            for (int m = 0; m < 4; ++m)
#pragma unroll
                for (int n = 0; n < 2; ++n) acc[a][b][m][n] = (f32x4){0.f, 0.f, 0.f, 0.f};
    bf16x8 At[4][2], B0[2][2], B1[2][2];
    const char* cA = (const char*)g.A + (size_t)cur.pm * tstep; const char* cB = (const char*)g.Bt + (size_t)cur.pn * tstep;
    S.a_ready(cur);
    if constexpr (SP2) {
        PG8_STAGE(PG8_SB(0, 0), cB, voffB); PG8_STAGE(PG8_SB(0, 1), cB + hstep, voffB); PG8_STAGE(PG8_SA(0, 0), cA, voffA); PG8_STAGE(PG8_SA(0, 1), cA + hstep, voffA);
        if (wr == 1) PG8_BAR;
        PG8_WAIT_V(2); PG8_BAR;
        PG8_STAGE(PG8_SB(1, 0), cB + kstep, voffB); PG8_STAGE(PG8_SA(1, 0), cA + kstep, voffA); PG8_STAGE(PG8_SB(1, 1), cB + hstep + kstep, voffB);
        PG8_WAIT_V(6); PG8_BAR;
    } else {
        PG8_STAGE(PG8_SB(0, 0), cB, voffB); PG8_STAGE(PG8_SA(0, 0), cA, voffA); PG8_STAGE(PG8_SB(0, 1), cB + hstep, voffB); PG8_STAGE(PG8_SA(0, 1), cA + hstep, voffA);
        if (wr == 1) PG8_BAR;
        PG8_WAIT_V(4); PG8_BAR;
        PG8_STAGE(PG8_SB(1, 0), cB + kstep, voffB); PG8_STAGE(PG8_SA(1, 0), cA + kstep, voffA); PG8_STAGE(PG8_SB(1, 1), cB + hstep + kstep, voffB);
        PG8_WAIT_V(6); PG8_BAR;
    }
    for (;;) {
        const bool has_next = S.next(ui + 1, nxt);
        const char* nA = has_next ? (const char*)g.A + (size_t)nxt.pm * tstep : cA; const char* nB = has_next ? (const char*)g.Bt + (size_t)nxt.pn * tstep : cB;
        for (int t = 0; t < nt; t += 2) {
            const bool last = (t == nt - 2);
            const char* a1 = cA + (size_t)(t + 1) * kstep;
            const char* a2 = last ? nA : cA + (size_t)(t + 2) * kstep; const char* b2 = last ? nB : cB + (size_t)(t + 2) * kstep;
            const char* a3 = a2 + kstep; const char* b3 = b2 + kstep;
            if (last && has_next) S.a_ready(nxt);
            if constexpr (SP2) {
            PG8_LDB(B0, 0, 0); PG8_LDB(B1, 0, 1); PG8_SCHED; PG8_LDA(At, 0, 0); PG8_STAGE(PG8_SA(1, 1), a1 + hstep, voffA);
            PG8_WAIT_V(8); PG8_WAIT_L(0); PG8_BAR; PG8_MMA(0, 0, At, B0); PG8_MMA(0, 1, At, B1); PG8_BAR; PG8_SCHED;
            PG8_LDA(At, 0, 1); PG8_STAGE(PG8_SB(0, 0), b2, voffB); PG8_STAGE(PG8_SB(0, 1), b2 + hstep, voffB); PG8_STAGE(PG8_SA(0, 0), a2, voffA);
            PG8_WAIT_V(8); PG8_WAIT_L(0); PG8_BAR; PG8_MMA(1, 0, At, B0); PG8_MMA(1, 1, At, B1); PG8_BAR; PG8_SCHED;
            PG8_LDB(B0, 1, 0); PG8_LDB(B1, 1, 1); PG8_SCHED; PG8_LDA(At, 1, 0); PG8_STAGE(PG8_SA(0, 1), a2 + hstep, voffA);
            PG8_WAIT_V(8); PG8_WAIT_L(0); PG8_BAR; PG8_MMA(0, 0, At, B0); PG8_MMA(0, 1, At, B1); PG8_BAR; PG8_SCHED;
            PG8_LDA(At, 1, 1); PG8_STAGE(PG8_SB(1, 0), b3, voffB); PG8_STAGE(PG8_SB(1, 1), b3 + hstep, voffB); PG8_STAGE(PG8_SA(1, 0), a3, voffA);
            PG8_WAIT_V(8); PG8_WAIT_L(0); PG8_BAR; PG8_MMA(1, 0, At, B0); PG8_MMA(1, 1, At, B1); PG8_BAR; PG8_SCHED;
            } else {
            PG8_LDB(B0, 0, 0); PG8_SCHED; PG8_LDA(At, 0, 0); PG8_STAGE(PG8_SA(1, 1), a1 + hstep, voffA);
            PG8_WAIT_L(8); PG8_BAR; PG8_WAIT_L(0); PG8_MMA(0, 0, At, B0); PG8_BAR; PG8_SCHED;
            PG8_LDB(B1, 0, 1); PG8_STAGE(PG8_SB(0, 0), b2, voffB);
            PG8_BAR; PG8_WAIT_L(0); PG8_MMA(0, 1, At, B1); PG8_BAR;
            PG8_LDA(At, 0, 1); PG8_STAGE(PG8_SA(0, 0), a2, voffA);
            PG8_BAR; PG8_WAIT_L(0); PG8_MMA(1, 0, At, B0); PG8_BAR; PG8_SCHED;
            PG8_STAGE(PG8_SB(0, 1), b2 + hstep, voffB);
            PG8_WAIT_V(6); PG8_BAR; PG8_MMA(1, 1, At, B1); PG8_BAR;
            PG8_LDB(B0, 1, 0); PG8_SCHED; PG8_LDA(At, 1, 0); PG8_STAGE(PG8_SA(0, 1), a2 + hstep, voffA);
            PG8_WAIT_L(8); PG8_BAR; PG8_WAIT_L(0); PG8_MMA(0, 0, At, B0); PG8_BAR; PG8_SCHED;
            PG8_LDB(B1, 1, 1); PG8_STAGE(PG8_SB(1, 0), b3, voffB);
            PG8_BAR; PG8_WAIT_L(0); PG8_MMA(0, 1, At, B1); PG8_BAR;
            PG8_LDA(At, 1, 1); PG8_STAGE(PG8_SA(1, 0), a3, voffA);
            PG8_BAR; PG8_WAIT_L(0); PG8_MMA(1, 0, At, B0); PG8_BAR; PG8_SCHED;
            PG8_STAGE(PG8_SB(1, 1), b3 + hstep, voffB);
            PG8_WAIT_V(6); PG8_BAR; PG8_MMA(1, 1, At, B1); PG8_BAR;
            }
        }
        if constexpr (ALIGN_EPI) { if (wr == 0) PG8_BAR; }
        if constexpr (!Epi::AFTER_DRAIN) { E(acc, cur, wr, wc, fr, fq); S.done(cur); }
        if (!has_next) break;
#pragma unroll
        for (int a = 0; a < 2; ++a)
#pragma unroll
            for (int b = 0; b < 2; ++b)
#pragma unroll
                for (int m = 0; m < 4; ++m)
#pragma unroll
                    for (int n = 0; n < 2; ++n) acc[a][b][m][n] = (f32x4){0.f, 0.f, 0.f, 0.f};
        cur = nxt; cA = nA; cB = nB; ++ui;
        if constexpr (ALIGN_EPI) { if (wr == 1) PG8_BAR; }
    }
    PG8_WAIT_V(0);
    if constexpr (!ALIGN_EPI) { if (wr == 0) PG8_BAR; }
    PG8_BAR;
    if constexpr (Epi::AFTER_DRAIN) { E.fused(acc, cur, wr, wc, fr, fq, lds, wid, lane); S.done(cur); }
#undef PG8_SA
#undef PG8_SB
#undef PG8_STAGE
#undef PG8_LDA
#undef PG8_LDB
#undef PG8_MMA
#undef PG8_WAIT_V
#undef PG8_WAIT_L
#undef PG8_BAR
#undef PG8_SCHED
}
}

#ifndef MK_ONE_LAUNCH
#define MK_ONE_LAUNCH 1
#endif
constexpr int NWAVES = 8, NTHR = 512;
constexpr int DM = 4096, SEQ = 4096, MROWS = 8192, DFF = 11008, NQKV = 5120;
constexpr int TC = 64, NCHUNK = 64;
constexpr float LN_EPS = 1e-5f;
constexpr int N_PHASES = 3 + 8 * 4;

#define GAS __attribute__((address_space(1)))
#define LAS __attribute__((address_space(3)))
typedef unsigned short bf16;
typedef float f32x4 __attribute__((ext_vector_type(4)));
typedef unsigned u32x4 __attribute__((ext_vector_type(4)));
typedef unsigned u32x2 __attribute__((ext_vector_type(2)));
typedef short bf16x8 __attribute__((ext_vector_type(8)));

constexpr size_t MiB = 1u << 20;
constexpr size_t alignup(size_t x) { return (x + MiB - 1) & ~(MiB - 1); }
constexpr size_t WS_CTL = 0, CTL_BYTES = 1 * MiB;
constexpr size_t WS_MODP = 1 * MiB,                    SZ_MODP = 64ull * 2 * 24576 * 4;
constexpr size_t WS_MODSL = alignup(WS_MODP + SZ_MODP), SZ_MODSL = 4ull * 2 * 6 * 4096 * 4;
constexpr size_t WS_ABAR = alignup(WS_MODSL + SZ_MODSL), SZ_ABAR = 2ull * 256 * 2 * 64 * 4;
constexpr size_t WS_ABART = alignup(WS_ABAR + SZ_ABAR);
constexpr size_t WS_BBAR = alignup(WS_ABART + SZ_ABAR), SZ_BBAR = 2ull * 256 * 8 * 64 * 16;
constexpr size_t WS_E = alignup(WS_BBAR + SZ_BBAR),     SZ_E = 2ull * 64 * 256 * 2 * 64 * 4;
constexpr size_t SZ_WIN = 22016ull * 4096 * 2, SZ_WDN = 4096ull * 11008 * 2, SZ_WGLU = 8192ull * 4096 * 2, SZ_WQKV = 5120ull * 4096 * 2, SZ_WO = 4096ull * 4096 * 2;
constexpr size_t WS_SP = alignup(WS_E + SZ_E);
constexpr size_t WS_WIN = alignup(WS_SP + SZ_E);
constexpr size_t WS_WDN = alignup(WS_WIN + 4 * SZ_WIN);
constexpr size_t WS_WGLU = alignup(WS_WDN + 4 * SZ_WDN);
constexpr size_t WS_WQKV = alignup(WS_WGLU + 2 * SZ_WGLU);
constexpr size_t WS_WO = alignup(WS_WQKV + 2 * SZ_WQKV);
constexpr size_t WS_H = alignup(WS_WO + 2 * SZ_WO),    SZ_H = 8192ull * 4096 * 2;
constexpr size_t WS_ACT = alignup(WS_H + SZ_H),        SZ_ACT = 8192ull * 11008 * 2;
constexpr size_t WS_Z = alignup(WS_ACT + SZ_ACT),      SZ_Z = 8192ull * 4096 * 4;
constexpr size_t WS_X = alignup(WS_Z + SZ_Z);
constexpr size_t WS_X2 = alignup(WS_X + SZ_Z);
constexpr size_t WS_QKV = alignup(WS_X2 + SZ_Z),        SZ_QKV = 8192ull * 5120 * 2;
constexpr size_t WS_O = alignup(WS_QKV + SZ_QKV);
constexpr size_t WS_U = alignup(WS_O + SZ_H);
constexpr size_t WS_END = alignup(WS_U + SZ_H);
constexpr int CW_BAR = 4096;

constexpr int RING_BYTES = 131072, LDSCTL_OFF = RING_BYTES, MISC_OFF = LDSCTL_OFF + 320, LDS_BYTES = 147456;

__device__ __forceinline__ unsigned pk2(float lo, float hi) { return pg8::cvt_pk_bf16(lo, hi); }
__device__ __forceinline__ float bf_lo(unsigned w) { return __uint_as_float(w << 16); }
__device__ __forceinline__ float bf_hi(unsigned w) { return __uint_as_float(w & 0xffff0000u); }
template <int CTRL> __device__ __forceinline__ float dpp_mov(float x) { return __builtin_bit_cast(float, __builtin_amdgcn_mov_dpp(__builtin_bit_cast(int, x), CTRL, 0xf, 0xf, true)); }
__device__ __forceinline__ float wave_sum(float v) {
    v += dpp_mov<0xB1>(v);
    v += dpp_mov<0x4E>(v);
    v += dpp_mov<0x124>(v);
    v += dpp_mov<0x128>(v);
    const auto s = __builtin_amdgcn_permlane16_swap(__float_as_uint(v), __float_as_uint(v), false, false);
    v = __uint_as_float(s[0]) + __uint_as_float(s[1]);
    const auto t = __builtin_amdgcn_permlane32_swap(__float_as_uint(v), __float_as_uint(v), false, false);
    return __uint_as_float(t[0]) + __uint_as_float(t[1]);
}

#define XB_TMO      128
#define XB_XCNT(j)  (256  + 64 * (j))
#define XB_XSUB(j)  (1280 + 64 * (j))
#define XB_XGEN(j)  (2304 + 64 * (j))
#define XB_TOP      3328
#define XB_TOPGEN   3392
#define XCD_BAR_WORDS 3456
#define XB_SPIN_CAP (1u << 20)

__device__ __forceinline__ unsigned xb_ld(unsigned* p)              { return __hip_atomic_load(p, __ATOMIC_RELAXED, __HIP_MEMORY_SCOPE_AGENT); }
__device__ __forceinline__ unsigned xb_add(unsigned* p, unsigned v) { return __hip_atomic_fetch_add(p, v, __ATOMIC_RELAXED, __HIP_MEMORY_SCOPE_AGENT); }
__device__ __forceinline__ unsigned xb_xcc_id() { return (unsigned)__builtin_amdgcn_s_getreg((3 << 11) | 20) & 0xFu; }
#define XB_SPIN(cond, bar) do { unsigned _sp = 0; while (cond) { __builtin_amdgcn_s_sleep(1); \
    if ((++_sp & 255u) == 0u) { if (xb_ld(&(bar)[XB_TMO])) break; if (_sp > XB_SPIN_CAP) { atomicAdd(&(bar)[XB_TMO], 1u); break; } } } } while (0)

struct XcdBarrier { unsigned* bar; unsigned x; volatile LAS unsigned* st; };
__device__ __forceinline__ XcdBarrier xcd_barrier_post(unsigned* bar, volatile LAS unsigned* st) {
    XcdBarrier b; b.bar = bar; b.x = xb_xcc_id(); b.st = st;
    if (threadIdx.x == 0) (void)xb_add(&bar[XB_XCNT(b.x)], 1u);
    return b;
}
__device__ __forceinline__ void xcd_barrier_complete(unsigned* bar, unsigned x, unsigned& nloc, unsigned& nx) {
    const unsigned G = gridDim.x * gridDim.y * gridDim.z;
    unsigned sum, cnt, mine, sp = 0u;
    for (;;) {
        sum = 0u; cnt = 0u; mine = 0u;
#pragma unroll
        for (unsigned j = 0; j < 16; ++j) { const unsigned c = xb_ld(&bar[XB_XCNT(j)]); sum += c; cnt += (c > 0u) ? 1u : 0u; mine = (j == x) ? c : mine; }
        if (sum == G) break;
        __builtin_amdgcn_s_sleep(1);
        if ((++sp & 255u) == 0u) { if (xb_ld(&bar[XB_TMO])) break; if (sp > XB_SPIN_CAP) { atomicAdd(&bar[XB_TMO], 1u); break; } }
    }
    nloc = mine > 0u ? mine : 1u; nx = cnt > 0u ? cnt : 1u;
}
__device__ __forceinline__ void xcd_barrier(const XcdBarrier& b) {
    asm volatile("s_waitcnt vmcnt(0)" ::: "memory");
    __syncthreads();
    if (threadIdx.x == 0) {
        unsigned* bar = b.bar;
        __builtin_amdgcn_s_waitcnt(0);
        unsigned nloc = b.st[0], nx = b.st[1];
        if (nloc == 0u) { xcd_barrier_complete(bar, b.x, nloc, nx); b.st[0] = nloc; b.st[1] = nx; }
        const unsigned old = xb_add(&bar[XB_XSUB(b.x)], 1u);
        const unsigned gen = old / nloc;
        if (old + 1u == (gen + 1u) * nloc) {
            __builtin_amdgcn_fence(__ATOMIC_RELEASE, "agent");
            asm volatile("s_waitcnt vmcnt(0)" ::: "memory");
            const unsigned og = xb_add(&bar[XB_TOP], 1u);
            const unsigned tg = og / nx;
            if (og + 1u == (tg + 1u) * nx) xb_add(&bar[XB_TOPGEN], 1u);
            else XB_SPIN(xb_ld(&bar[XB_TOPGEN]) == tg, bar);
            __builtin_amdgcn_fence(__ATOMIC_ACQUIRE, "agent");
            xb_add(&bar[XB_XGEN(b.x)], 1u);
            asm volatile("s_waitcnt vmcnt(0)" ::: "memory");
        } else {
            XB_SPIN(xb_ld(&bar[XB_XGEN(b.x)]) == gen, bar);
            __builtin_amdgcn_fence(__ATOMIC_ACQUIRE, "agent");
            asm volatile("s_waitcnt vmcnt(0)" ::: "memory");
        }
    }
    __syncthreads();
}

__device__ const unsigned char kBucket[128] = {0, 1, 2, 3, 4, 5, 6, 7, 8, 9, 10, 11, 12, 13, 14, 15, 16, 16, 16, 17, 17, 18, 18, 18, 19, 19, 19, 20, 20, 20, 20, 21, 21, 21, 21, 22, 22, 22, 22, 22, 23, 23, 23, 23, 23, 23,
    24, 24, 24, 24, 24, 24, 25, 25, 25, 25, 25, 25, 25, 26, 26, 26, 26, 26, 26, 26, 26, 27, 27, 27, 27, 27, 27, 27, 27, 27, 27, 28, 28, 28, 28, 28, 28, 28, 28, 28, 28, 29, 29, 29, 29, 29, 29, 29, 29, 29, 29, 29, 29,
    30, 30, 30, 30, 30, 30, 30, 30, 30, 30, 30, 30, 30, 30, 31, 31, 31, 31, 31, 31, 31, 31, 31, 31, 31, 31, 31, 31, 31};

__device__ __forceinline__ void p0_transpose_item(const float* W, int K, int N, int ldw, bf16* WT, int mode, LAS float* scr, int item, int lane) {
    const int nblk = N / 32, kb = item / nblk, nb = item % nblk, k0 = 64 * kb, n0 = 32 * nb;
    const int r0 = mode == 0 ? n0 : (256 * (n0 >> 7) + 128 * (mode - 1) + (n0 & 127));
    f32x4 v[8];
#pragma unroll
    for (int i = 0; i < 8; ++i) v[i] = __builtin_nontemporal_load((const f32x4*)(W + (size_t)(k0 + 8 * i + (lane >> 3)) * ldw + n0 + 4 * (lane & 7)));
#pragma unroll
    for (int i = 0; i < 8; ++i) { LAS float* d = scr + (8 * i + (lane >> 3)) * 33 + 4 * (lane & 7); d[0] = v[i][0]; d[1] = v[i][1]; d[2] = v[i][2]; d[3] = v[i][3]; }
    asm volatile("s_waitcnt lgkmcnt(0)" ::: "memory");
    const int c = lane & 7;
#pragma unroll
    for (int j = 0; j < 4; ++j) { const int n = (lane >> 3) + 8 * j; const LAS float* s = scr + (8 * c) * 33 + n;
        u32x4 o; o.x = pk2(s[0 * 33], s[1 * 33]); o.y = pk2(s[2 * 33], s[3 * 33]); o.z = pk2(s[4 * 33], s[5 * 33]); o.w = pk2(s[6 * 33], s[7 * 33]);
        __builtin_nontemporal_store(o, (u32x4*)(WT + (size_t)(r0 + n) * K + k0 + 8 * c)); }
    asm volatile("s_waitcnt lgkmcnt(0)" ::: "memory");
}

template <int I> __device__ __forceinline__ const float* in_ptr() {
    unsigned long long v; const unsigned long long kav = (unsigned long long)__builtin_amdgcn_kernarg_segment_ptr();
    const unsigned ka_lo = __builtin_amdgcn_readfirstlane((unsigned)kav), ka_hi = __builtin_amdgcn_readfirstlane((unsigned)(kav >> 32));
    const unsigned long long ka = ((unsigned long long)ka_hi << 32) | ka_lo;
    asm volatile("s_load_dwordx2 %0, %1, %2\n\ts_waitcnt lgkmcnt(0)" : "=s"(v) : "s"(ka), "n"(I * 8));
    return (const float*)(const GAS float*)v;
}
__device__ __forceinline__ unsigned char* ws_ptr() { return (unsigned char*)in_ptr<25>(); }
__device__ __forceinline__ float* out_ptr() { return (float*)in_ptr<24>(); }
#define PHASE_IDS() int tid_ = threadIdx.x; asm volatile("" : "+v"(tid_)); const int tid = tid_, lane = tid & 63, wave = __builtin_amdgcn_readfirstlane(tid >> 6); (void)lane; (void)wave; unsigned char* const ws = ws_ptr(); (void)ws
constexpr int XP_IT_A = 64 * 344, XP_IT_SQ = 64 * 128, XP_IT_QKV = 64 * 160, XP_PER_L = 3 * XP_IT_A, XP_PER_J = 3 * XP_IT_SQ + XP_IT_QKV;
static_assert((11008 / 64) * (4096 / 32) == XP_IT_A, "w_down items");
constexpr int XG_MIX0 = 0, XG_FFN0 = XG_MIX0 + XP_PER_J, XG_FFN1 = XG_FFN0 + XP_PER_L, XG_GLU1 = XG_FFN1 + XP_PER_L, XG_FFN2 = XG_GLU1 + 2 * XP_IT_SQ, XG_QKVO1 = XG_FFN2 + XP_PER_L,
              XG_FFN3 = XG_QKVO1 + XP_IT_QKV + XP_IT_SQ, XG_END = XG_FFN3 + XP_PER_L;
static_assert(XG_FFN0 == 34816 && XG_FFN1 == 100864 && XG_GLU1 == 166912 && XG_FFN2 == 183296 && XG_QKVO1 == 249344 && XG_FFN3 == 267776 && XG_END == 333824, "conversion list");
constexpr int XS_P0A_LO = 0, XS_P0A_HI = XG_FFN0;
constexpr int XS_L0S1_LO = XG_FFN0, XS_L0S1_HI = XG_FFN0 + XP_PER_L / 2, XS_L0S3_LO = XS_L0S1_HI, XS_L0S3_HI = XG_FFN1;
constexpr int XS_T0_LO = XG_FFN1, XS_T0_HI = XG_FFN1 + 16384;
constexpr int XS_T1Q_LO = XS_T0_HI, XS_T1Q_HI = XS_T0_HI + 32768;
constexpr int XS_X = 8448;
constexpr int XS_L0S1X_LO = XS_T1Q_HI, XS_L0S3X_LO = XS_T1Q_HI + XS_X;
constexpr int XS_P0B_LO = XS_T1Q_HI + 2 * XS_X, XS_P0B_HI = XG_GLU1;
constexpr int XS_T1_LO = XG_GLU1, XS_T1_HI = XG_FFN2;
constexpr int XS_L2S1_LO = XG_FFN2, XS_L2S1_HI = XG_FFN2 + XP_PER_L / 2, XS_L2S3_LO = XS_L2S1_HI, XS_L2S3_HI = XG_QKVO1;
constexpr int XS_T2_LO = XG_QKVO1, XS_T2_HI = XG_QKVO1 + 16384;
constexpr int XS_T3Q_LO = XS_T2_HI, XS_T3Q_HI = XS_T2_HI + 32768;
constexpr int XS_L2S1X_LO = XS_T3Q_HI, XS_L2S3X_LO = XS_T3Q_HI + XS_X;
constexpr int XS_P0C_LO = XS_T3Q_HI + 2 * XS_X, XS_P0C_HI = XG_END;
static_assert(XS_P0B_LO <= XS_P0B_HI && XS_P0C_LO <= XS_P0C_HI && XS_T1Q_HI < XG_GLU1 && XS_T2_HI > XG_QKVO1 + XP_IT_QKV && XS_T2_HI < XG_FFN3 && XS_T3Q_HI < XG_END, "conversion deal");
__device__ __forceinline__ void xpose_global_item(int idx, LAS float* scr, int lane) {
    unsigned char* const ws = ws_ptr();
    const float* W; bf16* WT; int K = 4096, N = 4096, ldw = 4096, mode = 0, r;
    const bool mix = idx < XG_FFN0 || (idx >= XG_GLU1 && idx < XG_FFN2) || (idx >= XG_QKVO1 && idx < XG_FFN3);
    if (!mix) {
        int l, base;
        if (idx < XG_FFN1) { l = 0; base = XG_FFN0; } else if (idx < XG_GLU1) { l = 1; base = XG_FFN1; } else if (idx < XG_QKVO1) { l = 2; base = XG_FFN2; } else { l = 3; base = XG_FFN3; }
        r = idx - base; const int which = r / XP_IT_A; r -= which * XP_IT_A;
        if (which < 2) { W = in_ptr<7>() + (size_t)l * 4096 * 22016 + which * 11008; N = 11008; ldw = 22016; WT = (bf16*)(ws + WS_WIN + l * SZ_WIN); mode = 1 + which; }
        else { W = in_ptr<8>() + (size_t)l * 11008 * 4096; K = 11008; WT = (bf16*)(ws + WS_WDN + l * SZ_WDN); }
    } else {
        int j;
        if (idx < XG_FFN0) { j = 0; r = idx; } else if (idx < XG_FFN2) { j = 1; r = idx - XG_GLU1; } else { j = 1; r = idx - XG_QKVO1 + 2 * XP_IT_SQ; }
        if (r < XP_IT_SQ) { W = in_ptr<22>() + (size_t)j * 4096 * 4096; WT = (bf16*)(ws + WS_WGLU + j * SZ_WGLU); mode = 1; }
        else if (r < 2 * XP_IT_SQ) { W = in_ptr<23>() + (size_t)j * 4096 * 4096; WT = (bf16*)(ws + WS_WGLU + j * SZ_WGLU); mode = 2; r -= XP_IT_SQ; }
        else if (r < 2 * XP_IT_SQ + XP_IT_QKV) { W = in_ptr<9>() + (size_t)j * 4096 * 5120; N = 5120; ldw = 5120; WT = (bf16*)(ws + WS_WQKV + j * SZ_WQKV); r -= 2 * XP_IT_SQ; }
        else { W = in_ptr<11>() + (size_t)j * 4096 * 4096; WT = (bf16*)(ws + WS_WO + j * SZ_WO); r -= 2 * XP_IT_SQ + XP_IT_QKV; }
    }
    p0_transpose_item(W, K, N, ldw, WT, mode, scr, r, lane);
}
__device__ __forceinline__ void host_tail(LAS unsigned char* lds, int nunits, int lo, int hi) {
    PHASE_IDS();
    const int first = nunits % (int)gridDim.x;
    if ((int)blockIdx.x < first) return;
    const int nw = ((int)gridDim.x - first) * NWAVES, w = ((int)blockIdx.x - first) * NWAVES + wave;
    LAS float* scr = (LAS float*)(lds + wave * 16384);
    for (int it = lo + w; it < hi; it += nw) xpose_global_item(it, scr, lane);
}

__device__ __forceinline__ void phase0(LAS unsigned char* lds) {
    PHASE_IDS();
    const int gw = blockIdx.x * NWAVES + wave, ngw = gridDim.x * NWAVES, gtid = blockIdx.x * NTHR + tid, gthr = gridDim.x * NTHR;
    {
        LAS float* sc = (LAS float*)lds;
        const float* c = in_ptr<1>();
        for (int i = tid; i < 2 * 4096; i += NTHR) { const float v = c[i]; sc[i] = v / (1.0f + expf(-v)); }
        __syncthreads();
        const float* w_ada = in_ptr<2>(); float* modp = (float*)(ws + WS_MODP);
        for (int it = gw; it < 96 * 64; it += ngw) {
            const int cb = it % 96, ks = it / 96;
            const float* wp = w_ada + (size_t)(ks * 64) * 24576 + cb * 256 + lane * 4;
            f32x4 a0 = {0.f, 0.f, 0.f, 0.f}, a1 = {0.f, 0.f, 0.f, 0.f};
#pragma unroll 8
            for (int k = 0; k < 64; ++k) { const f32x4 w = __builtin_nontemporal_load((const f32x4*)(wp + (size_t)k * 24576)); const float s0 = sc[ks * 64 + k], s1 = sc[4096 + ks * 64 + k]; a0 += s0 * w; a1 += s1 * w; }
            *(f32x4*)(modp + ((size_t)ks * 2 + 0) * 24576 + cb * 256 + lane * 4) = a0;
            *(f32x4*)(modp + ((size_t)ks * 2 + 1) * 24576 + cb * 256 + lane * 4) = a1;
        }
        __syncthreads();
    }
    {
        const float* a_re = in_ptr<14>(); const float* a_im = in_ptr<15>(); const float* log_dt = in_ptr<16>(); const float* b_re = in_ptr<17>(); const float* b_im = in_ptr<18>();
        float* ABAR = (float*)(ws + WS_ABAR); float* ABART = (float*)(ws + WS_ABART); u32x4* BFRAG = (u32x4*)(ws + WS_BBAR);
        for (int i = gtid; i < 2 * 256 * 64; i += gthr) {
            const int p = i & 63, jg = i >> 6;
            const float are = a_re[i], aim = a_im[i], dt = expf(log_dt[jg]);
            const float mag = expf(are * dt), ang = aim * dt;
            const float abr = mag * cosf(ang), abi = mag * sinf(ang);
            const float den = are * are + aim * aim, nr = abr - 1.0f;
            const float kre = (nr * are + abi * aim) / den, kim = (abi * are - nr * aim) / den;
            ABAR[(jg * 2 + 0) * 64 + p] = abr; ABAR[(jg * 2 + 1) * 64 + p] = abi;
            float tr = abr, ti = abi;
#pragma unroll
            for (int q = 0; q < 6; ++q) { const float n2 = tr * tr - ti * ti, i2 = 2.0f * tr * ti; tr = n2; ti = i2; }
            ABART[(jg * 2 + 0) * 64 + p] = tr; ABART[(jg * 2 + 1) * 64 + p] = ti;
            const f32x4* br = (const f32x4*)(b_re + (size_t)i * 16); const f32x4* bi = (const f32x4*)(b_im + (size_t)i * 16);
            float vr[16], vi[16];
#pragma unroll
            for (int q = 0; q < 4; ++q) { const f32x4 r = br[q], m = bi[q];
#pragma unroll
                for (int e = 0; e < 4; ++e) { vr[q * 4 + e] = kre * r[e] - kim * m[e]; vi[q * 4 + e] = kre * m[e] + kim * r[e]; } }
            u32x4* fr_re = BFRAG + ((size_t)jg * 8 + (p >> 4)) * 64 + (p & 15); u32x4* fr_im = fr_re + 4 * 64;
#pragma unroll
            for (int q = 0; q < 2; ++q) { u32x4 w; w.x = pk2(vr[8 * q + 0], vr[8 * q + 1]); w.y = pk2(vr[8 * q + 2], vr[8 * q + 3]); w.z = pk2(vr[8 * q + 4], vr[8 * q + 5]); w.w = pk2(vr[8 * q + 6], vr[8 * q + 7]); fr_re[16 * q] = w;
                w.x = pk2(vi[8 * q + 0], vi[8 * q + 1]); w.y = pk2(vi[8 * q + 2], vi[8 * q + 3]); w.z = pk2(vi[8 * q + 4], vi[8 * q + 5]); w.w = pk2(vi[8 * q + 6], vi[8 * q + 7]); fr_im[16 * q] = w; }
            const u32x4 z4 = {0u, 0u, 0u, 0u}; fr_re[32] = z4; fr_re[48] = z4; fr_im[32] = z4; fr_im[48] = z4;
        }
    }
    {
        LAS float* scr = (LAS float*)(lds + wave * 16384);
        constexpr int NA = XS_P0A_HI - XS_P0A_LO, NB = XS_P0B_HI - XS_P0B_LO, NC = XS_P0C_HI - XS_P0C_LO;
        for (int it = gw; it < NA + NB + NC; it += ngw) {
            const int idx = it < NA ? XS_P0A_LO + it : (it < NA + NB ? XS_P0B_LO + (it - NA) : XS_P0C_LO + (it - NA - NB));
            xpose_global_item(idx, scr, lane);
        }
    }
}

__device__ __forceinline__ void phase1() {
    PHASE_IDS();
    const int gtid = blockIdx.x * NTHR + tid, gthr = gridDim.x * NTHR;
    const float* modp = (const float*)(ws + WS_MODP); const float* b_ada = in_ptr<3>(); const float* tab = in_ptr<4>(); float* modsl = (float*)(ws + WS_MODSL);
    for (int i = gtid; i < 2 * 24576; i += gthr) {
        const int b = i / 24576, n = i % 24576; float s = b_ada[n];
        for (int ks = 0; ks < 64; ++ks) s += modp[((size_t)ks * 2 + b) * 24576 + n];
#pragma unroll
        for (int l = 0; l < 4; ++l) modsl[((size_t)(l * 2 + b) * 6) * 4096 + n] = s + tab[(size_t)l * 24576 + n];
    }
}
#define LN_ROW_STATS(va, vb, mean, rstd) do { float s_ = 0.f; \
    _Pragma("unroll") for (int i = 0; i < 8; ++i) s_ += ((va[i][0] + va[i][1]) + (va[i][2] + va[i][3])) + ((vb[i][0] + vb[i][1]) + (vb[i][2] + vb[i][3])); \
    mean = wave_sum(s_) * (1.0f / 4096.0f); float s2_ = 0.f; \
    _Pragma("unroll") for (int i = 0; i < 8; ++i) { va[i] = va[i] - mean; vb[i] = vb[i] - mean; \
        s2_ += ((va[i][0] * va[i][0] + va[i][1] * va[i][1]) + (va[i][2] * va[i][2] + va[i][3] * va[i][3])) + ((vb[i][0] * vb[i][0] + vb[i][1] * vb[i][1]) + (vb[i][2] * vb[i][2] + vb[i][3] * vb[i][3])); } \
    rstd = 1.0f / sqrtf(wave_sum(s2_) * (1.0f / 4096.0f) + LN_EPS); } while (0)
#define LN_LOAD_Z(va, vb, xr, yr) do { _Pragma("unroll") for (int i = 0; i < 8; ++i) { \
    const f32x4 xa = __builtin_nontemporal_load((const f32x4*)(xr + 512 * i)), xb = __builtin_nontemporal_load((const f32x4*)(xr + 512 * i + 4)); const u32x4 yw = __builtin_nontemporal_load((const u32x4*)(yr + 512 * i)); \
    va[i][0] = pg8::ALPHA_RES * xa[0] + bf_lo(yw.x); va[i][1] = pg8::ALPHA_RES * xa[1] + bf_hi(yw.x); va[i][2] = pg8::ALPHA_RES * xa[2] + bf_lo(yw.y); va[i][3] = pg8::ALPHA_RES * xa[3] + bf_hi(yw.y); \
    vb[i][0] = pg8::ALPHA_RES * xb[0] + bf_lo(yw.z); vb[i][1] = pg8::ALPHA_RES * xb[1] + bf_hi(yw.z); vb[i][2] = pg8::ALPHA_RES * xb[2] + bf_lo(yw.w); vb[i][3] = pg8::ALPHA_RES * xb[3] + bf_hi(yw.w); } } while (0)
__device__ __forceinline__ void ln_stage_vec(LAS unsigned char* lds, int k, const float* src, float add, int tid) {
    for (int q = tid; q < 1024; q += NTHR) { const int c = 4 * q, i = c >> 9, w = c & 511, ln = w >> 3, h = (w >> 2) & 1;
        const f32x4 v = *(const f32x4*)(src + c) + add;
        *(LAS f32x4*)(lds + k * 16384 + i * 2048 + h * 1024 + ln * 16) = v; }
}
#define LN_VEC(k, i, h) (*(const LAS f32x4*)(lds + (k) * 16384 + (i) * 2048 + (h) * 1024 + lane * 16))
__device__ __forceinline__ void phase_ln1(LAS unsigned char* lds, const float* Xin, const bf16* Y1, const float* g, const float* beta, const float* mods, bf16* H) {
    PHASE_IDS();
    ln_stage_vec(lds, 0, g, 0.f, tid); ln_stage_vec(lds, 1, beta, 0.f, tid);
    ln_stage_vec(lds, 2, mods + (size_t)(0 * 6 + 4) * 4096, 1.0f, tid); ln_stage_vec(lds, 3, mods + (size_t)(0 * 6 + 3) * 4096, 0.f, tid);
    ln_stage_vec(lds, 4, mods + (size_t)(1 * 6 + 4) * 4096, 1.0f, tid); ln_stage_vec(lds, 5, mods + (size_t)(1 * 6 + 3) * 4096, 0.f, tid);
    __syncthreads();
    const int gw = blockIdx.x * NWAVES + wave, ngw = gridDim.x * NWAVES;
    for (int row = gw; row < MROWS; row += ngw) {
        const int b = row >> 12;
        const float* xr = Xin + (size_t)row * 4096 + lane * 8; const bf16* yr = Y1 + (size_t)row * 4096 + lane * 8;
        f32x4 va[8], vb[8]; float mean, rstd;
        LN_LOAD_Z(va, vb, xr, yr);
        LN_ROW_STATS(va, vb, mean, rstd);
#pragma unroll
        for (int i = 0; i < 8; ++i) {
            const f32x4 xna = va[i] * rstd * LN_VEC(0, i, 0) + LN_VEC(1, i, 0), xnb = vb[i] * rstd * LN_VEC(0, i, 1) + LN_VEC(1, i, 1);
            const f32x4 ha = xna * LN_VEC(2 + 2 * b, i, 0) + LN_VEC(3 + 2 * b, i, 0), hb = xnb * LN_VEC(2 + 2 * b, i, 1) + LN_VEC(3 + 2 * b, i, 1);
            u32x4 w; w.x = pk2(ha[0], ha[1]); w.y = pk2(ha[2], ha[3]); w.z = pk2(hb[0], hb[1]); w.w = pk2(hb[2], hb[3]);
            *(u32x4*)(H + (size_t)row * 4096 + lane * 8 + 512 * i) = w;
        }
    }
    __syncthreads();
}
__device__ __forceinline__ void phase_ln2(LAS unsigned char* lds, const float* Xin, const bf16* Y1, const bf16* Y2, const float* g1, const float* beta1, const float* g2, const float* beta2, float* Xout, const float* mods, bf16* H) {
    PHASE_IDS();
    ln_stage_vec(lds, 0, g1, 0.f, tid); ln_stage_vec(lds, 1, beta1, 0.f, tid); ln_stage_vec(lds, 2, g2, 0.f, tid); ln_stage_vec(lds, 3, beta2, 0.f, tid);
    if (H) { ln_stage_vec(lds, 4, mods + (size_t)(0 * 6 + 1) * 4096, 1.0f, tid); ln_stage_vec(lds, 5, mods + (size_t)(0 * 6 + 0) * 4096, 0.f, tid);
             ln_stage_vec(lds, 6, mods + (size_t)(1 * 6 + 1) * 4096, 1.0f, tid); ln_stage_vec(lds, 7, mods + (size_t)(1 * 6 + 0) * 4096, 0.f, tid); }
    __syncthreads();
    const int gw = blockIdx.x * NWAVES + wave, ngw = gridDim.x * NWAVES;
    for (int row = gw; row < MROWS; row += ngw) {
        const int b = row >> 12;
        const float* xr = Xin + (size_t)row * 4096 + lane * 8; const bf16* yr = Y1 + (size_t)row * 4096 + lane * 8; const bf16* y2r = Y2 + (size_t)row * 4096 + lane * 8;
        f32x4 va[8], vb[8]; float mean, rstd;
        LN_LOAD_Z(va, vb, xr, yr);
        u32x4 y2w[8];
#pragma unroll
        for (int i = 0; i < 8; ++i) y2w[i] = __builtin_nontemporal_load((const u32x4*)(y2r + 512 * i));
        LN_ROW_STATS(va, vb, mean, rstd);
#pragma unroll
        for (int i = 0; i < 8; ++i) {
            const f32x4 xna = va[i] * rstd * LN_VEC(0, i, 0) + LN_VEC(1, i, 0), xnb = vb[i] * rstd * LN_VEC(0, i, 1) + LN_VEC(1, i, 1);
            const u32x4 yw = y2w[i];
            va[i][0] = pg8::ALPHA_RES * xna[0] + bf_lo(yw.x); va[i][1] = pg8::ALPHA_RES * xna[1] + bf_hi(yw.x); va[i][2] = pg8::ALPHA_RES * xna[2] + bf_lo(yw.y); va[i][3] = pg8::ALPHA_RES * xna[3] + bf_hi(yw.y);
            vb[i][0] = pg8::ALPHA_RES * xnb[0] + bf_lo(yw.z); vb[i][1] = pg8::ALPHA_RES * xnb[1] + bf_hi(yw.z); vb[i][2] = pg8::ALPHA_RES * xnb[2] + bf_lo(yw.w); vb[i][3] = pg8::ALPHA_RES * xnb[3] + bf_hi(yw.w); }
        LN_ROW_STATS(va, vb, mean, rstd);
        float* xo = Xout + (size_t)row * 4096 + lane * 8;
#pragma unroll
        for (int i = 0; i < 8; ++i) {
            const f32x4 xna = va[i] * rstd * LN_VEC(2, i, 0) + LN_VEC(3, i, 0), xnb = vb[i] * rstd * LN_VEC(2, i, 1) + LN_VEC(3, i, 1);
            __builtin_nontemporal_store(xna, (f32x4*)(xo + 512 * i)); __builtin_nontemporal_store(xnb, (f32x4*)(xo + 512 * i + 4));
            if (H) {
                const f32x4 ha = xna * LN_VEC(4 + 2 * b, i, 0) + LN_VEC(5 + 2 * b, i, 0), hb = xnb * LN_VEC(4 + 2 * b, i, 1) + LN_VEC(5 + 2 * b, i, 1);
                u32x4 w; w.x = pk2(ha[0], ha[1]); w.y = pk2(ha[2], ha[3]); w.z = pk2(hb[0], hb[1]); w.w = pk2(hb[2], hb[3]);
                *(u32x4*)(H + (size_t)row * 4096 + lane * 8 + 512 * i) = w;
            }
        }
    }
    __syncthreads();
}

__device__ __forceinline__ void phase_modulate(LAS unsigned char* lds, const float* x, const float* mods, bf16* H) {
    PHASE_IDS();
    ln_stage_vec(lds, 0, mods + (size_t)(0 * 6 + 1) * 4096, 1.0f, tid); ln_stage_vec(lds, 1, mods + (size_t)(0 * 6 + 0) * 4096, 0.f, tid);
    ln_stage_vec(lds, 2, mods + (size_t)(1 * 6 + 1) * 4096, 1.0f, tid); ln_stage_vec(lds, 3, mods + (size_t)(1 * 6 + 0) * 4096, 0.f, tid);
    __syncthreads();
    const int gw = blockIdx.x * NWAVES + wave, ngw = gridDim.x * NWAVES;
    for (int row = gw; row < MROWS; row += ngw) {
        const int b = row >> 12; const float* xr = x + (size_t)row * 4096 + lane * 8;
        f32x4 xa[8], xb[8];
#pragma unroll
        for (int i = 0; i < 8; ++i) { xa[i] = __builtin_nontemporal_load((const f32x4*)(xr + 512 * i)); xb[i] = __builtin_nontemporal_load((const f32x4*)(xr + 512 * i + 4)); }
#pragma unroll
        for (int i = 0; i < 8; ++i) { const f32x4 ha = xa[i] * LN_VEC(2 * b, i, 0) + LN_VEC(2 * b + 1, i, 0), hb = xb[i] * LN_VEC(2 * b, i, 1) + LN_VEC(2 * b + 1, i, 1);
            u32x4 w; w.x = pk2(ha[0], ha[1]); w.y = pk2(ha[2], ha[3]); w.z = pk2(hb[0], hb[1]); w.w = pk2(hb[2], hb[3]);
            *(u32x4*)(H + (size_t)row * 4096 + lane * 8 + 512 * i) = w; }
    }
    __syncthreads();
}

constexpr int SSM_WLDS = 16384, SSM_ST = 2048, SSM_U = 6400, SSM_USTR = 528;
__device__ __forceinline__ void ssm_load_h(const bf16* H, int b, int k, int g, int lane, u32x4& v0, u32x4& v1) {
    const u32x4* src = (const u32x4*)(H + ((size_t)(b * SEQ + k * TC + lane)) * 4096 + g * 16);
    v0 = src[0]; v1 = src[1];
}
__device__ __forceinline__ void ssm_store_h(LAS unsigned char* hs, int lane, const u32x4& v0, const u32x4& v1) { *(LAS u32x4*)(hs + lane * 32) = v0; *(LAS u32x4*)(hs + lane * 32 + 16) = v1; }
__device__ __forceinline__ void ssm_bproj16(const LAS unsigned char* hs, LAS unsigned char* ut, int tg, const bf16x8 (&bf)[8], int fr, int fq) {
    u32x4 aw = {0u, 0u, 0u, 0u};
    if (fq < 2) aw = *(const LAS u32x4*)(hs + (tg * 16 + fr) * 32 + fq * 16);
    const bf16x8 a = __builtin_bit_cast(bf16x8, aw);
#pragma unroll
    for (int tau = 0; tau < 8; ++tau) { f32x4 acc = {0.f, 0.f, 0.f, 0.f};
        acc = __builtin_amdgcn_mfma_f32_16x16x32_bf16(a, bf[tau], acc, 0, 0, 0);
#pragma unroll
        for (int r = 0; r < 4; ++r) *(LAS float*)(ut + (4 * fq + r) * SSM_USTR + (tau * 16 + fr) * 4) = acc[r]; }
}
__device__ __forceinline__ void ssm_update(const LAS unsigned char* ut, int tt, int lane, float are, float aim, float& sre, float& sim) {
    const float ure = *(const LAS float*)(ut + tt * SSM_USTR + lane * 4), uim = *(const LAS float*)(ut + tt * SSM_USTR + 256 + lane * 4);
    const float nre = are * sre - aim * sim + ure, nim = are * sim + aim * sre + uim;
    sre = nre; sim = nim;
}
__device__ __forceinline__ void phase_ssm_local(int j, LAS unsigned char* lds, int xlo, int xhi, int xlo2, int xn2) {
    PHASE_IDS();
    const bf16* H = (const bf16*)(ws + WS_H); float* E = (float*)(ws + WS_E);
    const float* ABAR = (const float*)(ws + WS_ABAR); const u32x4* BFRAG = (const u32x4*)(ws + WS_BBAR);
    LAS unsigned char* hs = lds + wave * SSM_WLDS; LAS unsigned char* ut = hs + SSM_U;
    const int gw = blockIdx.x * NWAVES + wave, ngw = gridDim.x * NWAVES, fr = lane & 15, fq = lane >> 4;
    const int g = gw & 255, jg = j * 256 + g, bstep = ngw >> 8; constexpr int NBK = 2 * (NCHUNK - 1);
    bf16x8 bf[8];
#pragma unroll
    for (int tau = 0; tau < 8; ++tau) bf[tau] = __builtin_bit_cast(bf16x8, BFRAG[((size_t)jg * 8 + tau) * 64 + lane]);
    const float are = ABAR[(jg * 2 + 0) * 64 + lane], aim = ABAR[(jg * 2 + 1) * 64 + lane];
    u32x4 n0 = {0u, 0u, 0u, 0u}, n1 = {0u, 0u, 0u, 0u};
    int xi = gw, itn = 0; const int xtot = xn2 + (xhi - xlo);
    int bk = (gw < (ngw & ~255)) ? (gw >> 8) : NBK;
    if (bk < NBK) ssm_load_h(H, bk / (NCHUNK - 1), bk % (NCHUNK - 1), g, lane, n0, n1);
    for (; bk < NBK; bk += bstep) {
        const int k = bk % (NCHUNK - 1), b = bk / (NCHUNK - 1);
        ssm_store_h(hs, lane, n0, n1);
        { const int nx = bk + bstep; if (nx < NBK) ssm_load_h(H, nx / (NCHUNK - 1), nx % (NCHUNK - 1), g, lane, n0, n1); }
        float sre = 0.f, sim = 0.f;
        for (int tg = 0; tg < TC / 16; ++tg) {
            ssm_bproj16(hs, ut, tg, bf, fr, fq);
#pragma unroll
            for (int tt = 0; tt < 16; ++tt) ssm_update(ut, tt, lane, are, aim, sre, sim);
        }
        float* e = E + (((size_t)(b * NCHUNK + k) * 256 + g) * 2) * 64 + lane;
        e[0] = sre; e[64] = sim;
        if (xi < xtot) { xpose_global_item(xi < xn2 ? xlo2 + xi : xlo + (xi - xn2), (LAS float*)ut, lane); xi += ngw; }
        if ((itn++ & 3) == 3 && xi < xtot) { xpose_global_item(xi < xn2 ? xlo2 + xi : xlo + (xi - xn2), (LAS float*)ut, lane); xi += ngw; }
    }
    for (; xi < xtot; xi += ngw) xpose_global_item(xi < xn2 ? xlo2 + xi : xlo + (xi - xn2), (LAS float*)ut, lane);
}
__device__ __forceinline__ void phase_ssm_carry(int j) {
    PHASE_IDS();
    const float* E = (const float*)(ws + WS_E); float* SP = (float*)(ws + WS_SP); const float* ABART = (const float*)(ws + WS_ABART);
    const int gtid = blockIdx.x * NTHR + tid, gthr = gridDim.x * NTHR;
    for (int i = gtid; i < 2 * 256 * 64; i += gthr) {
        const int p = i & 63, g = (i >> 6) & 255, b = i >> 14, jg = j * 256 + g;
        const float tr = ABART[(jg * 2 + 0) * 64 + p], ti = ABART[(jg * 2 + 1) * 64 + p];
        const size_t base = (((size_t)(b * NCHUNK) * 256 + g) * 2) * 64 + p, kstr = (size_t)256 * 2 * 64;
        float sre = 0.f, sim = 0.f;
        for (int k0 = 0; k0 < NCHUNK; k0 += 8) {
            float er[8], ei[8];
#pragma unroll
            for (int u = 0; u < 8; ++u) { const bool ok = (k0 + u) < NCHUNK - 1; er[u] = ok ? E[base + (size_t)(k0 + u) * kstr] : 0.f; ei[u] = ok ? E[base + (size_t)(k0 + u) * kstr + 64] : 0.f; }
#pragma unroll
            for (int u = 0; u < 8; ++u) { SP[base + (size_t)(k0 + u) * kstr] = sre; SP[base + (size_t)(k0 + u) * kstr + 64] = sim;
                const float nre = tr * sre - ti * sim + er[u], nim = tr * sim + ti * sre + ei[u]; sre = nre; sim = nim; }
        }
    }
}
__device__ __forceinline__ float gelu_tanh(float y) {
    const float a = 0.7978845608028654f * (y + 0.044715f * y * y * y);
    return y * __builtin_amdgcn_rcpf(1.0f + __builtin_amdgcn_exp2f(-2.0f * 1.44269504089f * a));
}
__device__ __forceinline__ void phase_ssm_scan(int j, LAS unsigned char* lds, int xlo, int xhi, int xlo2, int xn2) {
    PHASE_IDS();
    const bf16* H = (const bf16*)(ws + WS_H); const float* SP = (const float*)(ws + WS_SP); bf16* U = (bf16*)(ws + WS_U);
    const float* ABAR = (const float*)(ws + WS_ABAR); const u32x4* BFRAG = (const u32x4*)(ws + WS_BBAR);
    const float* c_re = in_ptr<19>(); const float* c_im = in_ptr<20>(); const float* dsk = in_ptr<21>();
    LAS unsigned char* hs = lds + wave * SSM_WLDS; LAS unsigned char* st = hs + SSM_ST; LAS unsigned char* ut = hs + SSM_U;
    const int gw = blockIdx.x * NWAVES + wave, ngw = gridDim.x * NWAVES, fr = lane & 15, fq = lane >> 4;
    const int g = gw & 255, jg = j * 256 + g, bstep = ngw >> 8; constexpr int NBK = 2 * NCHUNK;
    bf16x8 bf[8];
#pragma unroll
    for (int tau = 0; tau < 8; ++tau) bf[tau] = __builtin_bit_cast(bf16x8, BFRAG[((size_t)jg * 8 + tau) * 64 + lane]);
    const float are = ABAR[(jg * 2 + 0) * 64 + lane], aim = ABAR[(jg * 2 + 1) * 64 + lane];
    bf16x8 cf[4];
#pragma unroll
    for (int s4 = 0; s4 < 4; ++s4) { const float* src = ((s4 >> 1) ? c_im : c_re) + ((size_t)jg * 16 + fr) * 64 + 32 * (s4 & 1) + 8 * fq; const float sg = (s4 >> 1) ? -1.0f : 1.0f;
        const f32x4 a = *(const f32x4*)src * sg, c4 = *(const f32x4*)(src + 4) * sg;
        u32x4 w; w.x = pk2(a[0], a[1]); w.y = pk2(a[2], a[3]); w.z = pk2(c4[0], c4[1]); w.w = pk2(c4[2], c4[3]);
        cf[s4] = __builtin_bit_cast(bf16x8, w); }
    const f32x4 dv4 = *(const f32x4*)(dsk + j * 4096 + g * 16 + 4 * fq);
    u32x4 n0 = {0u, 0u, 0u, 0u}, n1 = {0u, 0u, 0u, 0u}; float nsre = 0.f, nsim = 0.f;
    int xi = gw, itn = 0; const int xtot = xn2 + (xhi - xlo);
    int bk = (gw < (ngw & ~255)) ? (gw >> 8) : NBK;
    if (bk < NBK) { ssm_load_h(H, bk >> 6, bk & (NCHUNK - 1), g, lane, n0, n1); const float* sp = SP + (((size_t)bk * 256 + g) * 2) * 64 + lane; nsre = sp[0]; nsim = sp[64]; }
    for (; bk < NBK; bk += bstep) {
        const int k = bk & (NCHUNK - 1), b = bk >> 6;
        ssm_store_h(hs, lane, n0, n1);
        float sre = nsre, sim = nsim;
        { const int nx = bk + bstep; if (nx < NBK) { ssm_load_h(H, nx >> 6, nx & (NCHUNK - 1), g, lane, n0, n1); const float* sp = SP + (((size_t)nx * 256 + g) * 2) * 64 + lane; nsre = sp[0]; nsim = sp[64]; } }
        for (int tg = 0; tg < TC / 16; ++tg) {
            ssm_bproj16(hs, ut, tg, bf, fr, fq);
            float ur[16], ui[16];
#pragma unroll
            for (int tt = 0; tt < 16; ++tt) { ur[tt] = *(const LAS float*)(ut + tt * SSM_USTR + lane * 4); ui[tt] = *(const LAS float*)(ut + tt * SSM_USTR + 256 + lane * 4); }
#pragma unroll
            for (int tt = 0; tt < 16; ++tt) {
                { const float nre = are * sre - aim * sim + ur[tt], nim = are * sim + aim * sre + ui[tt]; sre = nre; sim = nim; }
                const unsigned w = pk2(sre, sim);
                *(LAS unsigned short*)(st + tt * 272 + lane * 2) = (unsigned short)(w & 0xffffu);
                *(LAS unsigned short*)(st + tt * 272 + 128 + lane * 2) = (unsigned short)(w >> 16);
            }
            f32x4 acc = {0.f, 0.f, 0.f, 0.f};
#pragma unroll
            for (int s4 = 0; s4 < 4; ++s4) { const bf16x8 a = *(const LAS bf16x8*)(st + fr * 272 + 64 * s4 + 16 * fq);
                acc = __builtin_amdgcn_mfma_f32_16x16x32_bf16(cf[s4], a, acc, 0, 0, 0); }
            const int tok = tg * 16 + fr;
            const u32x2 hw = *(const LAS u32x2*)(hs + tok * 32 + fq * 8);
            const float y0 = acc[0] + dv4[0] * bf_lo(hw.x), y1 = acc[1] + dv4[1] * bf_hi(hw.x), y2 = acc[2] + dv4[2] * bf_lo(hw.y), y3 = acc[3] + dv4[3] * bf_hi(hw.y);
            u32x2 w; w.x = pk2(gelu_tanh(y0), gelu_tanh(y1)); w.y = pk2(gelu_tanh(y2), gelu_tanh(y3));
            *(u32x2*)(U + ((size_t)(b * SEQ + k * TC + tok)) * 4096 + g * 16 + 4 * fq) = w;
        }
        if (xi < xtot) { xpose_global_item(xi < xn2 ? xlo2 + xi : xlo + (xi - xn2), (LAS float*)ut, lane); xi += ngw; }
        if ((itn++ & 3) == 3 && xi < xtot) { xpose_global_item(xi < xn2 ? xlo2 + xi : xlo + (xi - xn2), (LAS float*)ut, lane); xi += ngw; }
    }
    for (; xi < xtot; xi += ngw) xpose_global_item(xi < xn2 ? xlo2 + xi : xlo + (xi - xn2), (LAS float*)ut, lane);
}

typedef float f32x16 __attribute__((ext_vector_type(16)));
constexpr int AT_KSTR = 144, AT_VSTR = 520, AT_K_OFF = 0, AT_V_OFF = 256 * AT_KSTR, AT_TBL_OFF = AT_V_OFF + 64 * AT_VSTR;
static_assert(AT_TBL_OFF + 8 * 512 <= RING_BYTES, "attention LDS");
__device__ __forceinline__ void phase_attn(int j, LAS unsigned char* lds) {
    PHASE_IDS();
    const bf16* QKV = (const bf16*)(ws + WS_QKV); bf16* O = (bf16*)(ws + WS_O);
    const float* sinks = in_ptr<12>() + j * 64; const float* relb = in_ptr<13>();
    const int qc = lane & 31, hh = lane >> 5;
    constexpr float LOG2E = 1.44269504089f;
    LAS float* tbl = (LAS float*)(lds + AT_TBL_OFF + wave * 512);
    for (int unit = blockIdx.x; unit < 512; unit += gridDim.x) {
        const int kvh = unit & 7, n = (unit >> 3) & 31, b = unit >> 8, h = kvh * 8 + wave;
        for (int i = lane; i < 128; i += 64) tbl[i] = relb[kBucket[i] * 64 + h] * LOG2E;
        const float sink2 = sinks[h] * LOG2E;
        const int pos0 = n * 128 - 128;
#pragma unroll
        for (int i = 0; i < 4; ++i) { const int c = tid + 512 * i, key = c >> 3, part = c & 7, pos = pos0 + key;
            u32x4 kv = {0u, 0u, 0u, 0u}, vv = {0u, 0u, 0u, 0u};
            if (pos >= 0) { const bf16* src = QKV + (size_t)(b * SEQ + pos) * NQKV + 4096 + kvh * 64 + part * 8; kv = *(const u32x4*)src; vv = *(const u32x4*)(src + 512); }
            *(LAS u32x4*)(lds + AT_K_OFF + key * AT_KSTR + part * 16) = kv;
            LAS unsigned short* vt = (LAS unsigned short*)(lds + AT_V_OFF + (part * 8) * AT_VSTR + key * 2);
#pragma unroll
            for (int e = 0; e < 4; ++e) { vt[(2 * e) * (AT_VSTR / 2)] = (unsigned short)(vv[e] & 0xffffu); vt[(2 * e + 1) * (AT_VSTR / 2)] = (unsigned short)(vv[e] >> 16); } }
        __syncthreads();
        for (int qb = 0; qb < 4; ++qb) {
            const bf16* qp = QKV + (size_t)(b * SEQ + n * 128 + 32 * qb + qc) * NQKV + h * 64 + 8 * hh;
            bf16x8 qf[4];
#pragma unroll
            for (int ks = 0; ks < 4; ++ks) qf[ks] = *(const bf16x8*)(qp + 16 * ks);
            f32x16 s[5];
#pragma unroll
            for (int jt = 0; jt < 5; ++jt) {
#pragma unroll
                for (int r = 0; r < 16; ++r) s[jt][r] = 0.f;
#pragma unroll
                for (int ks = 0; ks < 4; ++ks) { const bf16x8 kf = *(const LAS bf16x8*)(lds + AT_K_OFF + (32 * (qb + jt) + qc) * AT_KSTR + (16 * ks + 8 * hh) * 2);
                    s[jt] = __builtin_amdgcn_mfma_f32_32x32x16_bf16(kf, qf[ks], s[jt], 0, 0, 0); } }
            float mx = sink2;
#pragma unroll
            for (int jt = 0; jt < 5; ++jt) { const bool tile_dead = (n == 0) && (qb + jt < 4);
#pragma unroll
                for (int r = 0; r < 16; ++r) { const int krow = (r & 3) + 8 * (r >> 2) + 4 * hh, dist = 128 + qc - krow - 32 * jt;
                    bool valid = (jt == 0) ? (krow > qc) : ((jt == 4) ? (krow <= qc) : true); valid = valid && !tile_dead;
                    float t = s[jt][r] * (0.125f * LOG2E) + tbl[dist & 127]; t = valid ? t : -1e30f; s[jt][r] = t; mx = fmaxf(mx, t); } }
            mx = fmaxf(mx, __shfl_xor(mx, 32));
            float sum = 0.f;
#pragma unroll
            for (int jt = 0; jt < 5; ++jt)
#pragma unroll
                for (int r = 0; r < 16; ++r) { const float p = __builtin_amdgcn_exp2f(s[jt][r] - mx); s[jt][r] = p; sum += p; }
            sum += __shfl_xor(sum, 32); sum += __builtin_amdgcn_exp2f(sink2 - mx);
            const float inv = 1.0f / sum;
            f32x16 o[2];
#pragma unroll
            for (int dt = 0; dt < 2; ++dt)
#pragma unroll
                for (int r = 0; r < 16; ++r) o[dt][r] = 0.f;
#pragma unroll
            for (int jt = 0; jt < 5; ++jt)
#pragma unroll
                for (int s2 = 0; s2 < 2; ++s2) { u32x4 pw; pw.x = pk2(s[jt][8 * s2 + 0], s[jt][8 * s2 + 1]); pw.y = pk2(s[jt][8 * s2 + 2], s[jt][8 * s2 + 3]); pw.z = pk2(s[jt][8 * s2 + 4], s[jt][8 * s2 + 5]); pw.w = pk2(s[jt][8 * s2 + 6], s[jt][8 * s2 + 7]);
                    const bf16x8 pf = __builtin_bit_cast(bf16x8, pw);
#pragma unroll
                    for (int dt = 0; dt < 2; ++dt) { const LAS unsigned char* vp = lds + AT_V_OFF + (32 * dt + qc) * AT_VSTR + (32 * (qb + jt) + 16 * s2 + 4 * hh) * 2;
                        const u32x2 v0 = *(const LAS u32x2*)vp, v1 = *(const LAS u32x2*)(vp + 16); u32x4 vw; vw.x = v0.x; vw.y = v0.y; vw.z = v1.x; vw.w = v1.y;
                        o[dt] = __builtin_amdgcn_mfma_f32_32x32x16_bf16(__builtin_bit_cast(bf16x8, vw), pf, o[dt], 0, 0, 0); } }
            bf16* op = O + (size_t)(b * SEQ + n * 128 + 32 * qb + qc) * 4096 + h * 64;
#pragma unroll
            for (int dt = 0; dt < 2; ++dt)
#pragma unroll
                for (int g4 = 0; g4 < 4; ++g4) { u32x2 w; w.x = pk2(o[dt][4 * g4] * inv, o[dt][4 * g4 + 1] * inv); w.y = pk2(o[dt][4 * g4 + 2] * inv, o[dt][4 * g4 + 3] * inv);
                    *(u32x2*)(op + 32 * dt + 8 * g4 + 4 * hh) = w; }
        }
        __syncthreads();
    }
}

struct Args { const float* in[24]; float* out; unsigned char* ws; int ph_lo, ph_hi; };
__global__ void __launch_bounds__(NTHR, 2) fwd_kernel(Args args) {
    extern __shared__ __attribute__((aligned(16))) unsigned char lds_raw[];
    LAS unsigned char* lds = (LAS unsigned char*)lds_raw;
    for (int u = threadIdx.x; u < (LDS_BYTES - LDSCTL_OFF) / 4; u += NTHR) ((LAS unsigned*)(lds + LDSCTL_OFF))[u] = 0u;
    __syncthreads();
#if MK_ONE_LAUNCH
    const XcdBarrier bar = xcd_barrier_post((unsigned*)(ws_ptr() + WS_CTL) + CW_BAR, (volatile LAS unsigned*)(lds + MISC_OFF) + 8);
#define GRID_BAR() xcd_barrier(bar)
#else
#define GRID_BAR() do {} while (0)
#endif
    const int lo = args.ph_lo, hi = args.ph_hi;
#define IN(k) (lo <= (k) && (k) < hi)
#define SEAM() GRID_BAR()
#define WSP(off) (ws_ptr() + (off))
#define MODS_L(l) ((const float*)WSP(WS_MODSL) + (size_t)(l) * 2 * 6 * 4096)
#define XRES(l) ((l) == 0 ? in_ptr<0>() : (const float*)WSP(WS_X))

    if (IN(0)) phase0(lds);
    SEAM();
    if (IN(1)) phase1();
    SEAM();
    if (IN(2)) phase_modulate(lds, in_ptr<0>(), MODS_L(0), (bf16*)WSP(WS_H));
    SEAM();

    for (int l = 0; l < 4; ++l) {
        const int pb = 3 + 8 * l, j = l >> 1;
        if ((l & 1) == 0) {
            if (IN(pb + 0)) phase_ssm_local(j, lds, l ? XS_L2S1_LO : XS_L0S1_LO, l ? XS_L2S1_HI : XS_L0S1_HI, l ? XS_L2S1X_LO : XS_L0S1X_LO, XS_X);
            SEAM();
            if (IN(pb + 1)) phase_ssm_carry(j);
            SEAM();
            if (IN(pb + 2)) phase_ssm_scan(j, lds, l ? XS_L2S3_LO : XS_L0S3_LO, l ? XS_L2S3_HI : XS_L0S3_HI, l ? XS_L2S3X_LO : XS_L0S3X_LO, XS_X);
            SEAM();
            if (IN(pb + 3)) {
                pg8::Gemm g{(const bf16*)WSP(WS_U), (const bf16*)WSP(WS_WGLU + j * SZ_WGLU), MROWS, 8192, 4096}; pg8::StaticOrder S; S.init(MROWS, 8192, gridDim.x, (int)blockIdx.x);
                pg8::EpiGLUY E{(bf16*)WSP(WS_Z), MODS_L(l) + 2 * 4096};
                pg8::gemm_phase<pg8::EpiGLUY, pg8::StaticOrder, true, true, 4096>(lds, g, S, E);
            }
            SEAM();
        } else {
            if (IN(pb + 0)) {
                pg8::Gemm g{(const bf16*)WSP(WS_H), (const bf16*)WSP(WS_WQKV + j * SZ_WQKV), MROWS, NQKV, 4096}; pg8::StaticOrder S; S.init(MROWS, NQKV, gridDim.x, (int)blockIdx.x);
                pg8::EpiQKV E{(bf16*)WSP(WS_QKV), NQKV, in_ptr<10>() + j * NQKV};
                pg8::gemm_phase<pg8::EpiQKV, pg8::StaticOrder, true, true, 4096>(lds, g, S, E);
                host_tail(lds, (MROWS / 256) * (NQKV / 256), l == 1 ? XS_T1Q_LO : XS_T3Q_LO, l == 1 ? XS_T1Q_HI : XS_T3Q_HI);
            }
            SEAM();
            if (IN(pb + 1)) phase_attn(j, lds);
            SEAM();
            if (IN(pb + 2)) {
                pg8::Gemm g{(const bf16*)WSP(WS_O), (const bf16*)WSP(WS_WO + j * SZ_WO), MROWS, 4096, 4096}; pg8::StaticOrder S; S.init(MROWS, 4096, gridDim.x, (int)blockIdx.x);
                pg8::EpiY E{(bf16*)WSP(WS_Z), MODS_L(l) + 2 * 4096};
                pg8::gemm_phase<pg8::EpiY, pg8::StaticOrder, true, true, 4096>(lds, g, S, E);
            }
            SEAM();
        }
        if (IN(pb + 4)) phase_ln1(lds, XRES(l), (const bf16*)WSP(WS_Z), in_ptr<5>() + (size_t)(l * 2 + 0) * 4096, in_ptr<6>() + (size_t)(l * 2 + 0) * 4096, MODS_L(l), (bf16*)WSP(WS_H));
        SEAM();
        if (IN(pb + 5)) {
            pg8::Gemm g{(const bf16*)WSP(WS_H), (const bf16*)WSP(WS_WIN + l * SZ_WIN), MROWS, 2 * DFF, 4096}; pg8::StaticOrder S; S.init(MROWS, 2 * DFF, gridDim.x, (int)blockIdx.x);
            pg8::EpiSwiGLU E{(bf16*)WSP(WS_ACT), DFF};
            pg8::gemm_phase<pg8::EpiSwiGLU, pg8::StaticOrder, true, true, 4096>(lds, g, S, E);
            if (l < 3) host_tail(lds, (MROWS / 256) * (2 * DFF / 256), l == 0 ? XS_T0_LO : (l == 1 ? XS_T1_LO : XS_T2_LO), l == 0 ? XS_T0_HI : (l == 1 ? XS_T1_HI : XS_T2_HI));
        }
        SEAM();
        if (IN(pb + 6)) {
            pg8::Gemm g{(const bf16*)WSP(WS_ACT), (const bf16*)WSP(WS_WDN + l * SZ_WDN), MROWS, 4096, DFF}; pg8::StaticOrder S; S.init(MROWS, 4096, gridDim.x, (int)blockIdx.x);
            pg8::EpiY E{(bf16*)WSP(WS_Z + SZ_H), MODS_L(l) + 5 * 4096};
            pg8::gemm_phase<pg8::EpiY, pg8::StaticOrder, true, true, DFF>(lds, g, S, E);
        }
        SEAM();
        if (IN(pb + 7)) phase_ln2(lds, XRES(l), (const bf16*)WSP(WS_Z), (const bf16*)WSP(WS_Z + SZ_H), in_ptr<5>() + (size_t)(l * 2 + 0) * 4096, in_ptr<6>() + (size_t)(l * 2 + 0) * 4096, in_ptr<5>() + (size_t)(l * 2 + 1) * 4096, in_ptr<6>() + (size_t)(l * 2 + 1) * 4096, (l == 3) ? out_ptr() : (float*)WSP(WS_X), MODS_L(l + 1), (l == 3) ? (bf16*)nullptr : (bf16*)WSP(WS_H));
        if (l < 3) SEAM();
    }
#undef IN
#undef SEAM
#undef GRID_BAR
}

extern "C" void kernel_launch(void* const* d_in, const int* in_sizes, int n_in, void* d_out, int out_size, void* d_ws, size_t ws_size, hipStream_t stream) {
    static int grid = 0;
    if (grid == 0) {
        if (n_in != 24 || out_size != MROWS * DM || ws_size < WS_END) { fprintf(stderr, "kernel_launch: unexpected problem (n_in %d, out %d, ws %zu < %zu)\n", n_in, out_size, ws_size, (size_t)WS_END); grid = -1; return; }
        int dev = 0, cus = 0, per_cu = 0;
        if (hipGetDevice(&dev) != hipSuccess || hipDeviceGetAttribute(&cus, hipDeviceAttributeMultiprocessorCount, dev) != hipSuccess) { grid = -1; return; }
        if (hipFuncSetAttribute((const void*)fwd_kernel, hipFuncAttributeMaxDynamicSharedMemorySize, LDS_BYTES) != hipSuccess) { fprintf(stderr, "kernel_launch: hipFuncSetAttribute failed\n"); grid = -1; return; }
        if (hipOccupancyMaxActiveBlocksPerMultiprocessor(&per_cu, (const void*)fwd_kernel, NTHR, LDS_BYTES) != hipSuccess || per_cu < 1) fprintf(stderr, "kernel_launch: occupancy query says %d\n", per_cu);
        (void)hipGetLastError();
        grid = cus;
    }
    if (grid < 0) return;
    (void)hipMemsetAsync((char*)d_ws + WS_CTL, 0, CTL_BYTES, stream);
    Args a{};
    for (int i = 0; i < 24; ++i) a.in[i] = (const float*)d_in[i];
    a.out = (float*)d_out; a.ws = (unsigned char*)d_ws;
#if MK_ONE_LAUNCH
    a.ph_lo = 0; a.ph_hi = N_PHASES;
    hipLaunchKernelGGL(fwd_kernel, dim3(grid), dim3(NTHR), LDS_BYTES, stream, a);
#else
    for (int ph = 0; ph < N_PHASES; ++ph) {
        if (ph >= 3 && ((ph - 3) & 7) == 3 && (((ph - 3) >> 3) & 1)) continue;
        a.ph_lo = ph; a.ph_hi = ph + 1;
        hipLaunchKernelGGL(fwd_kernel, dim3(grid), dim3(NTHR), LDS_BYTES, stream, a);
    }
#endif
}
```

```cpp
#include <hip/hip_runtime.h>
#include <cstdio>
#include <cstdint>
namespace pg8 {
#define PG8_LAS __attribute__((address_space(3)))
typedef unsigned short bf16_t;
typedef short bf16x8 __attribute__((ext_vector_type(8)));
typedef float f32x4 __attribute__((ext_vector_type(4)));
typedef unsigned u32x4 __attribute__((ext_vector_type(4)));
constexpr int BM = 256, BK = 64, HALF = 128, HTB = HALF * BK * 2  , STAGE_BYTES = 8 * HTB, NXCD = 8, WGM = 8;

__host__ __device__ __forceinline__ int lds_byte(int r, int c) { const int st = (r >> 4) * 2 + (c >> 5), rr = r & 15, cc = c & 31, ob = rr * 64 + cc * 2; return st * 1024 + (ob ^ (((ob >> 9) & 1) << 5)); }
__host__ __device__ __forceinline__ void stage_rc(int b, int& R, int& C) { const int st = b / 1024, sb = b % 1024, swz = sb ^ (((sb >> 9) & 1) << 5); R = (st >> 1) * 16 + swz / 64; C = (st & 1) * 32 + (swz % 64) / 2; }
__host__ __device__ __forceinline__ int perm32(int rho) { const int n = rho >> 4, i = rho & 15; return 8 * (i >> 2) + 4 * n + (i & 3); }

struct Unit { int pm, pn; };
struct Gemm { const bf16_t* A; const bf16_t* Bt; int M, N, K; };

struct StaticOrder {
    int nM, nN, nwg, G, c;
    __host__ __device__ void init(int M, int N, int G_, int c_) { nM = M / BM; nN = N / BM; nwg = nM * nN; G = G_; c = c_; }
    __host__ __device__ bool next(int i, Unit& u) const {
        const long L = (long)i * G + c; if (L >= nwg) return false;
        int wgid = (int)L; { const int q = nwg / NXCD, r = nwg % NXCD, xcd = wgid % NXCD, off = wgid / NXCD; wgid = (xcd < r ? xcd * (q + 1) : r * (q + 1) + (xcd - r) * q) + off; }
        const int nig = WGM * nN, gid = wgid / nig, fm = gid * WGM, gsz = (nM - fm) < WGM ? (nM - fm) : WGM;
        u.pm = fm + ((wgid % nig) % gsz); u.pn = (wgid % nig) / gsz; return true;
    }
    __device__ __forceinline__ void a_ready(const Unit&) const {}
    __device__ __forceinline__ void done(const Unit&) const {}
};
__device__ __forceinline__ unsigned cvt_pk_bf16(float lo, float hi) { unsigned r; asm volatile("v_cvt_pk_bf16_f32 %0, %1, %2" : "=v"(r) : "v"(lo), "v"(hi)); return r; }
typedef float f32x2 __attribute__((ext_vector_type(2)));
__device__ __forceinline__ float fast_sigmoid(float v) { return __builtin_amdgcn_rcpf(1.0f + __builtin_amdgcn_exp2f(-1.44269504089f * v)); }
constexpr float ALPHA_RES = 1.681792830507429f;

struct EpiQKV {
    static constexpr bool PERM = true, AFTER_DRAIN = false;
    bf16_t* O; int ldc; const float* bias;
    __device__ __forceinline__ void operator()(const f32x4 (&acc)[2][2][4][2], const Unit& u, int wr, int wc, int fr, int fq) const {
        const int row0 = u.pm * BM + wr * 64 + fr, col0 = u.pn * BM + wc * 32 + 8 * fq;
        f32x4 bv[2][2];
#pragma unroll
        for (int bj = 0; bj < 2; ++bj)
#pragma unroll
            for (int n = 0; n < 2; ++n) bv[bj][n] = *(const f32x4*)(bias + col0 + bj * HALF + 4 * n);
#pragma unroll
        for (int ai = 0; ai < 2; ++ai)
#pragma unroll
            for (int m = 0; m < 4; ++m) { bf16_t* rowp = O + (size_t)(row0 + ai * HALF + m * 16) * ldc + col0;
#pragma unroll
                for (int bj = 0; bj < 2; ++bj) { const f32x4 v0 = acc[ai][bj][m][0] + bv[bj][0], v1 = acc[ai][bj][m][1] + bv[bj][1];
                    u32x4 w; w.x = cvt_pk_bf16(v0[0], v0[1]); w.y = cvt_pk_bf16(v0[2], v0[3]); w.z = cvt_pk_bf16(v1[0], v1[1]); w.w = cvt_pk_bf16(v1[2], v1[3]);
                    *(u32x4*)(rowp + bj * HALF) = w; } }
    }
};
struct EpiSwiGLU {
    static constexpr bool PERM = true, AFTER_DRAIN = false;
    bf16_t* O; int ldc;
    __device__ __forceinline__ void operator()(const f32x4 (&acc)[2][2][4][2], const Unit& u, int wr, int wc, int fr, int fq) const {
        const int row0 = u.pm * BM + wr * 64 + fr, col0 = u.pn * HALF + wc * 32 + 8 * fq;
#pragma unroll
        for (int ai = 0; ai < 2; ++ai)
#pragma unroll
            for (int m = 0; m < 4; ++m) { bf16_t* rowp = O + (size_t)(row0 + ai * HALF + m * 16) * ldc + col0;
                float t[8], gu[8];
#pragma unroll
                for (int i = 0; i < 8; ++i) { const float g = acc[ai][0][m][i >> 2][i & 3]; t[i] = -1.44269504089f * g; gu[i] = g * acc[ai][1][m][i >> 2][i & 3]; }
#pragma unroll
                for (int i = 0; i < 8; ++i) t[i] = __builtin_amdgcn_exp2f(t[i]);
#pragma unroll
                for (int i = 0; i < 8; ++i) t[i] = t[i] + 1.0f;
#pragma unroll
                for (int i = 0; i < 8; ++i) t[i] = __builtin_amdgcn_rcpf(t[i]);
#pragma unroll
                for (int i = 0; i < 8; ++i) t[i] = t[i] * gu[i];
                asm volatile("" : "+v"(t[0]), "+v"(t[1]), "+v"(t[2]), "+v"(t[3]), "+v"(t[4]), "+v"(t[5]), "+v"(t[6]), "+v"(t[7]));
                u32x4 w; w.x = cvt_pk_bf16(t[0], t[1]); w.y = cvt_pk_bf16(t[2], t[3]); w.z = cvt_pk_bf16(t[4], t[5]); w.w = cvt_pk_bf16(t[6], t[7]);
                *(u32x4*)rowp = w; }
    }
};
struct EpiGLUY {
    static constexpr bool PERM = true, AFTER_DRAIN = false;
    bf16_t* Y; const float* gmod;
    __device__ __forceinline__ void operator()(const f32x4 (&acc)[2][2][4][2], const Unit& u, int wr, int wc, int fr, int fq) const {
        const int row0 = u.pm * BM + wr * 64 + fr, col0 = u.pn * HALF + wc * 32 + 8 * fq, b = u.pm >> 4;
        f32x4 gm[2];
#pragma unroll
        for (int n = 0; n < 2; ++n) gm[n] = *(const f32x4*)(gmod + (size_t)b * 6 * 4096 + col0 + 4 * n) + 1.0f;
#pragma unroll
        for (int ai = 0; ai < 2; ++ai)
#pragma unroll
            for (int m = 0; m < 4; ++m) { float r[8], t[8];
#pragma unroll
                for (int i = 0; i < 8; ++i) { t[i] = -1.44269504089f * acc[ai][1][m][i >> 2][i & 3]; r[i] = gm[i >> 2][i & 3] * acc[ai][0][m][i >> 2][i & 3]; }
#pragma unroll
                for (int i = 0; i < 8; ++i) t[i] = __builtin_amdgcn_exp2f(t[i]);
#pragma unroll
                for (int i = 0; i < 8; ++i) t[i] = t[i] + 1.0f;
#pragma unroll
                for (int i = 0; i < 8; ++i) t[i] = __builtin_amdgcn_rcpf(t[i]);
#pragma unroll
                for (int i = 0; i < 8; ++i) r[i] = r[i] * t[i];
                asm volatile("" : "+v"(r[0]), "+v"(r[1]), "+v"(r[2]), "+v"(r[3]), "+v"(r[4]), "+v"(r[5]), "+v"(r[6]), "+v"(r[7]));
                u32x4 w; w.x = cvt_pk_bf16(r[0], r[1]); w.y = cvt_pk_bf16(r[2], r[3]); w.z = cvt_pk_bf16(r[4], r[5]); w.w = cvt_pk_bf16(r[6], r[7]);
                *(u32x4*)(Y + (size_t)(row0 + ai * HALF + m * 16) * 4096 + col0) = w; }
    }
};
struct EpiY {
    static constexpr bool PERM = true, AFTER_DRAIN = false;
    bf16_t* Y; const float* gmod;
    __device__ __forceinline__ void operator()(const f32x4 (&acc)[2][2][4][2], const Unit& u, int wr, int wc, int fr, int fq) const {
        const int row0 = u.pm * BM + wr * 64 + fr, col0 = u.pn * BM + wc * 32 + 8 * fq, b = u.pm >> 4;
        f32x4 gm[2][2];
#pragma unroll
        for (int bj = 0; bj < 2; ++bj)
#pragma unroll
            for (int n = 0; n < 2; ++n) gm[bj][n] = *(const f32x4*)(gmod + (size_t)b * 6 * 4096 + col0 + bj * HALF + 4 * n) + 1.0f;
#pragma unroll
        for (int ai = 0; ai < 2; ++ai)
#pragma unroll
            for (int m = 0; m < 4; ++m) { bf16_t* rowp = Y + (size_t)(row0 + ai * HALF + m * 16) * 4096 + col0;
#pragma unroll
                for (int bj = 0; bj < 2; ++bj) { const f32x4 v0 = acc[ai][bj][m][0] * gm[bj][0], v1 = acc[ai][bj][m][1] * gm[bj][1];
                    u32x4 w; w.x = cvt_pk_bf16(v0[0], v0[1]); w.y = cvt_pk_bf16(v0[2], v0[3]); w.z = cvt_pk_bf16(v1[0], v1[1]); w.w = cvt_pk_bf16(v1[2], v1[3]);
                    *(u32x4*)(rowp + bj * HALF) = w; } }
    }
};
template <class Epi, class Sched, bool ALIGN_EPI, bool SP2, int KD>
__device__ __forceinline__ void gemm_phase(PG8_LAS unsigned char* lds, const Gemm g, const Sched& S, const Epi& E) {
    int tid_ = threadIdx.x; asm volatile("" : "+v"(tid_));
    const int tid = tid_, wid = __builtin_amdgcn_readfirstlane(tid >> 6), lane = tid & 63, wr = wid >> 2, wc = wid & 3, fr = lane & 15, fq = lane >> 4;
    constexpr int K = KD, nt = K / BK; static_assert(KD % 128 == 0 && KD >= 256, "K");
    unsigned voffA[2], voffB[2];
#pragma unroll
    for (int i = 0; i < 2; ++i) { int R, C; stage_rc(tid * 16 + i * 8192, R, C); const int Rb = Epi::PERM ? ((R & ~31) + perm32(R & 31)) : R;
        voffA[i] = (unsigned)(R * K + C) * 2u; voffB[i] = (unsigned)(Rb * K + C) * 2u; }
    const size_t kstep = (size_t)(BK * 2);
    const size_t hstep = (size_t)HALF * K * 2;
    const size_t tstep = 2 * hstep;
    const unsigned ldsw = (unsigned)wid * 1024u;
    const int aoff = lds_byte(wr * 64 + fr, fq * 8), boff = lds_byte(wc * 32 + fr, fq * 8);
#define PG8_SA(b, h) (((b) * 2 + (h)) * HTB)
#define PG8_SB(b, h) ((4 + (b) * 2 + (h)) * HTB)
#define PG8_STAGE(bufoff, gbase, voff) do { _Pragma("unroll") for (int _i = 0; _i < 2; ++_i) \
        __builtin_amdgcn_global_load_lds((const unsigned*)((const char*)(gbase) + (voff)[_i]), (PG8_LAS unsigned*)(lds + (bufoff) + ldsw + _i * 8192), 16, 0, 0); } while (0)
#define PG8_LDA(dst, b, h) do { _Pragma("unroll") for (int m = 0; m < 4; ++m) _Pragma("unroll") for (int k = 0; k < 2; ++k) dst[m][k] = *(const PG8_LAS bf16x8*)(lds + PG8_SA(b, h) + aoff + m * 2048 + k * 1024); } while (0)
#define PG8_LDB(dst, b, h) do { _Pragma("unroll") for (int n = 0; n < 2; ++n) _Pragma("unroll") for (int k = 0; k < 2; ++k) dst[n][k] = *(const PG8_LAS bf16x8*)(lds + PG8_SB(b, h) + boff + n * 2048 + k * 1024); } while (0)
#define PG8_MMA(ai, bj, At, Bt) do { __builtin_amdgcn_s_setprio(1); _Pragma("unroll") for (int m = 0; m < 4; ++m) _Pragma("unroll") for (int n = 0; n < 2; ++n) _Pragma("unroll") for (int k = 0; k < 2; ++k) \
        acc[ai][bj][m][n] = __builtin_amdgcn_mfma_f32_16x16x32_bf16(Bt[n][k], At[m][k], acc[ai][bj][m][n], 0, 0, 0); __builtin_amdgcn_s_setprio(0); } while (0)
#define PG8_WAIT_V(n) asm volatile("s_waitcnt vmcnt(" #n ")" ::: "memory")
#define PG8_WAIT_L(n) asm volatile("s_waitcnt lgkmcnt(" #n ")" ::: "memory")
#define PG8_BAR __builtin_amdgcn_s_barrier()
#define PG8_SCHED __builtin_amdgcn_sched_barrier(0)
    Unit cur, nxt; int ui = 0;
    if (!S.next(0, cur)) return;
    f32x4 acc[2][2][4][2];
#pragma unroll
    for (int a = 0; a < 2; ++a)
#pragma unroll
        for (int b = 0; b < 2; ++b)
#pragma unroll
            for (int m = 0; m < 4; ++m)
#pragma unroll
                for (int n = 0; n < 2; ++n) acc[a][b][m][n] = (f32x4){0.f, 0.f, 0.f, 0.f};
    bf16x8 At[4][2], B0[2][2], B1[2][2];
    const char* cA = (const char*)g.A + (size_t)cur.pm * tstep; const char* cB = (const char*)g.Bt + (size_t)cur.pn * tstep;
    S.a_ready(cur);
    if constexpr (SP2) {
        PG8_STAGE(PG8_SB(0, 0), cB, voffB); PG8_STAGE(PG8_SB(0, 1), cB + hstep, voffB); PG8_STAGE(PG8_SA(0, 0), cA, voffA); PG8_STAGE(PG8_SA(0, 1), cA + hstep, voffA);
        if (wr == 1) PG8_BAR;
        PG8_WAIT_V(2); PG8_BAR;
        PG8_STAGE(PG8_SB(1, 0), cB + kstep, voffB); PG8_STAGE(PG8_SA(1, 0), cA + kstep, voffA); PG8_STAGE(PG8_SB(1, 1), cB + hstep + kstep, voffB);
        PG8_WAIT_V(6); PG8_BAR;
    } else {
        PG8_STAGE(PG8_SB(0, 0), cB, voffB); PG8_STAGE(PG8_SA(0, 0), cA, voffA); PG8_STAGE(PG8_SB(0, 1), cB + hstep, voffB); PG8_STAGE(PG8_SA(0, 1), cA + hstep, voffA);
        if (wr == 1) PG8_BAR;
        PG8_WAIT_V(4); PG8_BAR;
        PG8_STAGE(PG8_SB(1, 0), cB + kstep, voffB); PG8_STAGE(PG8_SA(1, 0), cA + kstep, voffA); PG8_STAGE(PG8_SB(1, 1), cB + hstep + kstep, voffB);
        PG8_WAIT_V(6); PG8_BAR;
    }
    for (;;) {
        const bool has_next = S.next(ui + 1, nxt);
        const char* nA = has_next ? (const char*)g.A + (size_t)nxt.pm * tstep : cA; const char* nB = has_next ? (const char*)g.Bt + (size_t)nxt.pn * tstep : cB;
        for (int t = 0; t < nt; t += 2) {
            const bool last = (t == nt - 2);
            const char* a1 = cA + (size_t)(t + 1) * kstep;
            const char* a2 = last ? nA : cA + (size_t)(t + 2) * kstep; const char* b2 = last ? nB : cB + (size_t)(t + 2) * kstep;
            const char* a3 = a2 + kstep; const char* b3 = b2 + kstep;
            if (last && has_next) S.a_ready(nxt);
            if constexpr (SP2) {
            PG8_LDB(B0, 0, 0); PG8_LDB(B1, 0, 1); PG8_SCHED; PG8_LDA(At, 0, 0); PG8_STAGE(PG8_SA(1, 1), a1 + hstep, voffA);
            PG8_WAIT_V(8); PG8_WAIT_L(0); PG8_BAR; PG8_MMA(0, 0, At, B0); PG8_MMA(0, 1, At, B1); PG8_BAR; PG8_SCHED;
            PG8_LDA(At, 0, 1); PG8_STAGE(PG8_SB(0, 0), b2, voffB); PG8_STAGE(PG8_SB(0, 1), b2 + hstep, voffB); PG8_STAGE(PG8_SA(0, 0), a2, voffA);
            PG8_WAIT_V(8); PG8_WAIT_L(0); PG8_BAR; PG8_MMA(1, 0, At, B0); PG8_MMA(1, 1, At, B1); PG8_BAR; PG8_SCHED;
            PG8_LDB(B0, 1, 0); PG8_LDB(B1, 1, 1); PG8_SCHED; PG8_LDA(At, 1, 0); PG8_STAGE(PG8_SA(0, 1), a2 + hstep, voffA);
            PG8_WAIT_V(8); PG8_WAIT_L(0); PG8_BAR; PG8_MMA(0, 0, At, B0); PG8_MMA(0, 1, At, B1); PG8_BAR; PG8_SCHED;
            PG8_LDA(At, 1, 1); PG8_STAGE(PG8_SB(1, 0), b3, voffB); PG8_STAGE(PG8_SB(1, 1), b3 + hstep, voffB); PG8_STAGE(PG8_SA(1, 0), a3, voffA);
            PG8_WAIT_V(8); PG8_WAIT_L(0); PG8_BAR; PG8_MMA(1, 0, At, B0); PG8_MMA(1, 1, At, B1); PG8_BAR; PG8_SCHED;
            } else {
            PG8_LDB(B0, 0, 0); PG8_SCHED; PG8_LDA(At, 0, 0); PG8_STAGE(PG8_SA(1, 1), a1 + hstep, voffA);
            PG8_WAIT_L(8); PG8_BAR; PG8_WAIT_L(0); PG8_MMA(0, 0, At, B0); PG8_BAR; PG8_SCHED;
            PG8_LDB(B1, 0, 1); PG8_STAGE(PG8_SB(0, 0), b2, voffB);
            PG8_BAR; PG8_WAIT_L(0); PG8_MMA(0, 1, At, B1); PG8_BAR;
            PG8_LDA(At, 0, 1); PG8_STAGE(PG8_SA(0, 0), a2, voffA);
            PG8_BAR; PG8_WAIT_L(0); PG8_MMA(1, 0, At, B0); PG8_BAR; PG8_SCHED;
            PG8_STAGE(PG8_SB(0, 1), b2 + hstep, voffB);
            PG8_WAIT_V(6); PG8_BAR; PG8_MMA(1, 1, At, B1); PG8_BAR;
            PG8_LDB(B0, 1, 0); PG8_SCHED; PG8_LDA(At, 1, 0); PG8_STAGE(PG8_SA(0, 1), a2 + hstep, voffA);
            PG8_WAIT_L(8); PG8_BAR; PG8_WAIT_L(0); PG8_MMA(0, 0, At, B0); PG8_BAR; PG8_SCHED;
            PG8_LDB(B1, 1, 1); PG8_STAGE(PG8_SB(1, 0), b3, voffB);
            PG8_BAR; PG8_WAIT_L(0); PG8_MMA(0, 1, At, B1); PG8_BAR;
            PG8_LDA(At, 1, 1); PG8_STAGE(PG8_SA(1, 0), a3, voffA);
            PG8_BAR; PG8_WAIT_L(0); PG8_MMA(1, 0, At, B0); PG8_BAR; PG8_SCHED;
            PG8_STAGE(PG8_SB(1, 1), b3 + hstep, voffB);
            PG8_WAIT_V(6); PG8_BAR; PG8_MMA(1, 1, At, B1); PG8_BAR;
            }
        }
        if constexpr (ALIGN_EPI) { if (wr == 0) PG8_BAR; }
        if constexpr (!Epi::AFTER_DRAIN) { E(acc, cur, wr, wc, fr, fq); S.done(cur); }
        if (!has_next) break;
#pragma unroll
        for (int a = 0; a < 2; ++a)
#pragma unroll
            for (int b = 0; b < 2; ++b)
#pragma unroll
                for (int m = 0; m < 4; ++m)
#pragma unroll
                    for (int n = 0; n < 2; ++n) acc[a][b][m][n] = (f32x4){0.f, 0.f, 0.f, 0.f};
        cur = nxt; cA = nA; cB = nB; ++ui;
        if constexpr (ALIGN_EPI) { if (wr == 1) PG8_BAR; }
    }
    PG8_WAIT_V(0);
    if constexpr (!ALIGN_EPI) { if (wr == 0) PG8_BAR; }
    PG8_BAR;
    if constexpr (Epi::AFTER_DRAIN) { E.fused(acc, cur, wr, wc, fr, fq, lds, wid, lane); S.done(cur); }
#undef PG8_SA
#undef PG8_SB
#undef PG8_STAGE
#undef PG8_LDA
#undef PG8_LDB
#undef PG8_MMA
#undef PG8_WAIT_V
#undef PG8_WAIT_L
#undef PG8_BAR
#undef PG8_SCHED
}
}

#ifndef MK_ONE_LAUNCH
#define MK_ONE_LAUNCH 1
#endif
constexpr int NWAVES = 8, NTHR = 512;
constexpr int DM = 4096, SEQ = 4096, MROWS = 8192, DFF = 11008, NQKV = 5120;
constexpr int TC = 64, NCHUNK = 64;
constexpr float LN_EPS = 1e-5f;
constexpr int N_PHASES = 3 + 8 * 4;

#define GAS __attribute__((address_space(1)))
#define LAS __attribute__((address_space(3)))
typedef unsigned short bf16;
typedef float f32x4 __attribute__((ext_vector_type(4)));
typedef unsigned u32x4 __attribute__((ext_vector_type(4)));
typedef unsigned u32x2 __attribute__((ext_vector_type(2)));
typedef short bf16x8 __attribute__((ext_vector_type(8)));

constexpr size_t MiB = 1u << 20;
constexpr size_t alignup(size_t x) { return (x + MiB - 1) & ~(MiB - 1); }
constexpr size_t WS_CTL = 0, CTL_BYTES = 1 * MiB;
constexpr size_t WS_MODP = 1 * MiB,                    SZ_MODP = 64ull * 2 * 24576 * 4;
constexpr size_t WS_MODSL = alignup(WS_MODP + SZ_MODP), SZ_MODSL = 4ull * 2 * 6 * 4096 * 4;
constexpr size_t WS_ABAR = alignup(WS_MODSL + SZ_MODSL), SZ_ABAR = 2ull * 256 * 2 * 64 * 4;
constexpr size_t WS_ABART = alignup(WS_ABAR + SZ_ABAR);
constexpr size_t WS_BBAR = alignup(WS_ABART + SZ_ABAR), SZ_BBAR = 2ull * 256 * 8 * 64 * 16;
constexpr size_t WS_E = alignup(WS_BBAR + SZ_BBAR),     SZ_E = 2ull * 64 * 256 * 2 * 64 * 4;
constexpr size_t SZ_WIN = 22016ull * 4096 * 2, SZ_WDN = 4096ull * 11008 * 2, SZ_WGLU = 8192ull * 4096 * 2, SZ_WQKV = 5120ull * 4096 * 2, SZ_WO = 4096ull * 4096 * 2;
constexpr size_t WS_SP = alignup(WS_E + SZ_E);
constexpr size_t WS_WIN = alignup(WS_SP + SZ_E);
constexpr size_t WS_WDN = alignup(WS_WIN + 4 * SZ_WIN);
constexpr size_t WS_WGLU = alignup(WS_WDN + 4 * SZ_WDN);
constexpr size_t WS_WQKV = alignup(WS_WGLU + 2 * SZ_WGLU);
constexpr size_t WS_WO = alignup(WS_WQKV + 2 * SZ_WQKV);
constexpr size_t WS_H = alignup(WS_WO + 2 * SZ_WO),    SZ_H = 8192ull * 4096 * 2;
constexpr size_t WS_ACT = alignup(WS_H + SZ_H),        SZ_ACT = 8192ull * 11008 * 2;
constexpr size_t WS_Z = alignup(WS_ACT + SZ_ACT),      SZ_Z = 8192ull * 4096 * 4;
constexpr size_t WS_X = alignup(WS_Z + SZ_Z);
constexpr size_t WS_X2 = alignup(WS_X + SZ_Z);
constexpr size_t WS_QKV = alignup(WS_X2 + SZ_Z),        SZ_QKV = 8192ull * 5120 * 2;
constexpr size_t WS_O = alignup(WS_QKV + SZ_QKV);
constexpr size_t WS_U = alignup(WS_O + SZ_H);
constexpr size_t WS_END = alignup(WS_U + SZ_H);
constexpr int CW_BAR = 4096;

constexpr int RING_BYTES = 131072, LDSCTL_OFF = RING_BYTES, MISC_OFF = LDSCTL_OFF + 320, LDS_BYTES = 147456;

__device__ __forceinline__ unsigned pk2(float lo, float hi) { return pg8::cvt_pk_bf16(lo, hi); }
__device__ __forceinline__ float bf_lo(unsigned w) { return __uint_as_float(w << 16); }
__device__ __forceinline__ float bf_hi(unsigned w) { return __uint_as_float(w & 0xffff0000u); }
template <int CTRL> __device__ __forceinline__ float dpp_mov(float x) { return __builtin_bit_cast(float, __builtin_amdgcn_mov_dpp(__builtin_bit_cast(int, x), CTRL, 0xf, 0xf, true)); }
__device__ __forceinline__ float wave_sum(float v) {
    v += dpp_mov<0xB1>(v);
    v += dpp_mov<0x4E>(v);
    v += dpp_mov<0x124>(v);
    v += dpp_mov<0x128>(v);
    const auto s = __builtin_amdgcn_permlane16_swap(__float_as_uint(v), __float_as_uint(v), false, false);
    v = __uint_as_float(s[0]) + __uint_as_float(s[1]);
    const auto t = __builtin_amdgcn_permlane32_swap(__float_as_uint(v), __float_as_uint(v), false, false);
    return __uint_as_float(t[0]) + __uint_as_float(t[1]);
}

#define XB_TMO      128
#define XB_XCNT(j)  (256  + 64 * (j))
#define XB_XSUB(j)  (1280 + 64 * (j))
#define XB_XGEN(j)  (2304 + 64 * (j))
#define XB_TOP      3328
#define XB_TOPGEN   3392
#define XCD_BAR_WORDS 3456
#define XB_SPIN_CAP (1u << 20)

__device__ __forceinline__ unsigned xb_ld(unsigned* p)              { return __hip_atomic_load(p, __ATOMIC_RELAXED, __HIP_MEMORY_SCOPE_AGENT); }
__device__ __forceinline__ unsigned xb_add(unsigned* p, unsigned v) { return __hip_atomic_fetch_add(p, v, __ATOMIC_RELAXED, __HIP_MEMORY_SCOPE_AGENT); }
__device__ __forceinline__ unsigned xb_xcc_id() { return (unsigned)__builtin_amdgcn_s_getreg((3 << 11) | 20) & 0xFu; }
#define XB_SPIN(cond, bar) do { unsigned _sp = 0; while (cond) { __builtin_amdgcn_s_sleep(1); \
    if ((++_sp & 255u) == 0u) { if (xb_ld(&(bar)[XB_TMO])) break; if (_sp > XB_SPIN_CAP) { atomicAdd(&(bar)[XB_TMO], 1u); break; } } } } while (0)

struct XcdBarrier { unsigned* bar; unsigned x; volatile LAS unsigned* st; };
__device__ __forceinline__ XcdBarrier xcd_barrier_post(unsigned* bar, volatile LAS unsigned* st) {
    XcdBarrier b; b.bar = bar; b.x = xb_xcc_id(); b.st = st;
    if (threadIdx.x == 0) (void)xb_add(&bar[XB_XCNT(b.x)], 1u);
    return b;
}
__device__ __forceinline__ void xcd_barrier_complete(unsigned* bar, unsigned x, unsigned& nloc, unsigned& nx) {
    const unsigned G = gridDim.x * gridDim.y * gridDim.z;
    unsigned sum, cnt, mine, sp = 0u;
    for (;;) {
        sum = 0u; cnt = 0u; mine = 0u;
#pragma unroll
        for (unsigned j = 0; j < 16; ++j) { const unsigned c = xb_ld(&bar[XB_XCNT(j)]); sum += c; cnt += (c > 0u) ? 1u : 0u; mine = (j == x) ? c : mine; }
        if (sum == G) break;
        __builtin_amdgcn_s_sleep(1);
        if ((++sp & 255u) == 0u) { if (xb_ld(&bar[XB_TMO])) break; if (sp > XB_SPIN_CAP) { atomicAdd(&bar[XB_TMO], 1u); break; } }
    }
    nloc = mine > 0u ? mine : 1u; nx = cnt > 0u ? cnt : 1u;
}
__device__ __forceinline__ void xcd_barrier(const XcdBarrier& b) {
    asm volatile("s_waitcnt vmcnt(0)" ::: "memory");
    __syncthreads();
    if (threadIdx.x == 0) {
        unsigned* bar = b.bar;
        __builtin_amdgcn_s_waitcnt(0);
        unsigned nloc = b.st[0], nx = b.st[1];
        if (nloc == 0u) { xcd_barrier_complete(bar, b.x, nloc, nx); b.st[0] = nloc; b.st[1] = nx; }
        const unsigned old = xb_add(&bar[XB_XSUB(b.x)], 1u);
        const unsigned gen = old / nloc;
        if (old + 1u == (gen + 1u) * nloc) {
            __builtin_amdgcn_fence(__ATOMIC_RELEASE, "agent");
            asm volatile("s_waitcnt vmcnt(0)" ::: "memory");
            const unsigned og = xb_add(&bar[XB_TOP], 1u);
            const unsigned tg = og / nx;
            if (og + 1u == (tg + 1u) * nx) xb_add(&bar[XB_TOPGEN], 1u);
            else XB_SPIN(xb_ld(&bar[XB_TOPGEN]) == tg, bar);
            __builtin_amdgcn_fence(__ATOMIC_ACQUIRE, "agent");
            xb_add(&bar[XB_XGEN(b.x)], 1u);
            asm volatile("s_waitcnt vmcnt(0)" ::: "memory");
        } else {
            XB_SPIN(xb_ld(&bar[XB_XGEN(b.x)]) == gen, bar);
            __builtin_amdgcn_fence(__ATOMIC_ACQUIRE, "agent");
            asm volatile("s_waitcnt vmcnt(0)" ::: "memory");
        }
    }
    __syncthreads();
}

__device__ const unsigned char kBucket[128] = {0, 1, 2, 3, 4, 5, 6, 7, 8, 9, 10, 11, 12, 13, 14, 15, 16, 16, 16, 17, 17, 18, 18, 18, 19, 19, 19, 20, 20, 20, 20, 21, 21, 21, 21, 22, 22, 22, 22, 22, 23, 23, 23, 23, 23, 23,
    24, 24, 24, 24, 24, 24, 25, 25, 25, 25, 25, 25, 25, 26, 26, 26, 26, 26, 26, 26, 26, 27, 27, 27, 27, 27, 27, 27, 27, 27, 27, 28, 28, 28, 28, 28, 28, 28, 28, 28, 28, 29, 29, 29, 29, 29, 29, 29, 29, 29, 29, 29, 29,
    30, 30, 30, 30, 30, 30, 30, 30, 30, 30, 30, 30, 30, 30, 31, 31, 31, 31, 31, 31, 31, 31, 31, 31, 31, 31, 31, 31, 31};

__device__ __forceinline__ void p0_transpose_item(const float* W, int K, int N, int ldw, bf16* WT, int mode, LAS float* scr, int item, int lane) {
    const int nblk = N / 32, kb = item / nblk, nb = item % nblk, k0 = 64 * kb, n0 = 32 * nb;
    const int r0 = mode == 0 ? n0 : (256 * (n0 >> 7) + 128 * (mode - 1) + (n0 & 127));
    f32x4 v[8];
#pragma unroll
    for (int i = 0; i < 8; ++i) v[i] = __builtin_nontemporal_load((const f32x4*)(W + (size_t)(k0 + 8 * i + (lane >> 3)) * ldw + n0 + 4 * (lane & 7)));
#pragma unroll
    for (int i = 0; i < 8; ++i) { LAS float* d = scr + (8 * i + (lane >> 3)) * 33 + 4 * (lane & 7); d[0] = v[i][0]; d[1] = v[i][1]; d[2] = v[i][2]; d[3] = v[i][3]; }
    asm volatile("s_waitcnt lgkmcnt(0)" ::: "memory");
    const int c = lane & 7;
#pragma unroll
    for (int j = 0; j < 4; ++j) { const int n = (lane >> 3) + 8 * j; const LAS float* s = scr + (8 * c) * 33 + n;
        u32x4 o; o.x = pk2(s[0 * 33], s[1 * 33]); o.y = pk2(s[2 * 33], s[3 * 33]); o.z = pk2(s[4 * 33], s[5 * 33]); o.w = pk2(s[6 * 33], s[7 * 33]);
        __builtin_nontemporal_store(o, (u32x4*)(WT + (size_t)(r0 + n) * K + k0 + 8 * c)); }
    asm volatile("s_waitcnt lgkmcnt(0)" ::: "memory");
}

template <int I> __device__ __forceinline__ const float* in_ptr() {
    unsigned long long v; const unsigned long long kav = (unsigned long long)__builtin_amdgcn_kernarg_segment_ptr();
    const unsigned ka_lo = __builtin_amdgcn_readfirstlane((unsigned)kav), ka_hi = __builtin_amdgcn_readfirstlane((unsigned)(kav >> 32));
    const unsigned long long ka = ((unsigned long long)ka_hi << 32) | ka_lo;
    asm volatile("s_load_dwordx2 %0, %1, %2\n\ts_waitcnt lgkmcnt(0)" : "=s"(v) : "s"(ka), "n"(I * 8));
    return (const float*)(const GAS float*)v;
}
__device__ __forceinline__ unsigned char* ws_ptr() { return (unsigned char*)in_ptr<25>(); }
__device__ __forceinline__ float* out_ptr() { return (float*)in_ptr<24>(); }
#define PHASE_IDS() int tid_ = threadIdx.x; asm volatile("" : "+v"(tid_)); const int tid = tid_, lane = tid & 63, wave = __builtin_amdgcn_readfirstlane(tid >> 6); (void)lane; (void)wave; unsigned char* const ws = ws_ptr(); (void)ws
constexpr int XP_IT_A = 64 * 344, XP_IT_SQ = 64 * 128, XP_IT_QKV = 64 * 160, XP_PER_L = 3 * XP_IT_A, XP_PER_J = 3 * XP_IT_SQ + XP_IT_QKV;
static_assert((11008 / 64) * (4096 / 32) == XP_IT_A, "w_down items");
constexpr int XG_MIX0 = 0, XG_FFN0 = XG_MIX0 + XP_PER_J, XG_FFN1 = XG_FFN0 + XP_PER_L, XG_GLU1 = XG_FFN1 + XP_PER_L, XG_FFN2 = XG_GLU1 + 2 * XP_IT_SQ, XG_QKVO1 = XG_FFN2 + XP_PER_L,
              XG_FFN3 = XG_QKVO1 + XP_IT_QKV + XP_IT_SQ, XG_END = XG_FFN3 + XP_PER_L;
static_assert(XG_FFN0 == 34816 && XG_FFN1 == 100864 && XG_GLU1 == 166912 && XG_FFN2 == 183296 && XG_QKVO1 == 249344 && XG_FFN3 == 267776 && XG_END == 333824, "conversion list");
constexpr int XS_P0A_LO = 0, XS_P0A_HI = XG_FFN0;
constexpr int XS_L0S1_LO = XG_FFN0, XS_L0S1_HI = XG_FFN0 + XP_PER_L / 2, XS_L0S3_LO = XS_L0S1_HI, XS_L0S3_HI = XG_FFN1;
constexpr int XS_T0_LO = XG_FFN1, XS_T0_HI = XG_FFN1 + 16384;
constexpr int XS_T1Q_LO = XS_T0_HI, XS_T1Q_HI = XS_T0_HI + 32768;
constexpr int XS_X = 8448;
constexpr int XS_L0S1X_LO = XS_T1Q_HI, XS_L0S3X_LO = XS_T1Q_HI + XS_X;
constexpr int XS_P0B_LO = XS_T1Q_HI + 2 * XS_X, XS_P0B_HI = XG_GLU1;
constexpr int XS_T1_LO = XG_GLU1, XS_T1_HI = XG_FFN2;
constexpr int XS_L2S1_LO = XG_FFN2, XS_L2S1_HI = XG_FFN2 + XP_PER_L / 2, XS_L2S3_LO = XS_L2S1_HI, XS_L2S3_HI = XG_QKVO1;
constexpr int XS_T2_LO = XG_QKVO1, XS_T2_HI = XG_QKVO1 + 16384;
constexpr int XS_T3Q_LO = XS_T2_HI, XS_T3Q_HI = XS_T2_HI + 32768;
constexpr int XS_L2S1X_LO = XS_T3Q_HI, XS_L2S3X_LO = XS_T3Q_HI + XS_X;
constexpr int XS_P0C_LO = XS_T3Q_HI + 2 * XS_X, XS_P0C_HI = XG_END;
static_assert(XS_P0B_LO <= XS_P0B_HI && XS_P0C_LO <= XS_P0C_HI && XS_T1Q_HI < XG_GLU1 && XS_T2_HI > XG_QKVO1 + XP_IT_QKV && XS_T2_HI < XG_FFN3 && XS_T3Q_HI < XG_END, "conversion deal");
__device__ __forceinline__ void xpose_global_item(int idx, LAS float* scr, int lane) {
    unsigned char* const ws = ws_ptr();
    const float* W; bf16* WT; int K = 4096, N = 4096, ldw = 4096, mode = 0, r;
    const bool mix = idx < XG_FFN0 || (idx >= XG_GLU1 && idx < XG_FFN2) || (idx >= XG_QKVO1 && idx < XG_FFN3);
    if (!mix) {
        int l, base;
        if (idx < XG_FFN1) { l = 0; base = XG_FFN0; } else if (idx < XG_GLU1) { l = 1; base = XG_FFN1; } else if (idx < XG_QKVO1) { l = 2; base = XG_FFN2; } else { l = 3; base = XG_FFN3; }
        r = idx - base; const int which = r / XP_IT_A; r -= which * XP_IT_A;
        if (which < 2) { W = in_ptr<7>() + (size_t)l * 4096 * 22016 + which * 11008; N = 11008; ldw = 22016; WT = (bf16*)(ws + WS_WIN + l * SZ_WIN); mode = 1 + which; }
        else { W = in_ptr<8>() + (size_t)l * 11008 * 4096; K = 11008; WT = (bf16*)(ws + WS_WDN + l * SZ_WDN); }
    } else {
        int j;
        if (idx < XG_FFN0) { j = 0; r = idx; } else if (idx < XG_FFN2) { j = 1; r = idx - XG_GLU1; } else { j = 1; r = idx - XG_QKVO1 + 2 * XP_IT_SQ; }
        if (r < XP_IT_SQ) { W = in_ptr<22>() + (size_t)j * 4096 * 4096; WT = (bf16*)(ws + WS_WGLU + j * SZ_WGLU); mode = 1; }
        else if (r < 2 * XP_IT_SQ) { W = in_ptr<23>() + (size_t)j * 4096 * 4096; WT = (bf16*)(ws + WS_WGLU + j * SZ_WGLU); mode = 2; r -= XP_IT_SQ; }
        else if (r < 2 * XP_IT_SQ + XP_IT_QKV) { W = in_ptr<9>() + (size_t)j * 4096 * 5120; N = 5120; ldw = 5120; WT = (bf16*)(ws + WS_WQKV + j * SZ_WQKV); r -= 2 * XP_IT_SQ; }
        else { W = in_ptr<11>() + (size_t)j * 4096 * 4096; WT = (bf16*)(ws + WS_WO + j * SZ_WO); r -= 2 * XP_IT_SQ + XP_IT_QKV; }
    }
    p0_transpose_item(W, K, N, ldw, WT, mode, scr, r, lane);
}
__device__ __forceinline__ void host_tail(LAS unsigned char* lds, int nunits, int lo, int hi) {
    PHASE_IDS();
    const int first = nunits % (int)gridDim.x;
    if ((int)blockIdx.x < first) return;
    const int nw = ((int)gridDim.x - first) * NWAVES, w = ((int)blockIdx.x - first) * NWAVES + wave;
    LAS float* scr = (LAS float*)(lds + wave * 16384);
    for (int it = lo + w; it < hi; it += nw) xpose_global_item(it, scr, lane);
}

__device__ __forceinline__ void phase0(LAS unsigned char* lds) {
    PHASE_IDS();
    const int gw = blockIdx.x * NWAVES + wave, ngw = gridDim.x * NWAVES, gtid = blockIdx.x * NTHR + tid, gthr = gridDim.x * NTHR;
    {
        LAS float* sc = (LAS float*)lds;
        const float* c = in_ptr<1>();
        for (int i = tid; i < 2 * 4096; i += NTHR) { const float v = c[i]; sc[i] = v / (1.0f + expf(-v)); }
        __syncthreads();
        const float* w_ada = in_ptr<2>(); float* modp = (float*)(ws + WS_MODP);
        for (int it = gw; it < 96 * 64; it += ngw) {
            const int cb = it % 96, ks = it / 96;
            const float* wp = w_ada + (size_t)(ks * 64) * 24576 + cb * 256 + lane * 4;
            f32x4 a0 = {0.f, 0.f, 0.f, 0.f}, a1 = {0.f, 0.f, 0.f, 0.f};
#pragma unroll 8
            for (int k = 0; k < 64; ++k) { const f32x4 w = __builtin_nontemporal_load((const f32x4*)(wp + (size_t)k * 24576)); const float s0 = sc[ks * 64 + k], s1 = sc[4096 + ks * 64 + k]; a0 += s0 * w; a1 += s1 * w; }
            *(f32x4*)(modp + ((size_t)ks * 2 + 0) * 24576 + cb * 256 + lane * 4) = a0;
            *(f32x4*)(modp + ((size_t)ks * 2 + 1) * 24576 + cb * 256 + lane * 4) = a1;
        }
        __syncthreads();
    }
    {
        const float* a_re = in_ptr<14>(); const float* a_im = in_ptr<15>(); const float* log_dt = in_ptr<16>(); const float* b_re = in_ptr<17>(); const float* b_im = in_ptr<18>();
        float* ABAR = (float*)(ws + WS_ABAR); float* ABART = (float*)(ws + WS_ABART); u32x4* BFRAG = (u32x4*)(ws + WS_BBAR);
        for (int i = gtid; i < 2 * 256 * 64; i += gthr) {
            const int p = i & 63, jg = i >> 6;
            const float are = a_re[i], aim = a_im[i], dt = expf(log_dt[jg]);
            const float mag = expf(are * dt), ang = aim * dt;
            const float abr = mag * cosf(ang), abi = mag * sinf(ang);
            const float den = are * are + aim * aim, nr = abr - 1.0f;
            const float kre = (nr * are + abi * aim) / den, kim = (abi * are - nr * aim) / den;
            ABAR[(jg * 2 + 0) * 64 + p] = abr; ABAR[(jg * 2 + 1) * 64 + p] = abi;
            float tr = abr, ti = abi;
#pragma unroll
            for (int q = 0; q < 6; ++q) { const float n2 = tr * tr - ti * ti, i2 = 2.0f * tr * ti; tr = n2; ti = i2; }
            ABART[(jg * 2 + 0) * 64 + p] = tr; ABART[(jg * 2 + 1) * 64 + p] = ti;
            const f32x4* br = (const f32x4*)(b_re + (size_t)i * 16); const f32x4* bi = (const f32x4*)(b_im + (size_t)i * 16);
            float vr[16], vi[16];
#pragma unroll
            for (int q = 0; q < 4; ++q) { const f32x4 r = br[q], m = bi[q];
#pragma unroll
                for (int e = 0; e < 4; ++e) { vr[q * 4 + e] = kre * r[e] - kim * m[e]; vi[q * 4 + e] = kre * m[e] + kim * r[e]; } }
            u32x4* fr_re = BFRAG + ((size_t)jg * 8 + (p >> 4)) * 64 + (p & 15); u32x4* fr_im = fr_re + 4 * 64;
#pragma unroll
            for (int q = 0; q < 2; ++q) { u32x4 w; w.x = pk2(vr[8 * q + 0], vr[8 * q + 1]); w.y = pk2(vr[8 * q + 2], vr[8 * q + 3]); w.z = pk2(vr[8 * q + 4], vr[8 * q + 5]); w.w = pk2(vr[8 * q + 6], vr[8 * q + 7]); fr_re[16 * q] = w;
                w.x = pk2(vi[8 * q + 0], vi[8 * q + 1]); w.y = pk2(vi[8 * q + 2], vi[8 * q + 3]); w.z = pk2(vi[8 * q + 4], vi[8 * q + 5]); w.w = pk2(vi[8 * q + 6], vi[8 * q + 7]); fr_im[16 * q] = w; }
            const u32x4 z4 = {0u, 0u, 0u, 0u}; fr_re[32] = z4; fr_re[48] = z4; fr_im[32] = z4; fr_im[48] = z4;
        }
    }
    {
        LAS float* scr = (LAS float*)(lds + wave * 16384);
        constexpr int NA = XS_P0A_HI - XS_P0A_LO, NB = XS_P0B_HI - XS_P0B_LO, NC = XS_P0C_HI - XS_P0C_LO;
        for (int it = gw; it < NA + NB + NC; it += ngw) {
            const int idx = it < NA ? XS_P0A_LO + it : (it < NA + NB ? XS_P0B_LO + (it - NA) : XS_P0C_LO + (it - NA - NB));
            xpose_global_item(idx, scr, lane);
        }
    }
}

__device__ __forceinline__ void phase1() {
    PHASE_IDS();
    const int gtid = blockIdx.x * NTHR + tid, gthr = gridDim.x * NTHR;
    const float* modp = (const float*)(ws + WS_MODP); const float* b_ada = in_ptr<3>(); const float* tab = in_ptr<4>(); float* modsl = (float*)(ws + WS_MODSL);
    for (int i = gtid; i < 2 * 24576; i += gthr) {
        const int b = i / 24576, n = i % 24576; float s = b_ada[n];
        for (int ks = 0; ks < 64; ++ks) s += modp[((size_t)ks * 2 + b) * 24576 + n];
#pragma unroll
        for (int l = 0; l < 4; ++l) modsl[((size_t)(l * 2 + b) * 6) * 4096 + n] = s + tab[(size_t)l * 24576 + n];
    }
}
#define LN_ROW_STATS(va, vb, mean, rstd) do { float s_ = 0.f; \
    _Pragma("unroll") for (int i = 0; i < 8; ++i) s_ += ((va[i][0] + va[i][1]) + (va[i][2] + va[i][3])) + ((vb[i][0] + vb[i][1]) + (vb[i][2] + vb[i][3])); \
    mean = wave_sum(s_) * (1.0f / 4096.0f); float s2_ = 0.f; \
    _Pragma("unroll") for (int i = 0; i < 8; ++i) { va[i] = va[i] - mean; vb[i] = vb[i] - mean; \
        s2_ += ((va[i][0] * va[i][0] + va[i][1] * va[i][1]) + (va[i][2] * va[i][2] + va[i][3] * va[i][3])) + ((vb[i][0] * vb[i][0] + vb[i][1] * vb[i][1]) + (vb[i][2] * vb[i][2] + vb[i][3] * vb[i][3])); } \
    rstd = 1.0f / sqrtf(wave_sum(s2_) * (1.0f / 4096.0f) + LN_EPS); } while (0)
constexpr size_t X24_LO_OFF = 8192ull * 4096 * 2;
__device__ __forceinline__ void ln_load_x(const float* Xin, bool x24, int row, int lane, int i, f32x4& xa, f32x4& xb) {
    if (!x24) { const float* xr = Xin + (size_t)row * 4096 + lane * 8 + 512 * i; xa = __builtin_nontemporal_load((const f32x4*)xr); xb = __builtin_nontemporal_load((const f32x4*)(xr + 4)); return; }
    const size_t e0 = (size_t)row * 4096 + lane * 8 + 512 * i;
    const u32x4 hw = __builtin_nontemporal_load((const u32x4*)((const unsigned short*)Xin + e0)); const u32x2 lw = __builtin_nontemporal_load((const u32x2*)((const unsigned char*)Xin + X24_LO_OFF + e0));
    xa[0] = __uint_as_float(__builtin_amdgcn_perm(hw.x, lw.x, 0x0504000cu)); xa[1] = __uint_as_float(__builtin_amdgcn_perm(hw.x, lw.x, 0x0706010cu));
    xa[2] = __uint_as_float(__builtin_amdgcn_perm(hw.y, lw.x, 0x0504020cu)); xa[3] = __uint_as_float(__builtin_amdgcn_perm(hw.y, lw.x, 0x0706030cu));
    xb[0] = __uint_as_float(__builtin_amdgcn_perm(hw.z, lw.y, 0x0504000cu)); xb[1] = __uint_as_float(__builtin_amdgcn_perm(hw.z, lw.y, 0x0706010cu));
    xb[2] = __uint_as_float(__builtin_amdgcn_perm(hw.w, lw.y, 0x0504020cu)); xb[3] = __uint_as_float(__builtin_amdgcn_perm(hw.w, lw.y, 0x0706030cu));
}
__device__ __forceinline__ void ln_store_x(float* Xout, bool x24, int row, int lane, int i, const f32x4& xa, const f32x4& xb) {
    if (!x24) { float* xo = Xout + (size_t)row * 4096 + lane * 8 + 512 * i; __builtin_nontemporal_store(xa, (f32x4*)xo); __builtin_nontemporal_store(xb, (f32x4*)(xo + 4)); return; }
    unsigned t[8];
#pragma unroll
    for (int e = 0; e < 4; ++e) { t[e] = __float_as_uint(xa[e]) + 0x80u; t[4 + e] = __float_as_uint(xb[e]) + 0x80u; }
    u32x4 hw; hw.x = __builtin_amdgcn_perm(t[1], t[0], 0x07060302u); hw.y = __builtin_amdgcn_perm(t[3], t[2], 0x07060302u); hw.z = __builtin_amdgcn_perm(t[5], t[4], 0x07060302u); hw.w = __builtin_amdgcn_perm(t[7], t[6], 0x07060302u);
    u32x2 lw; lw.x = __builtin_amdgcn_perm(__builtin_amdgcn_perm(t[3], t[2], 0x0c0c0501u), __builtin_amdgcn_perm(t[1], t[0], 0x0c0c0501u), 0x05040100u);
    lw.y = __builtin_amdgcn_perm(__builtin_amdgcn_perm(t[7], t[6], 0x0c0c0501u), __builtin_amdgcn_perm(t[5], t[4], 0x0c0c0501u), 0x05040100u);
    const size_t e0 = (size_t)row * 4096 + lane * 8 + 512 * i;
    __builtin_nontemporal_store(hw, (u32x4*)((unsigned short*)Xout + e0)); __builtin_nontemporal_store(lw, (u32x2*)((unsigned char*)Xout + X24_LO_OFF + e0));
}
#define LN_LOAD_Z(va, vb, Xin, x24, row, yr) do { _Pragma("unroll") for (int i = 0; i < 8; ++i) { \
    f32x4 xa, xb; ln_load_x(Xin, x24, row, lane, i, xa, xb); const u32x4 yw = __builtin_nontemporal_load((const u32x4*)(yr + 512 * i)); \
    va[i][0] = pg8::ALPHA_RES * xa[0] + bf_lo(yw.x); va[i][1] = pg8::ALPHA_RES * xa[1] + bf_hi(yw.x); va[i][2] = pg8::ALPHA_RES * xa[2] + bf_lo(yw.y); va[i][3] = pg8::ALPHA_RES * xa[3] + bf_hi(yw.y); \
    vb[i][0] = pg8::ALPHA_RES * xb[0] + bf_lo(yw.z); vb[i][1] = pg8::ALPHA_RES * xb[1] + bf_hi(yw.z); vb[i][2] = pg8::ALPHA_RES * xb[2] + bf_lo(yw.w); vb[i][3] = pg8::ALPHA_RES * xb[3] + bf_hi(yw.w); } } while (0)
__device__ __forceinline__ void ln_stage_vec(LAS unsigned char* lds, int k, const float* src, float add, int tid) {
    for (int q = tid; q < 1024; q += NTHR) { const int c = 4 * q, i = c >> 9, w = c & 511, ln = w >> 3, h = (w >> 2) & 1;
        const f32x4 v = *(const f32x4*)(src + c) + add;
        *(LAS f32x4*)(lds + k * 16384 + i * 2048 + h * 1024 + ln * 16) = v; }
}
#define LN_VEC(k, i, h) (*(const LAS f32x4*)(lds + (k) * 16384 + (i) * 2048 + (h) * 1024 + lane * 16))
__device__ __forceinline__ void phase_ln1(LAS unsigned char* lds, const float* Xin, bool xin24, const bf16* Y1, const float* g, const float* beta, const float* mods, bf16* H) {
    PHASE_IDS();
    ln_stage_vec(lds, 0, g, 0.f, tid); ln_stage_vec(lds, 1, beta, 0.f, tid);
    ln_stage_vec(lds, 2, mods + (size_t)(0 * 6 + 4) * 4096, 1.0f, tid); ln_stage_vec(lds, 3, mods + (size_t)(0 * 6 + 3) * 4096, 0.f, tid);
    ln_stage_vec(lds, 4, mods + (size_t)(1 * 6 + 4) * 4096, 1.0f, tid); ln_stage_vec(lds, 5, mods + (size_t)(1 * 6 + 3) * 4096, 0.f, tid);
    __syncthreads();
    const int gw = blockIdx.x * NWAVES + wave, ngw = gridDim.x * NWAVES;
    for (int row = gw; row < MROWS; row += ngw) {
        const int b = row >> 12;
        const bf16* yr = Y1 + (size_t)row * 4096 + lane * 8;
        f32x4 va[8], vb[8]; float mean, rstd;
        LN_LOAD_Z(va, vb, Xin, xin24, row, yr);
        LN_ROW_STATS(va, vb, mean, rstd);
#pragma unroll
        for (int i = 0; i < 8; ++i) {
            const f32x4 xna = va[i] * rstd * LN_VEC(0, i, 0) + LN_VEC(1, i, 0), xnb = vb[i] * rstd * LN_VEC(0, i, 1) + LN_VEC(1, i, 1);
            const f32x4 ha = xna * LN_VEC(2 + 2 * b, i, 0) + LN_VEC(3 + 2 * b, i, 0), hb = xnb * LN_VEC(2 + 2 * b, i, 1) + LN_VEC(3 + 2 * b, i, 1);
            u32x4 w; w.x = pk2(ha[0], ha[1]); w.y = pk2(ha[2], ha[3]); w.z = pk2(hb[0], hb[1]); w.w = pk2(hb[2], hb[3]);
            *(u32x4*)(H + (size_t)row * 4096 + lane * 8 + 512 * i) = w;
        }
    }
    __syncthreads();
}
__device__ __forceinline__ void phase_ln2(LAS unsigned char* lds, const float* Xin, bool xin24, bool xout24, const bf16* Y1, const bf16* Y2, const float* g1, const float* beta1, const float* g2, const float* beta2, float* Xout, const float* mods, bf16* H) {
    PHASE_IDS();
    ln_stage_vec(lds, 0, g1, 0.f, tid); ln_stage_vec(lds, 1, beta1, 0.f, tid); ln_stage_vec(lds, 2, g2, 0.f, tid); ln_stage_vec(lds, 3, beta2, 0.f, tid);
    if (H) { ln_stage_vec(lds, 4, mods + (size_t)(0 * 6 + 1) * 4096, 1.0f, tid); ln_stage_vec(lds, 5, mods + (size_t)(0 * 6 + 0) * 4096, 0.f, tid);
             ln_stage_vec(lds, 6, mods + (size_t)(1 * 6 + 1) * 4096, 1.0f, tid); ln_stage_vec(lds, 7, mods + (size_t)(1 * 6 + 0) * 4096, 0.f, tid); }
    __syncthreads();
    const int gw = blockIdx.x * NWAVES + wave, ngw = gridDim.x * NWAVES;
    for (int row = gw; row < MROWS; row += ngw) {
        const int b = row >> 12;
        const bf16* yr = Y1 + (size_t)row * 4096 + lane * 8; const bf16* y2r = Y2 + (size_t)row * 4096 + lane * 8;
        f32x4 va[8], vb[8]; float mean, rstd;
        LN_LOAD_Z(va, vb, Xin, xin24, row, yr);
        u32x4 y2w[8];
#pragma unroll
        for (int i = 0; i < 8; ++i) y2w[i] = __builtin_nontemporal_load((const u32x4*)(y2r + 512 * i));
        LN_ROW_STATS(va, vb, mean, rstd);
#pragma unroll
        for (int i = 0; i < 8; ++i) {
            const f32x4 xna = va[i] * rstd * LN_VEC(0, i, 0) + LN_VEC(1, i, 0), xnb = vb[i] * rstd * LN_VEC(0, i, 1) + LN_VEC(1, i, 1);
            const u32x4 yw = y2w[i];
            va[i][0] = pg8::ALPHA_RES * xna[0] + bf_lo(yw.x); va[i][1] = pg8::ALPHA_RES * xna[1] + bf_hi(yw.x); va[i][2] = pg8::ALPHA_RES * xna[2] + bf_lo(yw.y); va[i][3] = pg8::ALPHA_RES * xna[3] + bf_hi(yw.y);
            vb[i][0] = pg8::ALPHA_RES * xnb[0] + bf_lo(yw.z); vb[i][1] = pg8::ALPHA_RES * xnb[1] + bf_hi(yw.z); vb[i][2] = pg8::ALPHA_RES * xnb[2] + bf_lo(yw.w); vb[i][3] = pg8::ALPHA_RES * xnb[3] + bf_hi(yw.w); }
        LN_ROW_STATS(va, vb, mean, rstd);
#pragma unroll
        for (int i = 0; i < 8; ++i) {
            const f32x4 xna = va[i] * rstd * LN_VEC(2, i, 0) + LN_VEC(3, i, 0), xnb = vb[i] * rstd * LN_VEC(2, i, 1) + LN_VEC(3, i, 1);
            ln_store_x(Xout, xout24, row, lane, i, xna, xnb);
            if (H) {
                const f32x4 ha = xna * LN_VEC(4 + 2 * b, i, 0) + LN_VEC(5 + 2 * b, i, 0), hb = xnb * LN_VEC(4 + 2 * b, i, 1) + LN_VEC(5 + 2 * b, i, 1);
                u32x4 w; w.x = pk2(ha[0], ha[1]); w.y = pk2(ha[2], ha[3]); w.z = pk2(hb[0], hb[1]); w.w = pk2(hb[2], hb[3]);
                *(u32x4*)(H + (size_t)row * 4096 + lane * 8 + 512 * i) = w;
            }
        }
    }
    __syncthreads();
}

__device__ __forceinline__ void phase_modulate(LAS unsigned char* lds, const float* x, const float* mods, bf16* H) {
    PHASE_IDS();
    ln_stage_vec(lds, 0, mods + (size_t)(0 * 6 + 1) * 4096, 1.0f, tid); ln_stage_vec(lds, 1, mods + (size_t)(0 * 6 + 0) * 4096, 0.f, tid);
    ln_stage_vec(lds, 2, mods + (size_t)(1 * 6 + 1) * 4096, 1.0f, tid); ln_stage_vec(lds, 3, mods + (size_t)(1 * 6 + 0) * 4096, 0.f, tid);
    __syncthreads();
    const int gw = blockIdx.x * NWAVES + wave, ngw = gridDim.x * NWAVES;
    for (int row = gw; row < MROWS; row += ngw) {
        const int b = row >> 12; const float* xr = x + (size_t)row * 4096 + lane * 8;
        f32x4 xa[8], xb[8];
#pragma unroll
        for (int i = 0; i < 8; ++i) { xa[i] = __builtin_nontemporal_load((const f32x4*)(xr + 512 * i)); xb[i] = __builtin_nontemporal_load((const f32x4*)(xr + 512 * i + 4)); }
#pragma unroll
        for (int i = 0; i < 8; ++i) { const f32x4 ha = xa[i] * LN_VEC(2 * b, i, 0) + LN_VEC(2 * b + 1, i, 0), hb = xb[i] * LN_VEC(2 * b, i, 1) + LN_VEC(2 * b + 1, i, 1);
            u32x4 w; w.x = pk2(ha[0], ha[1]); w.y = pk2(ha[2], ha[3]); w.z = pk2(hb[0], hb[1]); w.w = pk2(hb[2], hb[3]);
            *(u32x4*)(H + (size_t)row * 4096 + lane * 8 + 512 * i) = w; }
    }
    __syncthreads();
}

constexpr int SSM_WLDS = 16384, SSM_ST = 2048, SSM_U = 6400, SSM_USTR = 528;
__device__ __forceinline__ void ssm_load_h(const bf16* H, int b, int k, int g, int lane, u32x4& v0, u32x4& v1) {
    const u32x4* src = (const u32x4*)(H + ((size_t)(b * SEQ + k * TC + lane)) * 4096 + g * 16);
    v0 = src[0]; v1 = src[1];
}
__device__ __forceinline__ void ssm_store_h(LAS unsigned char* hs, int lane, const u32x4& v0, const u32x4& v1) { *(LAS u32x4*)(hs + lane * 32) = v0; *(LAS u32x4*)(hs + lane * 32 + 16) = v1; }
__device__ __forceinline__ void ssm_bproj16(const LAS unsigned char* hs, LAS unsigned char* ut, int tg, const bf16x8 (&bf)[8], int fr, int fq) {
    u32x4 aw = {0u, 0u, 0u, 0u};
    if (fq < 2) aw = *(const LAS u32x4*)(hs + (tg * 16 + fr) * 32 + fq * 16);
    const bf16x8 a = __builtin_bit_cast(bf16x8, aw);
#pragma unroll
    for (int tau = 0; tau < 8; ++tau) { f32x4 acc = {0.f, 0.f, 0.f, 0.f};
        acc = __builtin_amdgcn_mfma_f32_16x16x32_bf16(a, bf[tau], acc, 0, 0, 0);
#pragma unroll
        for (int r = 0; r < 4; ++r) *(LAS float*)(ut + (4 * fq + r) * SSM_USTR + (tau * 16 + fr) * 4) = acc[r]; }
}
__device__ __forceinline__ void ssm_update(const LAS unsigned char* ut, int tt, int lane, float are, float aim, float& sre, float& sim) {
    const float ure = *(const LAS float*)(ut + tt * SSM_USTR + lane * 4), uim = *(const LAS float*)(ut + tt * SSM_USTR + 256 + lane * 4);
    const float nre = are * sre - aim * sim + ure, nim = are * sim + aim * sre + uim;
    sre = nre; sim = nim;
}
__device__ __forceinline__ void phase_ssm_local(int j, LAS unsigned char* lds, int xlo, int xhi, int xlo2, int xn2) {
    PHASE_IDS();
    const bf16* H = (const bf16*)(ws + WS_H); float* E = (float*)(ws + WS_E);
    const float* ABAR = (const float*)(ws + WS_ABAR); const u32x4* BFRAG = (const u32x4*)(ws + WS_BBAR);
    LAS unsigned char* hs = lds + wave * SSM_WLDS; LAS unsigned char* ut = hs + SSM_U;
    const int gw = blockIdx.x * NWAVES + wave, ngw = gridDim.x * NWAVES, fr = lane & 15, fq = lane >> 4;
    const int g = gw & 255, jg = j * 256 + g, bstep = ngw >> 8; constexpr int NBK = 2 * (NCHUNK - 1);
    bf16x8 bf[8];
#pragma unroll
    for (int tau = 0; tau < 8; ++tau) bf[tau] = __builtin_bit_cast(bf16x8, BFRAG[((size_t)jg * 8 + tau) * 64 + lane]);
    const float are = ABAR[(jg * 2 + 0) * 64 + lane], aim = ABAR[(jg * 2 + 1) * 64 + lane];
    u32x4 n0 = {0u, 0u, 0u, 0u}, n1 = {0u, 0u, 0u, 0u};
    int xi = gw, itn = 0; const int xtot = xn2 + (xhi - xlo);
    int bk = (gw < (ngw & ~255)) ? (gw >> 8) : NBK;
    if (bk < NBK) ssm_load_h(H, bk / (NCHUNK - 1), bk % (NCHUNK - 1), g, lane, n0, n1);
    for (; bk < NBK; bk += bstep) {
        const int k = bk % (NCHUNK - 1), b = bk / (NCHUNK - 1);
        ssm_store_h(hs, lane, n0, n1);
        { const int nx = bk + bstep; if (nx < NBK) ssm_load_h(H, nx / (NCHUNK - 1), nx % (NCHUNK - 1), g, lane, n0, n1); }
        float sre = 0.f, sim = 0.f;
        for (int tg = 0; tg < TC / 16; ++tg) {
            ssm_bproj16(hs, ut, tg, bf, fr, fq);
#pragma unroll
            for (int tt = 0; tt < 16; ++tt) ssm_update(ut, tt, lane, are, aim, sre, sim);
        }
        float* e = E + (((size_t)(b * NCHUNK + k) * 256 + g) * 2) * 64 + lane;
        e[0] = sre; e[64] = sim;
        if (xi < xtot) { xpose_global_item(xi < xn2 ? xlo2 + xi : xlo + (xi - xn2), (LAS float*)ut, lane); xi += ngw; }
        if ((itn++ & 3) == 3 && xi < xtot) { xpose_global_item(xi < xn2 ? xlo2 + xi : xlo + (xi - xn2), (LAS float*)ut, lane); xi += ngw; }
    }
    for (; xi < xtot; xi += ngw) xpose_global_item(xi < xn2 ? xlo2 + xi : xlo + (xi - xn2), (LAS float*)ut, lane);
}
__device__ __forceinline__ void phase_ssm_carry(int j) {
    PHASE_IDS();
    const float* E = (const float*)(ws + WS_E); float* SP = (float*)(ws + WS_SP); const float* ABART = (const float*)(ws + WS_ABART);
    const int gtid = blockIdx.x * NTHR + tid, gthr = gridDim.x * NTHR;
    for (int i = gtid; i < 2 * 256 * 64; i += gthr) {
        const int p = i & 63, g = (i >> 6) & 255, b = i >> 14, jg = j * 256 + g;
        const float tr = ABART[(jg * 2 + 0) * 64 + p], ti = ABART[(jg * 2 + 1) * 64 + p];
        const size_t base = (((size_t)(b * NCHUNK) * 256 + g) * 2) * 64 + p, kstr = (size_t)256 * 2 * 64;
        float sre = 0.f, sim = 0.f;
        for (int k0 = 0; k0 < NCHUNK; k0 += 8) {
            float er[8], ei[8];
#pragma unroll
            for (int u = 0; u < 8; ++u) { const bool ok = (k0 + u) < NCHUNK - 1; er[u] = ok ? E[base + (size_t)(k0 + u) * kstr] : 0.f; ei[u] = ok ? E[base + (size_t)(k0 + u) * kstr + 64] : 0.f; }
#pragma unroll
            for (int u = 0; u < 8; ++u) { SP[base + (size_t)(k0 + u) * kstr] = sre; SP[base + (size_t)(k0 + u) * kstr + 64] = sim;
                const float nre = tr * sre - ti * sim + er[u], nim = tr * sim + ti * sre + ei[u]; sre = nre; sim = nim; }
        }
    }
}
__device__ __forceinline__ float gelu_tanh(float y) {
    const float a = 0.7978845608028654f * (y + 0.044715f * y * y * y);
    return y * __builtin_amdgcn_rcpf(1.0f + __builtin_amdgcn_exp2f(-2.0f * 1.44269504089f * a));
}
__device__ __forceinline__ void phase_ssm_scan(int j, LAS unsigned char* lds, int xlo, int xhi, int xlo2, int xn2) {
    PHASE_IDS();
    const bf16* H = (const bf16*)(ws + WS_H); const float* SP = (const float*)(ws + WS_SP); bf16* U = (bf16*)(ws + WS_U);
    const float* ABAR = (const float*)(ws + WS_ABAR); const u32x4* BFRAG = (const u32x4*)(ws + WS_BBAR);
    const float* c_re = in_ptr<19>(); const float* c_im = in_ptr<20>(); const float* dsk = in_ptr<21>();
    LAS unsigned char* hs = lds + wave * SSM_WLDS; LAS unsigned char* st = hs + SSM_ST; LAS unsigned char* ut = hs + SSM_U;
    const int gw = blockIdx.x * NWAVES + wave, ngw = gridDim.x * NWAVES, fr = lane & 15, fq = lane >> 4;
    const int g = gw & 255, jg = j * 256 + g, bstep = ngw >> 8; constexpr int NBK = 2 * NCHUNK;
    bf16x8 bf[8];
#pragma unroll
    for (int tau = 0; tau < 8; ++tau) bf[tau] = __builtin_bit_cast(bf16x8, BFRAG[((size_t)jg * 8 + tau) * 64 + lane]);
    const float are = ABAR[(jg * 2 + 0) * 64 + lane], aim = ABAR[(jg * 2 + 1) * 64 + lane];
    bf16x8 cf[4];
#pragma unroll
    for (int s4 = 0; s4 < 4; ++s4) { const float* src = ((s4 >> 1) ? c_im : c_re) + ((size_t)jg * 16 + fr) * 64 + 32 * (s4 & 1) + 8 * fq; const float sg = (s4 >> 1) ? -1.0f : 1.0f;
        const f32x4 a = *(const f32x4*)src * sg, c4 = *(const f32x4*)(src + 4) * sg;
        u32x4 w; w.x = pk2(a[0], a[1]); w.y = pk2(a[2], a[3]); w.z = pk2(c4[0], c4[1]); w.w = pk2(c4[2], c4[3]);
        cf[s4] = __builtin_bit_cast(bf16x8, w); }
    const f32x4 dv4 = *(const f32x4*)(dsk + j * 4096 + g * 16 + 4 * fq);
    u32x4 n0 = {0u, 0u, 0u, 0u}, n1 = {0u, 0u, 0u, 0u}; float nsre = 0.f, nsim = 0.f;
    int xi = gw, itn = 0; const int xtot = xn2 + (xhi - xlo);
    int bk = (gw < (ngw & ~255)) ? (gw >> 8) : NBK;
    if (bk < NBK) { ssm_load_h(H, bk >> 6, bk & (NCHUNK - 1), g, lane, n0, n1); const float* sp = SP + (((size_t)bk * 256 + g) * 2) * 64 + lane; nsre = sp[0]; nsim = sp[64]; }
    for (; bk < NBK; bk += bstep) {
        const int k = bk & (NCHUNK - 1), b = bk >> 6;
        ssm_store_h(hs, lane, n0, n1);
        float sre = nsre, sim = nsim;
        { const int nx = bk + bstep; if (nx < NBK) { ssm_load_h(H, nx >> 6, nx & (NCHUNK - 1), g, lane, n0, n1); const float* sp = SP + (((size_t)nx * 256 + g) * 2) * 64 + lane; nsre = sp[0]; nsim = sp[64]; } }
        for (int tg = 0; tg < TC / 16; ++tg) {
            ssm_bproj16(hs, ut, tg, bf, fr, fq);
            float ur[16], ui[16];
#pragma unroll
            for (int tt = 0; tt < 16; ++tt) { ur[tt] = *(const LAS float*)(ut + tt * SSM_USTR + lane * 4); ui[tt] = *(const LAS float*)(ut + tt * SSM_USTR + 256 + lane * 4); }
#pragma unroll
            for (int tt = 0; tt < 16; ++tt) {
                { const float nre = are * sre - aim * sim + ur[tt], nim = are * sim + aim * sre + ui[tt]; sre = nre; sim = nim; }
                const unsigned w = pk2(sre, sim);
                *(LAS unsigned short*)(st + tt * 272 + lane * 2) = (unsigned short)(w & 0xffffu);
                *(LAS unsigned short*)(st + tt * 272 + 128 + lane * 2) = (unsigned short)(w >> 16);
            }
            f32x4 acc = {0.f, 0.f, 0.f, 0.f};
#pragma unroll
            for (int s4 = 0; s4 < 4; ++s4) { const bf16x8 a = *(const LAS bf16x8*)(st + fr * 272 + 64 * s4 + 16 * fq);
                acc = __builtin_amdgcn_mfma_f32_16x16x32_bf16(cf[s4], a, acc, 0, 0, 0); }
            const int tok = tg * 16 + fr;
            const u32x2 hw = *(const LAS u32x2*)(hs + tok * 32 + fq * 8);
            const float y0 = acc[0] + dv4[0] * bf_lo(hw.x), y1 = acc[1] + dv4[1] * bf_hi(hw.x), y2 = acc[2] + dv4[2] * bf_lo(hw.y), y3 = acc[3] + dv4[3] * bf_hi(hw.y);
            u32x2 w; w.x = pk2(gelu_tanh(y0), gelu_tanh(y1)); w.y = pk2(gelu_tanh(y2), gelu_tanh(y3));
            *(u32x2*)(U + ((size_t)(b * SEQ + k * TC + tok)) * 4096 + g * 16 + 4 * fq) = w;
        }
        if (xi < xtot) { xpose_global_item(xi < xn2 ? xlo2 + xi : xlo + (xi - xn2), (LAS float*)ut, lane); xi += ngw; }
        if ((itn++ & 3) == 3 && xi < xtot) { xpose_global_item(xi < xn2 ? xlo2 + xi : xlo + (xi - xn2), (LAS float*)ut, lane); xi += ngw; }
    }
    for (; xi < xtot; xi += ngw) xpose_global_item(xi < xn2 ? xlo2 + xi : xlo + (xi - xn2), (LAS float*)ut, lane);
}

typedef float f32x16 __attribute__((ext_vector_type(16)));
constexpr int AT_KSTR = 144, AT_VSTR = 520, AT_K_OFF = 0, AT_V_OFF = 256 * AT_KSTR, AT_TBL_OFF = AT_V_OFF + 64 * AT_VSTR;
static_assert(AT_TBL_OFF + 8 * 512 <= RING_BYTES, "attention LDS");
__device__ __forceinline__ void phase_attn(int j, LAS unsigned char* lds) {
    PHASE_IDS();
    const bf16* QKV = (const bf16*)(ws + WS_QKV); bf16* O = (bf16*)(ws + WS_O);
    const float* sinks = in_ptr<12>() + j * 64; const float* relb = in_ptr<13>();
    const int qc = lane & 31, hh = lane >> 5;
    constexpr float LOG2E = 1.44269504089f;
    LAS float* tbl = (LAS float*)(lds + AT_TBL_OFF + wave * 512);
    for (int unit = blockIdx.x; unit < 512; unit += gridDim.x) {
        const int kvh = unit & 7, n = (unit >> 3) & 31, b = unit >> 8, h = kvh * 8 + wave;
        for (int i = lane; i < 128; i += 64) tbl[i] = relb[kBucket[i] * 64 + h] * LOG2E;
        const float sink2 = sinks[h] * LOG2E;
        const int pos0 = n * 128 - 128;
#pragma unroll
        for (int i = 0; i < 4; ++i) { const int c = tid + 512 * i, key = c >> 3, part = c & 7, pos = pos0 + key;
            u32x4 kv = {0u, 0u, 0u, 0u}, vv = {0u, 0u, 0u, 0u};
            if (pos >= 0) { const bf16* src = QKV + (size_t)(b * SEQ + pos) * NQKV + 4096 + kvh * 64 + part * 8; kv = *(const u32x4*)src; vv = *(const u32x4*)(src + 512); }
            *(LAS u32x4*)(lds + AT_K_OFF + key * AT_KSTR + part * 16) = kv;
            LAS unsigned short* vt = (LAS unsigned short*)(lds + AT_V_OFF + (part * 8) * AT_VSTR + key * 2);
#pragma unroll
            for (int e = 0; e < 4; ++e) { vt[(2 * e) * (AT_VSTR / 2)] = (unsigned short)(vv[e] & 0xffffu); vt[(2 * e + 1) * (AT_VSTR / 2)] = (unsigned short)(vv[e] >> 16); } }
        __syncthreads();
        for (int qb = 0; qb < 4; ++qb) {
            const bf16* qp = QKV + (size_t)(b * SEQ + n * 128 + 32 * qb + qc) * NQKV + h * 64 + 8 * hh;
            bf16x8 qf[4];
#pragma unroll
            for (int ks = 0; ks < 4; ++ks) qf[ks] = *(const bf16x8*)(qp + 16 * ks);
            f32x16 s[5];
#pragma unroll
            for (int jt = 0; jt < 5; ++jt) {
#pragma unroll
                for (int r = 0; r < 16; ++r) s[jt][r] = 0.f;
#pragma unroll
                for (int ks = 0; ks < 4; ++ks) { const bf16x8 kf = *(const LAS bf16x8*)(lds + AT_K_OFF + (32 * (qb + jt) + qc) * AT_KSTR + (16 * ks + 8 * hh) * 2);
                    s[jt] = __builtin_amdgcn_mfma_f32_32x32x16_bf16(kf, qf[ks], s[jt], 0, 0, 0); } }
            float mx = sink2;
#pragma unroll
            for (int jt = 0; jt < 5; ++jt) { const bool tile_dead = (n == 0) && (qb + jt < 4);
#pragma unroll
                for (int r = 0; r < 16; ++r) { const int krow = (r & 3) + 8 * (r >> 2) + 4 * hh, dist = 128 + qc - krow - 32 * jt;
                    bool valid = (jt == 0) ? (krow > qc) : ((jt == 4) ? (krow <= qc) : true); valid = valid && !tile_dead;
                    float t = s[jt][r] * (0.125f * LOG2E) + tbl[dist & 127]; t = valid ? t : -1e30f; s[jt][r] = t; mx = fmaxf(mx, t); } }
            mx = fmaxf(mx, __shfl_xor(mx, 32));
            float sum = 0.f;
#pragma unroll
            for (int jt = 0; jt < 5; ++jt)
#pragma unroll
                for (int r = 0; r < 16; ++r) { const float p = __builtin_amdgcn_exp2f(s[jt][r] - mx); s[jt][r] = p; sum += p; }
            sum += __shfl_xor(sum, 32); sum += __builtin_amdgcn_exp2f(sink2 - mx);
            const float inv = 1.0f / sum;
            f32x16 o[2];
#pragma unroll
            for (int dt = 0; dt < 2; ++dt)
#pragma unroll
                for (int r = 0; r < 16; ++r) o[dt][r] = 0.f;
#pragma unroll
            for (int jt = 0; jt < 5; ++jt)
#pragma unroll
                for (int s2 = 0; s2 < 2; ++s2) { u32x4 pw; pw.x = pk2(s[jt][8 * s2 + 0], s[jt][8 * s2 + 1]); pw.y = pk2(s[jt][8 * s2 + 2], s[jt][8 * s2 + 3]); pw.z = pk2(s[jt][8 * s2 + 4], s[jt][8 * s2 + 5]); pw.w = pk2(s[jt][8 * s2 + 6], s[jt][8 * s2 + 7]);
                    const bf16x8 pf = __builtin_bit_cast(bf16x8, pw);
#pragma unroll
                    for (int dt = 0; dt < 2; ++dt) { const LAS unsigned char* vp = lds + AT_V_OFF + (32 * dt + qc) * AT_VSTR + (32 * (qb + jt) + 16 * s2 + 4 * hh) * 2;
                        const u32x2 v0 = *(const LAS u32x2*)vp, v1 = *(const LAS u32x2*)(vp + 16); u32x4 vw; vw.x = v0.x; vw.y = v0.y; vw.z = v1.x; vw.w = v1.y;
                        o[dt] = __builtin_amdgcn_mfma_f32_32x32x16_bf16(__builtin_bit_cast(bf16x8, vw), pf, o[dt], 0, 0, 0); } }
            bf16* op = O + (size_t)(b * SEQ + n * 128 + 32 * qb + qc) * 4096 + h * 64;
#pragma unroll
            for (int dt = 0; dt < 2; ++dt)
#pragma unroll
                for (int g4 = 0; g4 < 4; ++g4) { u32x2 w; w.x = pk2(o[dt][4 * g4] * inv, o[dt][4 * g4 + 1] * inv); w.y = pk2(o[dt][4 * g4 + 2] * inv, o[dt][4 * g4 + 3] * inv);
                    *(u32x2*)(op + 32 * dt + 8 * g4 + 4 * hh) = w; }
        }
        __syncthreads();
    }
}

struct Args { const float* in[24]; float* out; unsigned char* ws; int ph_lo, ph_hi; };
__global__ void __launch_bounds__(NTHR, 2) fwd_kernel(Args args) {
    extern __shared__ __attribute__((aligned(16))) unsigned char lds_raw[];
    LAS unsigned char* lds = (LAS unsigned char*)lds_raw;
    for (int u = threadIdx.x; u < (LDS_BYTES - LDSCTL_OFF) / 4; u += NTHR) ((LAS unsigned*)(lds + LDSCTL_OFF))[u] = 0u;
    __syncthreads();
#if MK_ONE_LAUNCH
    const XcdBarrier bar = xcd_barrier_post((unsigned*)(ws_ptr() + WS_CTL) + CW_BAR, (volatile LAS unsigned*)(lds + MISC_OFF) + 8);
#define GRID_BAR() xcd_barrier(bar)
#else
#define GRID_BAR() do {} while (0)
#endif
    const int lo = args.ph_lo, hi = args.ph_hi;
#define IN(k) (lo <= (k) && (k) < hi)
#define SEAM() GRID_BAR()
#define WSP(off) (ws_ptr() + (off))
#define MODS_L(l) ((const float*)WSP(WS_MODSL) + (size_t)(l) * 2 * 6 * 4096)
#define XRES(l) ((l) == 0 ? in_ptr<0>() : (const float*)WSP(WS_X))

    if (IN(0)) phase0(lds);
    SEAM();
    if (IN(1)) phase1();
    SEAM();
    if (IN(2)) phase_modulate(lds, in_ptr<0>(), MODS_L(0), (bf16*)WSP(WS_H));
    SEAM();

    for (int l = 0; l < 4; ++l) {
        const int pb = 3 + 8 * l, j = l >> 1;
        if ((l & 1) == 0) {
            if (IN(pb + 0)) phase_ssm_local(j, lds, l ? XS_L2S1_LO : XS_L0S1_LO, l ? XS_L2S1_HI : XS_L0S1_HI, l ? XS_L2S1X_LO : XS_L0S1X_LO, XS_X);
            SEAM();
            if (IN(pb + 1)) phase_ssm_carry(j);
            SEAM();
            if (IN(pb + 2)) phase_ssm_scan(j, lds, l ? XS_L2S3_LO : XS_L0S3_LO, l ? XS_L2S3_HI : XS_L0S3_HI, l ? XS_L2S3X_LO : XS_L0S3X_LO, XS_X);
            SEAM();
            if (IN(pb + 3)) {
                pg8::Gemm g{(const bf16*)WSP(WS_U), (const bf16*)WSP(WS_WGLU + j * SZ_WGLU), MROWS, 8192, 4096}; pg8::StaticOrder S; S.init(MROWS, 8192, gridDim.x, (int)blockIdx.x);
                pg8::EpiGLUY E{(bf16*)WSP(WS_Z), MODS_L(l) + 2 * 4096};
                pg8::gemm_phase<pg8::EpiGLUY, pg8::StaticOrder, true, true, 4096>(lds, g, S, E);
            }
            SEAM();
        } else {
            if (IN(pb + 0)) {
                pg8::Gemm g{(const bf16*)WSP(WS_H), (const bf16*)WSP(WS_WQKV + j * SZ_WQKV), MROWS, NQKV, 4096}; pg8::StaticOrder S; S.init(MROWS, NQKV, gridDim.x, (int)blockIdx.x);
                pg8::EpiQKV E{(bf16*)WSP(WS_QKV), NQKV, in_ptr<10>() + j * NQKV};
                pg8::gemm_phase<pg8::EpiQKV, pg8::StaticOrder, true, true, 4096>(lds, g, S, E);
                host_tail(lds, (MROWS / 256) * (NQKV / 256), l == 1 ? XS_T1Q_LO : XS_T3Q_LO, l == 1 ? XS_T1Q_HI : XS_T3Q_HI);
            }
            SEAM();
            if (IN(pb + 1)) phase_attn(j, lds);
            SEAM();
            if (IN(pb + 2)) {
                pg8::Gemm g{(const bf16*)WSP(WS_O), (const bf16*)WSP(WS_WO + j * SZ_WO), MROWS, 4096, 4096}; pg8::StaticOrder S; S.init(MROWS, 4096, gridDim.x, (int)blockIdx.x);
                pg8::EpiY E{(bf16*)WSP(WS_Z), MODS_L(l) + 2 * 4096};
                pg8::gemm_phase<pg8::EpiY, pg8::StaticOrder, true, true, 4096>(lds, g, S, E);
            }
            SEAM();
        }
        if (IN(pb + 4)) phase_ln1(lds, XRES(l), l != 0, (const bf16*)WSP(WS_Z), in_ptr<5>() + (size_t)(l * 2 + 0) * 4096, in_ptr<6>() + (size_t)(l * 2 + 0) * 4096, MODS_L(l), (bf16*)WSP(WS_H));
        SEAM();
        if (IN(pb + 5)) {
            pg8::Gemm g{(const bf16*)WSP(WS_H), (const bf16*)WSP(WS_WIN + l * SZ_WIN), MROWS, 2 * DFF, 4096}; pg8::StaticOrder S; S.init(MROWS, 2 * DFF, gridDim.x, (int)blockIdx.x);
            pg8::EpiSwiGLU E{(bf16*)WSP(WS_ACT), DFF};
            pg8::gemm_phase<pg8::EpiSwiGLU, pg8::StaticOrder, true, true, 4096>(lds, g, S, E);
            if (l < 3) host_tail(lds, (MROWS / 256) * (2 * DFF / 256), l == 0 ? XS_T0_LO : (l == 1 ? XS_T1_LO : XS_T2_LO), l == 0 ? XS_T0_HI : (l == 1 ? XS_T1_HI : XS_T2_HI));
        }
        SEAM();
        if (IN(pb + 6)) {
            pg8::Gemm g{(const bf16*)WSP(WS_ACT), (const bf16*)WSP(WS_WDN + l * SZ_WDN), MROWS, 4096, DFF}; pg8::StaticOrder S; S.init(MROWS, 4096, gridDim.x, (int)blockIdx.x);
            pg8::EpiY E{(bf16*)WSP(WS_Z + SZ_H), MODS_L(l) + 5 * 4096};
            pg8::gemm_phase<pg8::EpiY, pg8::StaticOrder, true, true, DFF>(lds, g, S, E);
        }
        SEAM();
        if (IN(pb + 7)) phase_ln2(lds, XRES(l), l != 0, l != 3, (const bf16*)WSP(WS_Z), (const bf16*)WSP(WS_Z + SZ_H), in_ptr<5>() + (size_t)(l * 2 + 0) * 4096, in_ptr<6>() + (size_t)(l * 2 + 0) * 4096, in_ptr<5>() + (size_t)(l * 2 + 1) * 4096, in_ptr<6>() + (size_t)(l * 2 + 1) * 4096, (l == 3) ? out_ptr() : (float*)WSP(WS_X), MODS_L(l + 1), (l == 3) ? (bf16*)nullptr : (bf16*)WSP(WS_H));
        if (l < 3) SEAM();
    }
#undef IN
#undef SEAM
#undef GRID_BAR
}

extern "C" void kernel_launch(void* const* d_in, const int* in_sizes, int n_in, void* d_out, int out_size, void* d_ws, size_t ws_size, hipStream_t stream) {
    static int grid = 0;
    if (grid == 0) {
        if (n_in != 24 || out_size != MROWS * DM || ws_size < WS_END) { fprintf(stderr, "kernel_launch: unexpected problem (n_in %d, out %d, ws %zu < %zu)\n", n_in, out_size, ws_size, (size_t)WS_END); grid = -1; return; }
        int dev = 0, cus = 0, per_cu = 0;
        if (hipGetDevice(&dev) != hipSuccess || hipDeviceGetAttribute(&cus, hipDeviceAttributeMultiprocessorCount, dev) != hipSuccess) { grid = -1; return; }
        if (hipFuncSetAttribute((const void*)fwd_kernel, hipFuncAttributeMaxDynamicSharedMemorySize, LDS_BYTES) != hipSuccess) { fprintf(stderr, "kernel_launch: hipFuncSetAttribute failed\n"); grid = -1; return; }
        if (hipOccupancyMaxActiveBlocksPerMultiprocessor(&per_cu, (const void*)fwd_kernel, NTHR, LDS_BYTES) != hipSuccess || per_cu < 1) fprintf(stderr, "kernel_launch: occupancy query says %d\n", per_cu);
        (void)hipGetLastError();
        grid = cus;
    }
    if (grid < 0) return;
    (void)hipMemsetAsync((char*)d_ws + WS_CTL, 0, CTL_BYTES, stream);
    Args a{};
    for (int i = 0; i < 24; ++i) a.in[i] = (const float*)d_in[i];
    a.out = (float*)d_out; a.ws = (unsigned char*)d_ws;
#if MK_ONE_LAUNCH
    a.ph_lo = 0; a.ph_hi = N_PHASES;
    hipLaunchKernelGGL(fwd_kernel, dim3(grid), dim3(NTHR), LDS_BYTES, stream, a);
#else
    for (int ph = 0; ph < N_PHASES; ++ph) {
        if (ph >= 3 && ((ph - 3) & 7) == 3 && (((ph - 3) >> 3) & 1)) continue;
        a.ph_lo = ph; a.ph_hi = ph + 1;
        hipLaunchKernelGGL(fwd_kernel, dim3(grid), dim3(NTHR), LDS_BYTES, stream, a);
    }
#endif
}
```
